# Optimizing an MI355X kernel written in HIP

```python
import math
import jax
import jax.numpy as jnp
from jax import lax
import numpy as np

D_MODEL = 1024
BATCH = 4
SEQ = 8192
DEPTH = 1

GRID_W = 64
CTX_LEN = 256
HEAD_DIM = 64
N_HEADS_DIFF = 8
N_HEADS_NA = 8
DIFF_QK_WIDTH = N_HEADS_DIFF * 2 * HEAD_DIM
DIFF_V_WIDTH = N_HEADS_DIFF * 2 * HEAD_DIM
NA_WIDTH = N_HEADS_NA * HEAD_DIM
IN_WIDTH = 2 * DIFF_QK_WIDTH + DIFF_V_WIDTH + 3 * NA_WIDTH + 2 * D_MODEL
NA_KH = 8
NA_KW = 16
Q_BLOCK = 128
ROPE_BASE = 10000.0
N_GROUPS = 4
EXPERTS_PER_GROUP = 8
N_EXPERTS = N_GROUPS * EXPERTS_PER_GROUP
TOP_K_IN_GROUP = 2
EXPERT_HIDDEN = 512
NORM_EPS = 1e-6

kernel_name = "hybrid_diffattn_natten_hmoe_block"


def rms_norm(x, w):
    xf = x.astype(jnp.float32)
    y = xf * lax.rsqrt(jnp.mean(xf * xf, axis=-1, keepdims=True) + NORM_EPS)
    return (y * w.astype(jnp.float32)).astype(x.dtype)


def adaln(cond, w_ada, b_ada):
    m = jax.nn.silu(cond) @ w_ada + b_ada
    return jnp.split(m, 6, axis=-1)


def modulate(h, shift, scale):
    return h * (1 + scale) + shift


def split_columns(p):
    widths = (DIFF_QK_WIDTH, DIFF_QK_WIDTH, DIFF_V_WIDTH, NA_WIDTH, NA_WIDTH, NA_WIDTH, D_MODEL, D_MODEL)
    points = [int(i) for i in np.cumsum(widths)[:-1]]
    return jnp.split(p, points, axis=-1)


def axial_rope_tables(n_tokens):
    t = jnp.arange(n_tokens, dtype=jnp.int32)
    pos = jnp.stack([t // GRID_W, t % GRID_W], axis=-1).astype(jnp.float32)
    n_freq = HEAD_DIM // 4
    inv_freq = ROPE_BASE ** (-jnp.arange(n_freq, dtype=jnp.float32) / n_freq)
    ang = pos[:, :, None] * inv_freq
    return jnp.cos(ang), jnp.sin(ang)


def apply_axial_rope(x, cos, sin):
    xr = x.reshape(*x.shape[:-1], 2, 2, HEAD_DIM // 4)
    x1, x2 = xr[..., 0, :], xr[..., 1, :]
    cs = cos[None, :, None].astype(x.dtype)
    sn = sin[None, :, None].astype(x.dtype)
    out = jnp.stack([x1 * cs - x2 * sn, x1 * sn + x2 * cs], axis=-2)
    return out.reshape(x.shape)


def diff_heads(q, k, v, q_norm, k_norm):
    b, l, _ = q.shape
    q = rms_norm(q.reshape(b, l, N_HEADS_DIFF, 2, HEAD_DIM), q_norm)
    k = rms_norm(k.reshape(b, l, N_HEADS_DIFF, 2, HEAD_DIM), k_norm)
    v = v.reshape(b, l, N_HEADS_DIFF, 2 * HEAD_DIM)
    return q[:, :, :, 0], q[:, :, :, 1], k[:, :, :, 0], k[:, :, :, 1], v


def diff_attend(q1, q2, k1, k2, v, lam):
    scale = HEAD_DIM ** -0.5
    p1 = jax.nn.softmax(jnp.einsum('bqhd,bkhd->bhqk', q1, k1).astype(jnp.float32) * scale, axis=-1)
    p2 = jax.nn.softmax(jnp.einsum('bqhd,bkhd->bhqk', q2, k2).astype(jnp.float32) * scale, axis=-1)
    p = (p1 - lam * p2).astype(v.dtype)
    return jnp.einsum('bhqk,bkhe->bqhe', p, v)


def diff_attention_blocks(q1, q2, k1, k2, v, lam):
    b, n, h, d = q1.shape
    nb = n // Q_BLOCK

    def blocks(q):
        return q.reshape(b, nb, Q_BLOCK, h, d).transpose(1, 0, 2, 3, 4)

    o = lax.map(lambda qs: diff_attend(qs[0], qs[1], k1, k2, v, lam), (blocks(q1), blocks(q2)))
    return o.transpose(1, 0, 2, 3, 4).reshape(b, n, h, 2 * d)


def softmax_attend(q, k, v):
    scale = HEAD_DIM ** -0.5
    p = jax.nn.softmax(jnp.einsum('bqhd,bkhd->bhqk', q, k).astype(jnp.float32) * scale, axis=-1)
    return jnp.einsum('bhqk,bkhd->bqhd', p.astype(v.dtype), v)


def neighbourhood_attention(q, k, v, k_ctx, v_ctx, rel_bias, rows):
    b, n, h, d = q.shape
    kh = min(NA_KH, rows)
    kw = NA_KW
    n_loc = kh * kw
    scale = d ** -0.5
    qg = q.reshape(b, rows, GRID_W, h, d)
    kg = k.reshape(b, rows, GRID_W, h, d)
    vg = v.reshape(b, rows, GRID_W, h, d)
    cols = np.arange(GRID_W)
    col_start = np.clip(cols - kw // 2, 0, GRID_W - kw)
    col_idx = col_start[:, None] + np.arange(kw)[None, :]
    col_bias_idx = col_idx - cols[:, None] + (NA_KW - 1)

    def row_block(r):
        r0 = jnp.clip(r - kh // 2, 0, rows - kh)
        q_row = lax.dynamic_index_in_dim(qg, r, axis=1, keepdims=False)
        k_rows = lax.dynamic_slice_in_dim(kg, r0, kh, axis=1)
        v_rows = lax.dynamic_slice_in_dim(vg, r0, kh, axis=1)
        k_win = k_rows[:, :, col_idx]
        v_win = v_rows[:, :, col_idx]
        row_bias_idx = r0 + jnp.arange(kh) - r + (NA_KH - 1)
        bias = rel_bias[:, row_bias_idx][:, :, col_bias_idx]
        s_loc = (jnp.einsum('bwhd,biwjhd->bhwij', q_row, k_win).astype(jnp.float32) * scale
                 + bias.transpose(0, 2, 1, 3)[None].astype(jnp.float32))
        s_ctx = jnp.einsum('bwhd,bchd->bhwc', q_row, k_ctx).astype(jnp.float32) * scale
        s = jnp.concatenate([s_loc.reshape(b, h, GRID_W, n_loc), s_ctx], axis=-1)
        p = jax.nn.softmax(s, axis=-1).astype(v.dtype)
        p_loc = p[..., :n_loc].reshape(b, h, GRID_W, kh, kw)
        p_ctx = p[..., n_loc:]
        return (jnp.einsum('bhwij,biwjhd->bwhd', p_loc, v_win)
                + jnp.einsum('bhwc,bchd->bwhd', p_ctx, v_ctx))

    o = lax.map(row_block, jnp.arange(rows, dtype=jnp.int32))
    return o.transpose(1, 0, 2, 3, 4).reshape(b, n, h * d)


def gated_merge(o_a, o_b, g_a, g_b, w_branch_a, w_branch_b, w_out):
    y = jax.nn.sigmoid(g_a) * (o_a @ w_branch_a) + jax.nn.sigmoid(g_b) * (o_b @ w_branch_b)
    return y @ w_out


def hierarchical_moe(h, w_rg, b_rg, w_re, b_re, w_gate, w_up, w_down):
    b, l, d = h.shape
    t = h.reshape(b * l, d)
    g_logits = (t @ w_rg + b_rg).astype(jnp.float32)
    g_prob = jax.nn.softmax(g_logits, axis=-1)
    g_idx = jnp.argmax(g_logits, axis=-1)
    g_w = jnp.max(g_prob, axis=-1, keepdims=True)
    e_logits = (jnp.einsum('td,gde->tge', t, w_re) + b_re).astype(jnp.float32)
    sel = jnp.einsum('tge,tg->te', e_logits, jax.nn.one_hot(g_idx, N_GROUPS, dtype=jnp.float32))
    top_vals, top_idx = lax.top_k(sel, TOP_K_IN_GROUP)
    weights = g_w * jax.nn.softmax(top_vals, axis=-1)
    expert_idx = g_idx[:, None] * EXPERTS_PER_GROUP + top_idx
    comb = jnp.einsum('tke,tk->te', jax.nn.one_hot(expert_idx, N_EXPERTS, dtype=jnp.float32), weights)
    comb = comb.astype(t.dtype)
    y = jnp.zeros_like(t)
    for e in range(N_EXPERTS):
        hid = jax.nn.silu(t @ w_gate[e]) * (t @ w_up[e])
        y = y + comb[:, e:e + 1] * (hid @ w_down[e])
    return y.reshape(b, l, d)


def setup_inputs(seed: int = 0) -> dict:
    key = jax.random.key(seed)
    ks = jax.random.split(key, 32)
    f32 = jnp.float32
    L, D = DEPTH, D_MODEL

    def nrm(k, shape, scale):
        return jax.random.normal(k, shape, f32) * scale

    def gain(k, shape):
        return 1.0 + 0.02 * jax.random.normal(k, shape, f32)

    return {
        "x": nrm(ks[0], (BATCH, SEQ, D), 1.0),
        "c": nrm(ks[1], (BATCH, D), 1.0),
        "ctx": nrm(ks[2], (BATCH, CTX_LEN, D), 1.0),
        "c_ctx": nrm(ks[3], (D,), 1.0),
        "w_ada": nrm(ks[4], (L, D, 6 * D), 0.5 * D ** -0.5),
        "b_ada": nrm(ks[5], (L, 6 * D), 0.02),
        "norm1_w": gain(ks[6], (L, D)),
        "norm2_w": gain(ks[7], (L, D)),
        "w_in": nrm(ks[8], (L, D, IN_WIDTH), D ** -0.5),
        "q_norm_a": gain(ks[9], (L, HEAD_DIM)),
        "k_norm_a": gain(ks[10], (L, HEAD_DIM)),
        "lambda_q1": nrm(ks[11], (L, HEAD_DIM), 0.1),
        "lambda_k1": nrm(ks[12], (L, HEAD_DIM), 0.1),
        "lambda_q2": nrm(ks[13], (L, HEAD_DIM), 0.1),
        "lambda_k2": nrm(ks[14], (L, HEAD_DIM), 0.1),
        "subln_a": gain(ks[15], (L, 2 * HEAD_DIM)),
        "q_norm_b": gain(ks[16], (L, HEAD_DIM)),
        "k_norm_b": gain(ks[17], (L, HEAD_DIM)),
        "na_rel_bias": nrm(ks[18], (L, N_HEADS_NA, 2 * NA_KH - 1, 2 * NA_KW - 1), 0.1),
        "w_branch_a": nrm(ks[19], (L, DIFF_V_WIDTH, D), DIFF_V_WIDTH ** -0.5),
        "w_branch_b": nrm(ks[20], (L, NA_WIDTH, D), NA_WIDTH ** -0.5),
        "w_out": nrm(ks[21], (L, D, D), D ** -0.5),
        "w_router_group": nrm(ks[22], (L, D, N_GROUPS), D ** -0.5),
        "b_router_group": nrm(ks[23], (L, N_GROUPS), 0.01),
        "w_router_expert": nrm(ks[24], (L, N_GROUPS, D, EXPERTS_PER_GROUP), D ** -0.5),
        "b_router_expert": nrm(ks[25], (L, N_GROUPS, EXPERTS_PER_GROUP), 0.01),
        "w_expert_gate": nrm(ks[26], (L, N_EXPERTS, D, EXPERT_HIDDEN), D ** -0.5),
        "w_expert_up": nrm(ks[27], (L, N_EXPERTS, D, EXPERT_HIDDEN), D ** -0.5),
        "w_expert_down": nrm(ks[28], (L, N_EXPERTS, EXPERT_HIDDEN, D), EXPERT_HIDDEN ** -0.5),
    }


def reference(x, c, ctx, c_ctx, w_ada, b_ada, norm1_w, norm2_w, w_in, q_norm_a, k_norm_a,
              lambda_q1, lambda_k1, lambda_q2, lambda_k2, subln_a, q_norm_b, k_norm_b, na_rel_bias,
              w_branch_a, w_branch_b, w_out, w_router_group, b_router_group, w_router_expert,
              b_router_expert, w_expert_gate, w_expert_up, w_expert_down):
    b, n, d = x.shape
    rows = n // GRID_W
    cos, sin = axial_rope_tables(n)
    for l in range(DEPTH):
        need_ctx = l < DEPTH - 1
        lam_init = 0.8 - 0.6 * math.exp(-0.3 * l)
        sh1, sc1, ga1, sh2, sc2, ga2 = adaln(c[:, None, :], w_ada[l], b_ada[l])
        csh1, csc1, cga1, csh2, csc2, cga2 = adaln(c_ctx[None, None, :], w_ada[l], b_ada[l])

        hx = modulate(rms_norm(x, norm1_w[l]), sh1, sc1)
        hc = modulate(rms_norm(ctx, norm1_w[l]), csh1, csc1)
        qa_x, ka_x, va_x, qb_x, kb_x, vb_x, gate_a_x, gate_b_x = split_columns(hx @ w_in[l])
        qa_c, ka_c, va_c, qb_c, kb_c, vb_c, gate_a_c, gate_b_c = split_columns(hc @ w_in[l])

        lam = (jnp.exp(jnp.sum(lambda_q1[l] * lambda_k1[l]).astype(jnp.float32))
               - jnp.exp(jnp.sum(lambda_q2[l] * lambda_k2[l]).astype(jnp.float32)) + lam_init)
        q1x, q2x, k1x, k2x, vax = diff_heads(qa_x, ka_x, va_x, q_norm_a[l], k_norm_a[l])
        q1c, q2c, k1c, k2c, vac = diff_heads(qa_c, ka_c, va_c, q_norm_a[l], k_norm_a[l])
        q1x, q2x = apply_axial_rope(q1x, cos, sin), apply_axial_rope(q2x, cos, sin)
        k1x, k2x = apply_axial_rope(k1x, cos, sin), apply_axial_rope(k2x, cos, sin)
        o_a = diff_attention_blocks(q1x, q2x,
                                    jnp.concatenate([k1c, k1x], axis=1),
                                    jnp.concatenate([k2c, k2x], axis=1),
                                    jnp.concatenate([vac, vax], axis=1), lam)
        o_a = (rms_norm(o_a, subln_a[l]) * (1 - lam_init)).reshape(b, n, DIFF_V_WIDTH)

        qbx = rms_norm(qb_x.reshape(b, n, N_HEADS_NA, HEAD_DIM), q_norm_b[l])
        kbx = rms_norm(kb_x.reshape(b, n, N_HEADS_NA, HEAD_DIM), k_norm_b[l])
        vbx = vb_x.reshape(b, n, N_HEADS_NA, HEAD_DIM)
        kbc = rms_norm(kb_c.reshape(b, CTX_LEN, N_HEADS_NA, HEAD_DIM), k_norm_b[l])
        vbc = vb_c.reshape(b, CTX_LEN, N_HEADS_NA, HEAD_DIM)
        o_b = neighbourhood_attention(qbx, kbx, vbx, kbc, vbc, na_rel_bias[l], rows)

        x_mid = x + ga1 * gated_merge(o_a, o_b, gate_a_x, gate_b_x, w_branch_a[l], w_branch_b[l], w_out[l])

        hx2 = modulate(rms_norm(x_mid, norm2_w[l]), sh2, sc2)
        x_new = x_mid + ga2 * hierarchical_moe(hx2, w_router_group[l], b_router_group[l], w_router_expert[l],
                                               b_router_expert[l], w_expert_gate[l], w_expert_up[l],
                                               w_expert_down[l])

        if need_ctx:
            o_a_c = diff_attend(q1c, q2c, k1c, k2c, vac, lam)
            o_a_c = (rms_norm(o_a_c, subln_a[l]) * (1 - lam_init)).reshape(b, CTX_LEN, DIFF_V_WIDTH)
            qbc = rms_norm(qb_c.reshape(b, CTX_LEN, N_HEADS_NA, HEAD_DIM), q_norm_b[l])
            o_b_c = softmax_attend(qbc, kbc, vbc).reshape(b, CTX_LEN, NA_WIDTH)
            ctx_mid = ctx + cga1 * gated_merge(o_a_c, o_b_c, gate_a_c, gate_b_c, w_branch_a[l], w_branch_b[l], w_out[l])
            hc2 = modulate(rms_norm(ctx_mid, norm2_w[l]), csh2, csc2)
            ctx = ctx_mid + cga2 * hierarchical_moe(hc2, w_router_group[l], b_router_group[l], w_router_expert[l],
                                                    b_router_expert[l], w_expert_gate[l], w_expert_up[l],
                                                    w_expert_down[l])
        x = x_new
    return x
```

```cpp
#include <hip/hip_runtime.h>
#include <cstdio>
#include <cstdint>

#ifndef MK_N_LAUNCHES
#define MK_N_LAUNCHES 1
#endif

constexpr int NB = 4, SEQ = 8192, D = 1024, T = NB * SEQ, CTX = 256, TC = NB * CTX, MROWS = T + TC;
constexpr int KVL = CTX + SEQ;
constexpr int NIN = 6656, GRIDW = 64, NROWS = SEQ / GRIDW;
constexpr int NH = 8, HD = 64;
constexpr int NEXP = 32, EH = 512, NGRP = 4, EPG = 8;
constexpr int NLIST = 64;
constexpr float EPS = 1e-6f;
constexpr float LOG2E = 1.4426950408889634f;
constexpr float C2 = 0.125f * LOG2E;

constexpr size_t MiB = 1u << 20;
constexpr size_t WS_CTL = 0, CTL_ZERO_BYTES = 1 * MiB;
constexpr size_t WS_MOD = 1 * MiB;
constexpr size_t WS_ROPE = 1 * MiB + 256 * 1024;
constexpr size_t WS_RT = 2 * MiB;
constexpr size_t WS_LIST = 4 * MiB;
constexpr size_t WS_XN = 126 * MiB;
constexpr size_t WS_QA = 192 * MiB;
constexpr size_t WS_QB = 256 * MiB;
constexpr size_t WS_KA = 288 * MiB;
constexpr size_t WS_VA = 354 * MiB;
constexpr size_t WS_KB = 420 * MiB;
constexpr size_t WS_VB = 453 * MiB;
constexpr size_t WS_END = 486 * MiB;
constexpr size_t WS_Y = WS_XN, WS_H2 = WS_XN, WS_HID = WS_QA, WS_XMID = WS_KA;
constexpr int CW_TMO = 0, CW_BAR = 4096, CW_CNT = 16384;

constexpr int LDS_BYTES = 155648;
constexpr int NTHR = 512;

#define GAS __attribute__((address_space(1)))
#define LAS __attribute__((address_space(3)))
typedef unsigned short bf16;
typedef float f32x4 __attribute__((ext_vector_type(4)));
typedef float f32x2 __attribute__((ext_vector_type(2)));
typedef unsigned u32x4 __attribute__((ext_vector_type(4)));
typedef unsigned u32x2 __attribute__((ext_vector_type(2)));
typedef GAS unsigned gu32;

__device__ __forceinline__ unsigned f2bf(float f) { unsigned u = __builtin_bit_cast(unsigned, f); return (u + 0x7fffu + ((u >> 16) & 1u)) >> 16; }
__device__ __forceinline__ float bf2f(unsigned h) { return __builtin_bit_cast(float, h << 16); }
__device__ __forceinline__ float rbf(float f) { return bf2f(f2bf(f)); }
__device__ __forceinline__ unsigned pk2(float lo, float hi) { return f2bf(lo) | (f2bf(hi) << 16); }

#define XB_TMO      128
#define XB_XCNT(j)  (256  + 64 * (j))
#define XB_XSUB(j)  (1280 + 64 * (j))
#define XB_XGEN(j)  (2304 + 64 * (j))
#define XB_TOP      3328
#define XB_TOPGEN   3392
#define XCD_BAR_WORDS 3456
#define XB_SPIN_CAP (1u << 18)
__device__ __forceinline__ unsigned xb_ld(unsigned* p)              { return __hip_atomic_load(p, __ATOMIC_RELAXED, __HIP_MEMORY_SCOPE_AGENT); }
__device__ __forceinline__ unsigned xb_add(unsigned* p, unsigned v) { return __hip_atomic_fetch_add(p, v, __ATOMIC_RELAXED, __HIP_MEMORY_SCOPE_AGENT); }
__device__ __forceinline__ unsigned xb_xcc_id() { return (unsigned)__builtin_amdgcn_s_getreg((3 << 11) | 20) & 0xFu; }
#define XB_SPIN(cond, bar) do { unsigned _sp = 0; while (cond) { __builtin_amdgcn_s_sleep(1); \
    if ((++_sp & 255u) == 0u) { if (xb_ld(&(bar)[XB_TMO])) break; if (_sp > XB_SPIN_CAP) { atomicAdd(&(bar)[XB_TMO], 1u); break; } } } } while (0)
struct XcdBarrier { unsigned* bar; unsigned x; volatile LAS unsigned* st; };
__device__ __forceinline__ XcdBarrier xcd_barrier_post(unsigned* bar, volatile LAS unsigned* st) {
    XcdBarrier b; b.bar = bar; b.x = xb_xcc_id(); b.st = st;
    if (threadIdx.x == 0) (void)xb_add(&bar[XB_XCNT(b.x)], 1u);
    return b;
}
__device__ __forceinline__ void xcd_barrier_complete(unsigned* bar, unsigned x, unsigned& nloc, unsigned& nx) {
    const unsigned G = gridDim.x * gridDim.y * gridDim.z;
    unsigned sum, cnt, mine, sp = 0u;
    for (;;) {
        sum = 0u; cnt = 0u; mine = 0u;
#pragma unroll
        for (unsigned j = 0; j < 16; ++j) { const unsigned c = xb_ld(&bar[XB_XCNT(j)]); sum += c; cnt += (c > 0u) ? 1u : 0u; mine = (j == x) ? c : mine; }
        if (sum == G) break;
        __builtin_amdgcn_s_sleep(1);
        if ((++sp & 255u) == 0u) { if (xb_ld(&bar[XB_TMO])) break; if (sp > XB_SPIN_CAP) { atomicAdd(&bar[XB_TMO], 1u); break; } }
    }
    nloc = mine > 0u ? mine : 1u; nx = cnt > 0u ? cnt : 1u;
}
__device__ __forceinline__ void xcd_barrier(const XcdBarrier& b) {
    asm volatile("s_waitcnt vmcnt(0)" ::: "memory");
    __syncthreads();
    if (threadIdx.x == 0) {
        unsigned* bar = b.bar;
        __builtin_amdgcn_s_waitcnt(0);
        unsigned nloc = b.st[0], nx = b.st[1];
        if (nloc == 0u) { xcd_barrier_complete(bar, b.x, nloc, nx); b.st[0] = nloc; b.st[1] = nx; }
        const unsigned old = xb_add(&bar[XB_XSUB(b.x)], 1u);
        const unsigned gen = old / nloc;
        if (old + 1u == (gen + 1u) * nloc) {
            __builtin_amdgcn_fence(__ATOMIC_RELEASE, "agent");
            asm volatile("s_waitcnt vmcnt(0)" ::: "memory");
            const unsigned og = xb_add(&bar[XB_TOP], 1u);
            const unsigned tg = og / nx;
            if (og + 1u == (tg + 1u) * nx) xb_add(&bar[XB_TOPGEN], 1u);
            else XB_SPIN(xb_ld(&bar[XB_TOPGEN]) == tg, bar);
            __builtin_amdgcn_fence(__ATOMIC_ACQUIRE, "agent");
            xb_add(&bar[XB_XGEN(b.x)], 1u);
            asm volatile("s_waitcnt vmcnt(0)" ::: "memory");
        } else {
            XB_SPIN(xb_ld(&bar[XB_XGEN(b.x)]) == gen, bar);
            __builtin_amdgcn_fence(__ATOMIC_ACQUIRE, "agent");
            asm volatile("s_waitcnt vmcnt(0)" ::: "memory");
        }
    }
    __syncthreads();
}

struct Args { const float* in[29]; float* out; unsigned char* ws; int ph_lo, ph_hi; };
struct Frame {
    LAS unsigned char* lds;
    unsigned char* ws; gu32* ctl;
    int tid, lane, wave, G, bid;
    const float* in[29];
    float* out;
};
__device__ __forceinline__ float wave_sum(float v) {
#pragma unroll
    for (int o = 1; o < 64; o <<= 1) v += __shfl_xor(v, o);
    return v;
}
__device__ __forceinline__ float silu_f(float v) { return v / (1.f + __expf(-v)); }
__device__ __forceinline__ float sigmoid_f(float v) { return 1.f / (1.f + __expf(-v)); }

__constant__ float INV_FREQ[16] = {1.0f, 0.5623413324356079f, 0.3162277638912201f, 0.17782793939113617f, 0.10000000149011612f, 0.05623413249850273f, 0.03162277489900589f, 0.017782794311642647f,
    0.009999999776482582f, 0.005623413249850273f, 0.003162277629598975f, 0.0017782794311642647f, 0.0010000000474974513f, 0.000562341301701963f, 0.0003162277571391314f, 0.00017782794020604342f};
__device__ __forceinline__ double sin_poly(double r) { double r2 = r * r, t = r, s = r; for (int i = 1; i <= 12; ++i) { t *= -r2 / (double)((2 * i) * (2 * i + 1)); s += t; } return s; }
__device__ __forceinline__ double cos_poly(double r) { double r2 = r * r, t = 1.0, s = 1.0; for (int i = 1; i <= 12; ++i) { t *= -r2 / (double)((2 * i - 1) * (2 * i)); s += t; } return s; }
__device__ __forceinline__ void p0_adaln_rope(Frame& F) {
    const float* c = F.in[1]; const float* c_ctx = F.in[3]; const float* w_ada = F.in[4]; const float* b_ada = F.in[5];
    float* MOD = (float*)(F.ws + WS_MOD);
    { float* RP = (float*)(F.ws + WS_ROPE);
      const int gi = F.bid * NTHR + F.tid;
      if (gi < 192 * 16) { const int pos = gi >> 4, f = gi & 15; const int p = pos < 128 ? pos : pos - 128;
          const float invf = INV_FREQ[f]; const float ang = (float)p * invf;
          const double a = (double)ang; const double k = rint(a * 0.15915494309189535); const double r = a - k * 6.283185307179586477;
          const float cs = (float)cos_poly(r), sn = (float)sin_poly(r);
          if (pos < 128) { RP[pos * 16 + f] = cs; RP[2048 + pos * 16 + f] = sn; } else { RP[4096 + p * 16 + f] = cs; RP[4096 + 1024 + p * 16 + f] = sn; } } }
    if (F.bid < 96) {
        LAS float* S = (LAS float*)F.lds;
        LAS float* R = S + 5 * 1024;
        for (int i = F.tid; i < 5 * 1024; i += NTHR) { const int r = i >> 10, k = i & 1023; const float v = r < 4 ? c[r * 1024 + k] : c_ctx[k]; S[i] = silu_f(v); }
        __syncthreads();
        for (int item = F.bid; item < 96; item += F.G) {
            const int c0 = item * 64; float acc[5] = {0.f, 0.f, 0.f, 0.f, 0.f};
            for (int kk = 0; kk < 128; ++kk) { const int k = F.wave * 128 + kk; const float w = w_ada[(size_t)k * 6144 + c0 + F.lane];
#pragma unroll
                for (int r = 0; r < 5; ++r) acc[r] += S[r * 1024 + k] * w; }
#pragma unroll
            for (int r = 0; r < 5; ++r) R[(F.wave * 5 + r) * 64 + F.lane] = acc[r];
            __syncthreads();
            if (F.tid < 320) { const int r = F.tid >> 6, l = F.tid & 63; float s = 0.f;
#pragma unroll
                for (int w = 0; w < 8; ++w) s += R[(w * 5 + r) * 64 + l];
                MOD[r * 6144 + c0 + l] = s + b_ada[c0 + l]; }
            __syncthreads();
        }
    }
}

__device__ __forceinline__ void norm_mod_row(const float* xrow, const float* nw, const float* scale, const float* shift, int lane, f32x4 (&v)[4]) {
    const GAS f32x4* xr = (const GAS f32x4*)xrow + lane; float ss = 0.f;
#pragma unroll
    for (int j = 0; j < 4; ++j) { v[j] = xr[64 * j]; ss += (v[j].x * v[j].x + v[j].y * v[j].y) + (v[j].z * v[j].z + v[j].w * v[j].w); }
    const float rstd = 1.0f / sqrtf(wave_sum(ss) * (1.f / D) + EPS);
#pragma unroll
    for (int j = 0; j < 4; ++j) { const int d0 = 4 * lane + 256 * j; const f32x4 w = *(const f32x4*)(nw + d0), sc = *(const f32x4*)(scale + d0), sh = *(const f32x4*)(shift + d0);
        v[j] = (v[j] * rstd * w) * (1.f + sc) + sh; }
}
__device__ __forceinline__ void store_row_bf16(bf16* orow, int lane, const f32x4 (&v)[4]) {
    GAS u32x2* o8 = (GAS u32x2*)orow + lane;
#pragma unroll
    for (int j = 0; j < 4; ++j) { u32x2 w; w.x = pk2(v[j].x, v[j].y); w.y = pk2(v[j].z, v[j].w); o8[64 * j] = w; }
}
__device__ __forceinline__ void p1a_norm1(Frame& F) {
    const float* x = F.in[0]; const float* ctx = F.in[2]; const float* nw = F.in[6];
    const float* MOD = (const float*)(F.ws + WS_MOD); bf16* XN = (bf16*)(F.ws + WS_XN);
    const int gw = F.bid * 8 + F.wave, NGW = F.G * 8;
    for (int m = gw; m < MROWS; m += NGW) {
        const float* row; int mr;
        if (m < T) { row = x + (size_t)m * D; mr = m / SEQ; } else { row = ctx + (size_t)(m - T) * D; mr = 4; }
        f32x4 v[4]; norm_mod_row(row, nw, MOD + mr * 6144 + 1024, MOD + mr * 6144, F.lane, v);
        store_row_bf16(XN + (size_t)m * D, F.lane, v);
    }
}

constexpr int NG_AS = 16 * 132, NG_BS = 16 * 68;
template <class AF, class BF>
__device__ __forceinline__ void gemm_core(float (&acc)[4][4], LAS float* As, LAS float* Bs, int K, int tid, const AF& af, const BF& bf) {
    const int ty = tid >> 4, tx = tid & 15;
    const int ar = tid >> 2, ak = (tid & 3) * 4;
    const int bk = tid >> 5, bn = (tid & 31) * 2;
    for (int k0 = 0; k0 < K; k0 += 16) {
        const u32x2 av = *(const GAS u32x2*)af(ar, k0 + ak);
        const f32x2 bv = bf(k0 + bk, bn);
        __syncthreads();
        As[(ak + 0) * 132 + ar] = bf2f(av.x & 0xffffu); As[(ak + 1) * 132 + ar] = bf2f(av.x >> 16);
        As[(ak + 2) * 132 + ar] = bf2f(av.y & 0xffffu); As[(ak + 3) * 132 + ar] = bf2f(av.y >> 16);
        Bs[bk * 68 + bn] = rbf(bv.x); Bs[bk * 68 + bn + 1] = rbf(bv.y);
        __syncthreads();
#pragma unroll
        for (int kk = 0; kk < 16; ++kk) {
            const f32x4 a = *(const LAS f32x4*)(As + kk * 132 + ty * 4), b = *(const LAS f32x4*)(Bs + kk * 68 + tx * 4);
#pragma unroll
            for (int i = 0; i < 4; ++i)
#pragma unroll
                for (int j = 0; j < 4; ++j) acc[i][j] += a[i] * b[j];
        }
    }
    __syncthreads();
}
__device__ __forceinline__ void zero_acc(float (&acc)[4][4]) {
#pragma unroll
    for (int i = 0; i < 4; ++i)
#pragma unroll
        for (int j = 0; j < 4; ++j) acc[i][j] = 0.f;
}

__device__ __forceinline__ int kv_row(int m) { if (m < T) { const int b = m / SEQ, t = m - b * SEQ; return b * KVL + CTX + t; } const int cm = m - T, b = cm / CTX, c = cm - b * CTX; return b * KVL + c; }

__device__ __forceinline__ void p1b_inproj(Frame& F) {
    const float* w_in = F.in[8];
    const bf16* XN = (const bf16*)(F.ws + WS_XN);
    LAS float* As = (LAS float*)F.lds; LAS float* Bs = As + NG_AS; LAS float* Ct = Bs + NG_BS;
    const float* RP = (const float*)(F.ws + WS_ROPE);
    bf16* QA = (bf16*)(F.ws + WS_QA); bf16* KA = (bf16*)(F.ws + WS_KA); bf16* VA = (bf16*)(F.ws + WS_VA);
    bf16* QB = (bf16*)(F.ws + WS_QB); bf16* KB = (bf16*)(F.ws + WS_KB); bf16* VB = (bf16*)(F.ws + WS_VB);
    bf16* GA = (bf16*)F.out; bf16* GB = GA + (size_t)T * D;
    constexpr int NT_LAT = (T / 128) * 104, NT_CTX = (TC / 128) * 48;
    for (int item = F.bid; item < NT_LAT + NT_CTX; item += F.G) {
        int tm, cg;
        if (item < NT_LAT) { tm = item / 104; cg = item % 104; }
        else { const int r = item - NT_LAT; tm = T / 128 + r / 48; const int c = r % 48; cg = c < 32 ? 16 + c : 56 + (c - 32); }
        const int m0 = tm * 128, n0 = cg * 64;
        float acc[4][4]; zero_acc(acc);
        gemm_core(acc, As, Bs, D, F.tid,
                  [&](int row, int k) { return XN + (size_t)(m0 + row) * D + k; },
                  [&](int k, int n) { return *(const f32x2*)(w_in + (size_t)k * NIN + n0 + n); });
        { const int ty = F.tid >> 4, tx = F.tid & 15;
#pragma unroll
          for (int i = 0; i < 4; ++i)
#pragma unroll
              for (int j = 0; j < 4; ++j) Ct[(ty * 4 + i) * 65 + tx * 4 + j] = acc[i][j]; }
        __syncthreads();
        const int row = F.tid >> 2, q4 = F.tid & 3, m = m0 + row; const LAS float* cr = Ct + row * 65;
        float v[16];
#pragma unroll
        for (int i = 0; i < 16; ++i) v[i] = cr[q4 * 16 + i];
        int kind; const float* gain = nullptr; bf16* dst; bool rope = false; float oscale = 1.f;
        if (cg < 16)      { kind = 0; gain = F.in[9];  dst = QA + (size_t)m * D + cg * 64; rope = true; oscale = C2; }
        else if (cg < 32) { kind = 0; gain = F.in[10]; dst = KA + (size_t)kv_row(m) * D + (cg - 16) * 64; rope = (m < T); }
        else if (cg < 48) { kind = 1; dst = VA + (size_t)kv_row(m) * D + (cg - 32) * 64; }
        else if (cg < 56) { kind = 0; gain = F.in[16]; dst = QB + (size_t)m * 512 + (cg - 48) * 64; oscale = C2; }
        else if (cg < 64) { kind = 0; gain = F.in[17]; dst = KB + (size_t)kv_row(m) * 512 + (cg - 56) * 64; }
        else if (cg < 72) { kind = 1; dst = VB + (size_t)kv_row(m) * 512 + (cg - 64) * 64; }
        else if (cg < 88) { kind = 2; dst = GA + (size_t)m * D + (cg - 72) * 64; }
        else              { kind = 2; dst = GB + (size_t)m * D + (cg - 88) * 64; }
        if (kind == 0) {
            float ss = 0.f;
#pragma unroll
            for (int i = 0; i < 16; ++i) ss += v[i] * v[i];
            ss += __shfl_xor(ss, 1); ss += __shfl_xor(ss, 2);
            const float rstd = 1.0f / sqrtf(ss * (1.f / 64.f) + EPS);
#pragma unroll
            for (int i = 0; i < 16; ++i) v[i] = v[i] * rstd * gain[q4 * 16 + i];
            if (rope) {
                const int t = m % SEQ, pr = t / GRIDW, pc = t % GRIDW;
                const float* cs = (q4 < 2) ? RP + pr * 16 : RP + 4096 + pc * 16;
                const float* sn = (q4 < 2) ? RP + 2048 + pr * 16 : RP + 4096 + 1024 + pc * 16;
#pragma unroll
                for (int i = 0; i < 16; ++i) { const float o = __shfl_xor(v[i], 1);
                    v[i] = (q4 & 1) ? (o * sn[i] + v[i] * cs[i]) : (v[i] * cs[i] - o * sn[i]); }
            }
#pragma unroll
            for (int i = 0; i < 16; ++i) v[i] *= oscale;
        } else if (kind == 2) {
#pragma unroll
            for (int i = 0; i < 16; ++i) v[i] = sigmoid_f(v[i]);
        }
        const bool skip = (m >= T) && (cg < 16 || (cg >= 48 && cg < 56) || cg >= 72);
        if (!skip) { u32x4 w0, w1; w0.x = pk2(v[0], v[1]); w0.y = pk2(v[2], v[3]); w0.z = pk2(v[4], v[5]); w0.w = pk2(v[6], v[7]);
            w1.x = pk2(v[8], v[9]); w1.y = pk2(v[10], v[11]); w1.z = pk2(v[12], v[13]); w1.w = pk2(v[14], v[15]);
            *(GAS u32x4*)(dst + q4 * 16) = w0; *(GAS u32x4*)(dst + q4 * 16 + 8) = w1; }
        __syncthreads();
    }
}

__device__ __forceinline__ float lam_value(const float* const (&in)[29]) {
    float a = 0.f, b = 0.f;
    for (int i = 0; i < 64; ++i) { a += in[11][i] * in[12][i]; b += in[13][i] * in[14][i]; }
    return expf(a) - expf(b) + 0.2f;
}
__device__ __forceinline__ float qk_bound(const float* gq, const float* gk) {
    float mq = 0.f, mk = 0.f; for (int i = 0; i < 64; ++i) { mq = fmaxf(mq, fabsf(gq[i])); mk = fmaxf(mk, fabsf(gk[i])); }
    return 8.0f * mq * mk * LOG2E * 1.02f + 0.1f;
}
__device__ __forceinline__ void p2a_diffattn(Frame& F) {
    bf16* QA = (bf16*)(F.ws + WS_QA); const bf16* KA = (const bf16*)(F.ws + WS_KA); const bf16* VA = (const bf16*)(F.ws + WS_VA);
    const float* subln = F.in[15];
    const float lam = lam_value(F.in); const float mb = qk_bound(F.in[9], F.in[10]);
    LAS float* K1s = (LAS float*)F.lds; LAS float* K2s = K1s + 32 * 64; LAS float* Vs = K2s + 32 * 64;
    LAS float* X = Vs + 32 * 128;
    LAS float* SS = X + 128 * 128;
    const int qrow = F.tid & 127, vh = (F.tid >> 7) & 1, br = F.tid >> 8;
    for (int unit = F.bid; unit < NB * NH * (SEQ / 128); unit += F.G) {
        const int bh = unit / (SEQ / 128), qt = unit % (SEQ / 128), b = bh / NH, h = bh % NH;
        const size_t qoff = (size_t)(b * SEQ + qt * 128 + qrow) * D + h * 128;
        float q[64], o[64], l = 0.f;
#pragma unroll
        for (int i = 0; i < 8; ++i) { const u32x4 w = *(const GAS u32x4*)(QA + qoff + br * 64 + i * 8);
            q[i * 8 + 0] = bf2f(w.x & 0xffffu); q[i * 8 + 1] = bf2f(w.x >> 16); q[i * 8 + 2] = bf2f(w.y & 0xffffu); q[i * 8 + 3] = bf2f(w.y >> 16);
            q[i * 8 + 4] = bf2f(w.z & 0xffffu); q[i * 8 + 5] = bf2f(w.z >> 16); q[i * 8 + 6] = bf2f(w.w & 0xffffu); q[i * 8 + 7] = bf2f(w.w >> 16); }
#pragma unroll
        for (int i = 0; i < 64; ++i) o[i] = 0.f;
        const bf16* Kb = KA + (size_t)b * KVL * D + h * 128; const bf16* Vb = VA + (size_t)b * KVL * D + h * 128;
        for (int kt = 0; kt < KVL / 32; ++kt) {
            __syncthreads();
            {
              const int r = F.tid >> 4, c8 = (F.tid & 15) * 8; const size_t go = (size_t)(kt * 32 + r) * D + c8;
              const u32x4 kw = *(const GAS u32x4*)(Kb + go); const u32x4 vw = *(const GAS u32x4*)(Vb + go);
              LAS float* kd = (c8 < 64) ? K1s + r * 64 + c8 : K2s + r * 64 + (c8 - 64);
              kd[0] = bf2f(kw.x & 0xffffu); kd[1] = bf2f(kw.x >> 16); kd[2] = bf2f(kw.y & 0xffffu); kd[3] = bf2f(kw.y >> 16);
              kd[4] = bf2f(kw.z & 0xffffu); kd[5] = bf2f(kw.z >> 16); kd[6] = bf2f(kw.w & 0xffffu); kd[7] = bf2f(kw.w >> 16);
              LAS float* vd = Vs + r * 128 + c8;
              vd[0] = bf2f(vw.x & 0xffffu); vd[1] = bf2f(vw.x >> 16); vd[2] = bf2f(vw.y & 0xffffu); vd[3] = bf2f(vw.y >> 16);
              vd[4] = bf2f(vw.z & 0xffffu); vd[5] = bf2f(vw.z >> 16); vd[6] = bf2f(vw.w & 0xffffu); vd[7] = bf2f(vw.w >> 16); }
            __syncthreads();
            const LAS float* Ks = br ? K2s : K1s;
            for (int j = 0; j < 32; ++j) {
                float s = 0.f;
#pragma unroll
                for (int d4 = 0; d4 < 16; ++d4) { const f32x4 kv = *(const LAS f32x4*)(Ks + j * 64 + d4 * 4);
                    s += q[d4 * 4] * kv.x + q[d4 * 4 + 1] * kv.y + q[d4 * 4 + 2] * kv.z + q[d4 * 4 + 3] * kv.w; }
                const float p = rbf(exp2f(s - mb)); l += p;
#pragma unroll
                for (int e4 = 0; e4 < 16; ++e4) { const f32x4 vv = *(const LAS f32x4*)(Vs + j * 128 + vh * 64 + e4 * 4);
                    o[e4 * 4] += p * vv.x; o[e4 * 4 + 1] += p * vv.y; o[e4 * 4 + 2] += p * vv.z; o[e4 * 4 + 3] += p * vv.w; }
            }
        }
        const float rl = 1.f / l;
        if (br == 1) {
#pragma unroll
            for (int i = 0; i < 64; ++i) X[qrow * 128 + vh * 64 + i] = o[i] * rl;
        }
        __syncthreads();
        float ss = 0.f;
        if (br == 0) {
#pragma unroll
            for (int i = 0; i < 64; ++i) { o[i] = o[i] * rl - lam * X[qrow * 128 + vh * 64 + i]; ss += o[i] * o[i]; }
            SS[qrow * 2 + vh] = ss;
        }
        __syncthreads();
        if (br == 0) {
            const float tot = SS[qrow * 2] + SS[qrow * 2 + 1]; const float rstd = 1.0f / sqrtf(tot * (1.f / 128.f) + EPS);
            bf16* dst = QA + qoff + vh * 64;
#pragma unroll
            for (int i = 0; i < 8; ++i) { u32x4 w; const float* sg = subln + vh * 64 + i * 8;
                w.x = pk2(o[i * 8] * rstd * sg[0] * 0.8f, o[i * 8 + 1] * rstd * sg[1] * 0.8f); w.y = pk2(o[i * 8 + 2] * rstd * sg[2] * 0.8f, o[i * 8 + 3] * rstd * sg[3] * 0.8f);
                w.z = pk2(o[i * 8 + 4] * rstd * sg[4] * 0.8f, o[i * 8 + 5] * rstd * sg[5] * 0.8f); w.w = pk2(o[i * 8 + 6] * rstd * sg[6] * 0.8f, o[i * 8 + 7] * rstd * sg[7] * 0.8f);
                *(GAS u32x4*)(dst + i * 8) = w; }
        }
        __syncthreads();
    }
}

__device__ __forceinline__ void p2b_natten(Frame& F) {
    bf16* QB = (bf16*)(F.ws + WS_QB); const bf16* KB = (const bf16*)(F.ws + WS_KB); const bf16* VB = (const bf16*)(F.ws + WS_VB);
    const float* bias = F.in[18];
    const int w = F.tid & 63, h = F.tid >> 6;
    for (int unit = F.bid; unit < NB * NROWS; unit += F.G) {
        const int b = unit / NROWS, r = unit % NROWS;
        const size_t qoff = (size_t)(b * SEQ + r * GRIDW + w) * 512 + h * 64;
        float q[64], o[64], l = 0.f, mx = -1e30f;
#pragma unroll
        for (int i = 0; i < 8; ++i) { const u32x4 ww = *(const GAS u32x4*)(QB + qoff + i * 8);
            q[i * 8 + 0] = bf2f(ww.x & 0xffffu); q[i * 8 + 1] = bf2f(ww.x >> 16); q[i * 8 + 2] = bf2f(ww.y & 0xffffu); q[i * 8 + 3] = bf2f(ww.y >> 16);
            q[i * 8 + 4] = bf2f(ww.z & 0xffffu); q[i * 8 + 5] = bf2f(ww.z >> 16); q[i * 8 + 6] = bf2f(ww.w & 0xffffu); q[i * 8 + 7] = bf2f(ww.w >> 16); }
#pragma unroll
        for (int i = 0; i < 64; ++i) o[i] = 0.f;
        int r0 = r - 4; r0 = r0 < 0 ? 0 : (r0 > NROWS - 8 ? NROWS - 8 : r0);
        int c0 = w - 8; c0 = c0 < 0 ? 0 : (c0 > GRIDW - 16 ? GRIDW - 16 : c0);
        for (int key = 0; key < 128 + CTX; ++key) {
            size_t krow; float bv = 0.f;
            if (key < 128) { const int i = key >> 4, j = key & 15; krow = (size_t)b * KVL + CTX + (r0 + i) * GRIDW + c0 + j;
                bv = bias[(h * 15 + (r0 + i - r + 7)) * 31 + (c0 + j - w + 15)] * LOG2E; }
            else krow = (size_t)b * KVL + (key - 128);
            const bf16* kp = KB + krow * 512 + h * 64; const bf16* vp = VB + krow * 512 + h * 64;
            float s = bv;
#pragma unroll
            for (int i = 0; i < 8; ++i) { const u32x4 kw = *(const GAS u32x4*)(kp + i * 8);
                s += q[i * 8] * bf2f(kw.x & 0xffffu) + q[i * 8 + 1] * bf2f(kw.x >> 16) + q[i * 8 + 2] * bf2f(kw.y & 0xffffu) + q[i * 8 + 3] * bf2f(kw.y >> 16)
                   + q[i * 8 + 4] * bf2f(kw.z & 0xffffu) + q[i * 8 + 5] * bf2f(kw.z >> 16) + q[i * 8 + 6] * bf2f(kw.w & 0xffffu) + q[i * 8 + 7] * bf2f(kw.w >> 16); }
            if (s > mx) { const float f = exp2f(mx - s); l *= f;
#pragma unroll
                for (int i = 0; i < 64; ++i) o[i] *= f;
                mx = s; }
            const float p = exp2f(s - mx); l += p;
#pragma unroll
            for (int i = 0; i < 8; ++i) { const u32x4 vw = *(const GAS u32x4*)(vp + i * 8);
                o[i * 8] += p * bf2f(vw.x & 0xffffu); o[i * 8 + 1] += p * bf2f(vw.x >> 16); o[i * 8 + 2] += p * bf2f(vw.y & 0xffffu); o[i * 8 + 3] += p * bf2f(vw.y >> 16);
                o[i * 8 + 4] += p * bf2f(vw.z & 0xffffu); o[i * 8 + 5] += p * bf2f(vw.z >> 16); o[i * 8 + 6] += p * bf2f(vw.w & 0xffffu); o[i * 8 + 7] += p * bf2f(vw.w >> 16); }
        }
        const float rl = 1.f / l;
#pragma unroll
        for (int i = 0; i < 8; ++i) { u32x4 ww; ww.x = pk2(o[i * 8] * rl, o[i * 8 + 1] * rl); ww.y = pk2(o[i * 8 + 2] * rl, o[i * 8 + 3] * rl);
            ww.z = pk2(o[i * 8 + 4] * rl, o[i * 8 + 5] * rl); ww.w = pk2(o[i * 8 + 6] * rl, o[i * 8 + 7] * rl); *(GAS u32x4*)(QB + qoff + i * 8) = ww; }
    }
}

__device__ __forceinline__ void p3a_merge(Frame& F) {
    const bf16* OA = (const bf16*)(F.ws + WS_QA); const bf16* OB = (const bf16*)(F.ws + WS_QB);
    const float* Wa = F.in[19]; const float* Wb = F.in[20];
    const bf16* GA = (const bf16*)F.out; const bf16* GB = GA + (size_t)T * D; bf16* Y = (bf16*)(F.ws + WS_Y);
    LAS float* As = (LAS float*)F.lds; LAS float* Bs = As + NG_AS;
    for (int item = F.bid; item < (T / 128) * 16; item += F.G) {
        const int tm = item / 16, tn = item % 16, m0 = tm * 128, n0 = tn * 64;
        float aa[4][4], ab[4][4]; zero_acc(aa); zero_acc(ab);
        gemm_core(aa, As, Bs, 1024, F.tid, [&](int row, int k) { return OA + (size_t)(m0 + row) * D + k; }, [&](int k, int n) { return *(const f32x2*)(Wa + (size_t)k * D + n0 + n); });
        gemm_core(ab, As, Bs, 512, F.tid, [&](int row, int k) { return OB + (size_t)(m0 + row) * 512 + k; }, [&](int k, int n) { return *(const f32x2*)(Wb + (size_t)k * D + n0 + n); });
        const int ty = F.tid >> 4, tx = F.tid & 15;
#pragma unroll
        for (int i = 0; i < 4; ++i) { const size_t off = (size_t)(m0 + ty * 4 + i) * D + n0 + tx * 4;
            const u32x2 ga = *(const GAS u32x2*)(GA + off), gb = *(const GAS u32x2*)(GB + off);
            const float y0 = bf2f(ga.x & 0xffffu) * aa[i][0] + bf2f(gb.x & 0xffffu) * ab[i][0], y1 = bf2f(ga.x >> 16) * aa[i][1] + bf2f(gb.x >> 16) * ab[i][1];
            const float y2 = bf2f(ga.y & 0xffffu) * aa[i][2] + bf2f(gb.y & 0xffffu) * ab[i][2], y3 = bf2f(ga.y >> 16) * aa[i][3] + bf2f(gb.y >> 16) * ab[i][3];
            u32x2 w; w.x = pk2(y0, y1); w.y = pk2(y2, y3); *(GAS u32x2*)(Y + off) = w; }
    }
}
__device__ __forceinline__ void p3b_out(Frame& F) {
    const bf16* Y = (const bf16*)(F.ws + WS_Y); const float* Wo = F.in[21]; const float* x = F.in[0];
    const float* MOD = (const float*)(F.ws + WS_MOD); float* XMID = (float*)(F.ws + WS_XMID);
    LAS float* As = (LAS float*)F.lds; LAS float* Bs = As + NG_AS;
    for (int item = F.bid; item < (T / 128) * 16; item += F.G) {
        const int tm = item / 16, tn = item % 16, m0 = tm * 128, n0 = tn * 64;
        float acc[4][4]; zero_acc(acc);
        gemm_core(acc, As, Bs, 1024, F.tid, [&](int row, int k) { return Y + (size_t)(m0 + row) * D + k; }, [&](int k, int n) { return *(const f32x2*)(Wo + (size_t)k * D + n0 + n); });
        const int ty = F.tid >> 4, tx = F.tid & 15; const int b = m0 / SEQ;
        const f32x4 g = *(const f32x4*)(MOD + b * 6144 + 2048 + n0 + tx * 4);
#pragma unroll
        for (int i = 0; i < 4; ++i) { const size_t off = (size_t)(m0 + ty * 4 + i) * D + n0 + tx * 4; const f32x4 xv = *(const f32x4*)(x + off);
            f32x4 o; o.x = xv.x + g.x * acc[i][0]; o.y = xv.y + g.y * acc[i][1]; o.z = xv.z + g.z * acc[i][2]; o.w = xv.w + g.w * acc[i][3]; *(f32x4*)(XMID + off) = o; }
    }
}

__device__ __forceinline__ void p4a_norm2_route(Frame& F) {
    const float* XMID = (const float*)(F.ws + WS_XMID); const float* nw = F.in[7]; const float* MOD = (const float*)(F.ws + WS_MOD);
    const float* w_rg = F.in[22]; const float* b_rg = F.in[23]; const float* w_re = F.in[24]; const float* b_re = F.in[25];
    bf16* H2 = (bf16*)(F.ws + WS_H2); float* RT = (float*)(F.ws + WS_RT); int* LIST = (int*)(F.ws + WS_LIST);
    LAS float* WG = (LAS float*)F.lds;
    LAS float* WE = WG + 4096;
    for (int i = F.tid; i < 4096; i += NTHR) WG[i] = w_rg[i];
    for (int i = F.tid; i < 4 * 1024 * 8; i += NTHR) WE[i] = w_re[i];
    __syncthreads();
    const int gw = F.bid * 8 + F.wave, NGW = F.G * 8;
    for (int m = gw; m < T; m += NGW) {
        const int b = m / SEQ; f32x4 v[4];
        norm_mod_row(XMID + (size_t)m * D, nw, MOD + b * 6144 + 4096, MOD + b * 6144 + 3072, F.lane, v);
        store_row_bf16(H2 + (size_t)m * D, F.lane, v);
        float lg[4] = {0.f, 0.f, 0.f, 0.f};
#pragma unroll
        for (int j = 0; j < 4; ++j)
#pragma unroll
            for (int e = 0; e < 4; ++e) { const int k = 4 * F.lane + 256 * j + e; const float hv = v[j][e]; const f32x4 w4 = *(const LAS f32x4*)(WG + k * 4);
                lg[0] += hv * w4.x; lg[1] += hv * w4.y; lg[2] += hv * w4.z; lg[3] += hv * w4.w; }
#pragma unroll
        for (int c = 0; c < 4; ++c) lg[c] = wave_sum(lg[c]);
        int g = 0; float gl[4];
#pragma unroll
        for (int c = 0; c < 4; ++c) gl[c] = lg[c] + b_rg[c];
        float gm = gl[0];
#pragma unroll
        for (int c = 1; c < 4; ++c) if (gl[c] > gm) { gm = gl[c]; g = c; }
        float gs = 0.f;
#pragma unroll
        for (int c = 0; c < 4; ++c) gs += expf(gl[c] - gm);
        const float g_w = 1.f / gs;
        g = __builtin_amdgcn_readfirstlane(g);
        float el[8] = {0.f, 0.f, 0.f, 0.f, 0.f, 0.f, 0.f, 0.f};
        { const LAS float* we = WE + g * 8192;
#pragma unroll
          for (int j = 0; j < 4; ++j)
#pragma unroll
              for (int e = 0; e < 4; ++e) { const int k = 4 * F.lane + 256 * j + e; const float hv = v[j][e];
                  const f32x4 wa = *(const LAS f32x4*)(we + k * 8), wb = *(const LAS f32x4*)(we + k * 8 + 4);
                  el[0] += hv * wa.x; el[1] += hv * wa.y; el[2] += hv * wa.z; el[3] += hv * wa.w; el[4] += hv * wb.x; el[5] += hv * wb.y; el[6] += hv * wb.z; el[7] += hv * wb.w; } }
#pragma unroll
        for (int e = 0; e < 8; ++e) el[e] = wave_sum(el[e]) + b_re[g * 8 + e];
        int i0 = 0; float v0 = el[0];
#pragma unroll
        for (int e = 1; e < 8; ++e) if (el[e] > v0) { v0 = el[e]; i0 = e; }
        int i1 = -1; float v1 = -3.0e38f;
#pragma unroll
        for (int e = 0; e < 8; ++e) if (e != i0 && el[e] > v1) { v1 = el[e]; i1 = e; }
        const float e1 = expf(v1 - v0), den = 1.f / (1.f + e1);
        const float w0 = g_w * den, w1 = g_w * e1 * den;
        if (F.lane == 0) {
            const int ge0 = g * 8 + i0, ge1 = 32 + g * 8 + i1;
            const unsigned p0 = atomicAdd((unsigned*)(F.ctl + CW_CNT + 64 * ge0), 1u); const unsigned p1 = atomicAdd((unsigned*)(F.ctl + CW_CNT + 64 * ge1), 1u);
            LIST[(size_t)ge0 * T + p0] = m; LIST[(size_t)ge1 * T + p1] = m;
            RT[(size_t)m * 4 + 0] = w0; RT[(size_t)m * 4 + 1] = w1;
        }
    }
}

struct GroupTab { LAS int* cnt; LAS int* tpre; LAS int* sbase; };
__device__ __forceinline__ GroupTab load_groups(Frame& F, int lds_off) {
    GroupTab G; G.cnt = (LAS int*)(F.lds + lds_off); G.tpre = G.cnt + 64; G.sbase = G.tpre + 65;
    __syncthreads();
    if (F.tid < 64) G.cnt[F.tid] = (int)__hip_atomic_load(F.ctl + CW_CNT + 64 * F.tid, __ATOMIC_RELAXED, __HIP_MEMORY_SCOPE_AGENT);
    __syncthreads();
    if (F.tid == 0) { int tp = 0, sb = 0; for (int g = 0; g < 64; ++g) { G.tpre[g] = tp; G.sbase[g] = sb; tp += (G.cnt[g] + 127) / 128; sb += (G.cnt[g] + 255) / 256 * 256; } G.tpre[64] = tp; }
    __syncthreads();
    return G;
}
__device__ __forceinline__ void p4b_gateup(Frame& F) {
    const bf16* H2 = (const bf16*)(F.ws + WS_H2); const int* LIST = (const int*)(F.ws + WS_LIST); bf16* HID = (bf16*)(F.ws + WS_HID);
    const float* Wg = F.in[26]; const float* Wu = F.in[27];
    LAS float* As = (LAS float*)F.lds; LAS float* Bs = As + NG_AS;
    const GroupTab G = load_groups(F, (NG_AS + NG_BS) * 4);
    const int ntiles = G.tpre[64];
    for (int item = F.bid; item < ntiles * 8; item += F.G) {
        const int tile = item / 8, tn = item % 8; int g = 0; while (G.tpre[g + 1] <= tile) ++g;
        const int r0 = (tile - G.tpre[g]) * 128, cnt = G.cnt[g], e = g & 31, n0 = tn * 64;
        const int* lst = LIST + (size_t)g * T;
        float ag[4][4], au[4][4]; zero_acc(ag); zero_acc(au);
        auto af = [&](int row, int k) { const int i = r0 + row; const int tok = i < cnt ? lst[i] : lst[0]; return H2 + (size_t)tok * D + k; };
        gemm_core(ag, As, Bs, 1024, F.tid, af, [&](int k, int n) { return *(const f32x2*)(Wg + ((size_t)e * 1024 + k) * EH + n0 + n); });
        gemm_core(au, As, Bs, 1024, F.tid, af, [&](int k, int n) { return *(const f32x2*)(Wu + ((size_t)e * 1024 + k) * EH + n0 + n); });
        const int ty = F.tid >> 4, tx = F.tid & 15;
#pragma unroll
        for (int i = 0; i < 4; ++i) { const int rr = r0 + ty * 4 + i; if (rr < cnt) {
            u32x2 w; w.x = pk2(silu_f(ag[i][0]) * au[i][0], silu_f(ag[i][1]) * au[i][1]); w.y = pk2(silu_f(ag[i][2]) * au[i][2], silu_f(ag[i][3]) * au[i][3]);
            *(GAS u32x2*)(HID + (size_t)(G.sbase[g] + rr) * EH + n0 + tx * 4) = w; } }
    }
}
__device__ __forceinline__ void p4c_down(Frame& F, int kk) {
    const bf16* HID = (const bf16*)(F.ws + WS_HID); const int* LIST = (const int*)(F.ws + WS_LIST); const float* RT = (const float*)(F.ws + WS_RT);
    const float* Wd = F.in[28]; const float* XMID = (const float*)(F.ws + WS_XMID); const float* MOD = (const float*)(F.ws + WS_MOD);
    LAS float* As = (LAS float*)F.lds; LAS float* Bs = As + NG_AS;
    const GroupTab G = load_groups(F, (NG_AS + NG_BS) * 4);
    const int t_lo = G.tpre[kk * 32], t_hi = G.tpre[kk * 32 + 32];
    for (int item = F.bid; item < (t_hi - t_lo) * 16; item += F.G) {
        const int tile = t_lo + item / 16, tn = item % 16; int g = kk * 32; while (G.tpre[g + 1] <= tile) ++g;
        const int r0 = (tile - G.tpre[g]) * 128, cnt = G.cnt[g], e = g & 31, n0 = tn * 64;
        const int* lst = LIST + (size_t)g * T;
        float acc[4][4]; zero_acc(acc);
        gemm_core(acc, As, Bs, 512, F.tid, [&](int row, int k) { const int i = r0 + row; return HID + (size_t)(G.sbase[g] + (i < cnt ? i : 0)) * EH + k; },
                  [&](int k, int n) { return *(const f32x2*)(Wd + ((size_t)e * EH + k) * D + n0 + n); });
        const int ty = F.tid >> 4, tx = F.tid & 15;
#pragma unroll
        for (int i = 0; i < 4; ++i) { const int rr = r0 + ty * 4 + i; if (rr < cnt) {
            const int tok = lst[rr]; const int b = tok / SEQ; const float w = RT[(size_t)tok * 4 + kk];
            const f32x4 g2 = *(const f32x4*)(MOD + b * 6144 + 5120 + n0 + tx * 4); const size_t off = (size_t)tok * D + n0 + tx * 4;
            const f32x4 base = kk == 0 ? *(const f32x4*)(XMID + off) : *(const f32x4*)(F.out + off);
            f32x4 o; o.x = base.x + g2.x * w * acc[i][0]; o.y = base.y + g2.y * w * acc[i][1]; o.z = base.z + g2.z * w * acc[i][2]; o.w = base.w + g2.w * w * acc[i][3];
            *(f32x4*)(F.out + off) = o; } }
    }
}

constexpr int NPHASE = 11;
__global__ void __launch_bounds__(NTHR, 2) mk_fwd(Args args) {
    extern __shared__ __attribute__((aligned(16))) unsigned char lds[];
    Frame F;
    F.lds = (LAS unsigned char*)lds; F.ws = args.ws; F.ctl = (gu32*)(args.ws + WS_CTL);
    F.tid = threadIdx.x; F.lane = F.tid & 63; F.wave = __builtin_amdgcn_readfirstlane(F.tid >> 6); F.G = gridDim.x; F.bid = blockIdx.x;
#pragma unroll
    for (int i = 0; i < 29; ++i) F.in[i] = args.in[i];
    F.out = args.out;
    volatile LAS unsigned* MISC = (volatile LAS unsigned*)(F.lds + LDS_BYTES - 64);
    if (F.tid < 16) MISC[F.tid] = 0u;
    __syncthreads();
    XcdBarrier bar; bar.bar = (unsigned*)(F.ctl + CW_BAR); bar.x = 0; bar.st = nullptr;
    if (MK_N_LAUNCHES == 1) bar = xcd_barrier_post((unsigned*)(F.ctl + CW_BAR), MISC);
    const int lo = args.ph_lo, hi = args.ph_hi;
#ifndef PH_MASK
#define PH_MASK 0x7ff
#endif
#define IN(k) (((PH_MASK >> (k)) & 1) && lo <= (k) && (k) < hi)
#define SEAM(k) do { if (IN(k) && IN((k) + 1)) xcd_barrier(bar); } while (0)
    if (IN(0)) p0_adaln_rope(F);
    SEAM(0);
    if (IN(1)) p1a_norm1(F);
    SEAM(1);
    if (IN(2)) p1b_inproj(F);
    SEAM(2);
    if (IN(3)) p2a_diffattn(F);
    SEAM(3);
    if (IN(4)) p2b_natten(F);
    SEAM(4);
    if (IN(5)) p3a_merge(F);
    SEAM(5);
    if (IN(6)) p3b_out(F);
    SEAM(6);
    if (IN(7)) p4a_norm2_route(F);
    SEAM(7);
    if (IN(8)) p4b_gateup(F);
    SEAM(8);
    if (IN(9)) p4c_down(F, 0);
    SEAM(9);
    if (IN(10)) p4c_down(F, 1);
#undef IN
#undef SEAM
}

extern "C" void kernel_launch(void* const* d_in, const int* in_sizes, int n_in, void* d_out, int out_size, void* d_ws, size_t ws_size, hipStream_t stream) {
    static int grid = 0;
    if (grid == 0) {
        if (n_in != 29 || out_size != T * D || ws_size < WS_END) { fprintf(stderr, "kernel_launch: unexpected shapes: n_in %d out %d ws %zu\n", n_in, out_size, ws_size); grid = -1; return; }
        int dev = 0, cus = 0, per_cu = 0;
        if (hipGetDevice(&dev) != hipSuccess || hipDeviceGetAttribute(&cus, hipDeviceAttributeMultiprocessorCount, dev) != hipSuccess) { grid = -1; return; }
        if (hipFuncSetAttribute((const void*)mk_fwd, hipFuncAttributeMaxDynamicSharedMemorySize, LDS_BYTES) != hipSuccess) { fprintf(stderr, "kernel_launch: hipFuncSetAttribute failed\n"); grid = -1; return; }
        if (hipOccupancyMaxActiveBlocksPerMultiprocessor(&per_cu, (const void*)mk_fwd, NTHR, LDS_BYTES) != hipSuccess || per_cu < 1) fprintf(stderr, "kernel_launch: occupancy query says %d\n", per_cu);
        (void)hipGetLastError();
        grid = cus;
    }
    if (grid < 0) return;
    if (hipMemsetAsync((char*)d_ws + WS_CTL, 0, CTL_ZERO_BYTES, stream) != hipSuccess) return;
    Args a{};
    for (int i = 0; i < 29; ++i) a.in[i] = (const float*)d_in[i];
    a.out = (float*)d_out; a.ws = (unsigned char*)d_ws;
    if (MK_N_LAUNCHES == 1) { a.ph_lo = 0; a.ph_hi = NPHASE; hipLaunchKernelGGL(mk_fwd, dim3(grid), dim3(NTHR), LDS_BYTES, stream, a); }
    else for (int p = 0; p < NPHASE; ++p) { a.ph_lo = p; a.ph_hi = p + 1; hipLaunchKernelGGL(mk_fwd, dim3(grid), dim3(NTHR), LDS_BYTES, stream, a); }
}
```

```cpp
#include <hip/hip_runtime.h>
#include <cstdio>
#include <cstdint>

#ifndef MK_N_LAUNCHES
#define MK_N_LAUNCHES 1
#endif

constexpr int NB = 4, SEQ = 8192, D = 1024, T = NB * SEQ, CTX = 256, TC = NB * CTX, MROWS = T + TC;
constexpr int KVL = CTX + SEQ;
constexpr int NIN = 6656, GRIDW = 64, NROWS = SEQ / GRIDW;
constexpr int NH = 8, HD = 64;
constexpr int NEXP = 32, EH = 512, NGRP = 4, EPG = 8;
constexpr int NLIST = 64;
constexpr float EPS = 1e-6f;
constexpr float LOG2E = 1.4426950408889634f;
constexpr float C2 = 0.125f * LOG2E;

constexpr size_t MiB = 1u << 20;
constexpr size_t WS_CTL = 0, CTL_ZERO_BYTES = 1 * MiB;
constexpr size_t WS_MOD = 1 * MiB;
constexpr size_t WS_ROPE = 1 * MiB + 256 * 1024;
constexpr size_t WS_RT = 2 * MiB;
constexpr size_t WS_LIST = 4 * MiB;
constexpr size_t WS_WIN = 12 * MiB;
constexpr size_t WS_WA = 25 * MiB, WS_WB = 27 * MiB, WS_WO = 28 * MiB;
constexpr size_t WS_WGU = 30 * MiB;
constexpr size_t WS_WD = 94 * MiB;
constexpr size_t WS_XN = 126 * MiB;
constexpr size_t WS_QA = 192 * MiB;
constexpr size_t WS_QB = 256 * MiB;
constexpr size_t WS_KA = 288 * MiB;
constexpr size_t WS_VA = 354 * MiB;
constexpr size_t WS_KB = 420 * MiB;
constexpr size_t WS_VB = 453 * MiB;
constexpr size_t WS_END = 486 * MiB;
constexpr size_t WS_Y = WS_XN, WS_H2 = WS_XN, WS_HID = WS_QA, WS_XMID = WS_KA;
constexpr int CW_TMO = 0, CW_BAR = 4096, CW_CNT = 16384;

constexpr int LDS_BYTES = 155648;
constexpr int NTHR = 512;

#define GAS __attribute__((address_space(1)))
#define LAS __attribute__((address_space(3)))
typedef unsigned short bf16;
typedef float f32x4 __attribute__((ext_vector_type(4)));
typedef float f32x2 __attribute__((ext_vector_type(2)));
typedef unsigned u32x4 __attribute__((ext_vector_type(4)));
typedef unsigned u32x2 __attribute__((ext_vector_type(2)));
typedef GAS unsigned gu32;

__device__ __forceinline__ unsigned f2bf(float f) { unsigned u = __builtin_bit_cast(unsigned, f); return (u + 0x7fffu + ((u >> 16) & 1u)) >> 16; }
__device__ __forceinline__ float bf2f(unsigned h) { return __builtin_bit_cast(float, h << 16); }
__device__ __forceinline__ float rbf(float f) { return bf2f(f2bf(f)); }
__device__ __forceinline__ unsigned pk2(float lo, float hi) { return f2bf(lo) | (f2bf(hi) << 16); }

#define XB_TMO      128
#define XB_XCNT(j)  (256  + 64 * (j))
#define XB_XSUB(j)  (1280 + 64 * (j))
#define XB_XGEN(j)  (2304 + 64 * (j))
#define XB_TOP      3328
#define XB_TOPGEN   3392
#define XCD_BAR_WORDS 3456
#define XB_SPIN_CAP (1u << 18)
__device__ __forceinline__ unsigned xb_ld(unsigned* p)              { return __hip_atomic_load(p, __ATOMIC_RELAXED, __HIP_MEMORY_SCOPE_AGENT); }
__device__ __forceinline__ unsigned xb_add(unsigned* p, unsigned v) { return __hip_atomic_fetch_add(p, v, __ATOMIC_RELAXED, __HIP_MEMORY_SCOPE_AGENT); }
__device__ __forceinline__ unsigned xb_xcc_id() { return (unsigned)__builtin_amdgcn_s_getreg((3 << 11) | 20) & 0xFu; }
#define XB_SPIN(cond, bar) do { unsigned _sp = 0; while (cond) { __builtin_amdgcn_s_sleep(1); \
    if ((++_sp & 255u) == 0u) { if (xb_ld(&(bar)[XB_TMO])) break; if (_sp > XB_SPIN_CAP) { atomicAdd(&(bar)[XB_TMO], 1u); break; } } } } while (0)
struct XcdBarrier { unsigned* bar; unsigned x; volatile LAS unsigned* st; };
__device__ __forceinline__ XcdBarrier xcd_barrier_post(unsigned* bar, volatile LAS unsigned* st) {
    XcdBarrier b; b.bar = bar; b.x = xb_xcc_id(); b.st = st;
    if (threadIdx.x == 0) (void)xb_add(&bar[XB_XCNT(b.x)], 1u);
    return b;
}
__device__ __forceinline__ void xcd_barrier_complete(unsigned* bar, unsigned x, unsigned& nloc, unsigned& nx) {
    const unsigned G = gridDim.x * gridDim.y * gridDim.z;
    unsigned sum, cnt, mine, sp = 0u;
    for (;;) {
        sum = 0u; cnt = 0u; mine = 0u;
#pragma unroll
        for (unsigned j = 0; j < 16; ++j) { const unsigned c = xb_ld(&bar[XB_XCNT(j)]); sum += c; cnt += (c > 0u) ? 1u : 0u; mine = (j == x) ? c : mine; }
        if (sum == G) break;
        __builtin_amdgcn_s_sleep(1);
        if ((++sp & 255u) == 0u) { if (xb_ld(&bar[XB_TMO])) break; if (sp > XB_SPIN_CAP) { atomicAdd(&bar[XB_TMO], 1u); break; } }
    }
    nloc = mine > 0u ? mine : 1u; nx = cnt > 0u ? cnt : 1u;
}
__device__ __forceinline__ void xcd_barrier(const XcdBarrier& b) {
    asm volatile("s_waitcnt vmcnt(0)" ::: "memory");
    __syncthreads();
    if (threadIdx.x == 0) {
        unsigned* bar = b.bar;
        __builtin_amdgcn_s_waitcnt(0);
        unsigned nloc = b.st[0], nx = b.st[1];
        if (nloc == 0u) { xcd_barrier_complete(bar, b.x, nloc, nx); b.st[0] = nloc; b.st[1] = nx; }
        const unsigned old = xb_add(&bar[XB_XSUB(b.x)], 1u);
        const unsigned gen = old / nloc;
        if (old + 1u == (gen + 1u) * nloc) {
            __builtin_amdgcn_fence(__ATOMIC_RELEASE, "agent");
            asm volatile("s_waitcnt vmcnt(0)" ::: "memory");
            const unsigned og = xb_add(&bar[XB_TOP], 1u);
            const unsigned tg = og / nx;
            if (og + 1u == (tg + 1u) * nx) xb_add(&bar[XB_TOPGEN], 1u);
            else XB_SPIN(xb_ld(&bar[XB_TOPGEN]) == tg, bar);
            __builtin_amdgcn_fence(__ATOMIC_ACQUIRE, "agent");
            xb_add(&bar[XB_XGEN(b.x)], 1u);
            asm volatile("s_waitcnt vmcnt(0)" ::: "memory");
        } else {
            XB_SPIN(xb_ld(&bar[XB_XGEN(b.x)]) == gen, bar);
            __builtin_amdgcn_fence(__ATOMIC_ACQUIRE, "agent");
            asm volatile("s_waitcnt vmcnt(0)" ::: "memory");
        }
    }
    __syncthreads();
}

namespace pg8 {
#define PG8_LAS __attribute__((address_space(3)))
typedef unsigned short bf16_t;
typedef short bf16x8 __attribute__((ext_vector_type(8)));
constexpr int BM = 256, BK = 64, HALF = 128, HTB = HALF * BK * 2, STAGE_BYTES = 8 * HTB, NXCD = 8, WGM = 8;
__host__ __device__ __forceinline__ int lds_byte(int r, int c) { const int st = (r >> 4) * 2 + (c >> 5), rr = r & 15, cc = c & 31, ob = rr * 64 + cc * 2; return st * 1024 + (ob ^ (((ob >> 9) & 1) << 5)); }
__host__ __device__ __forceinline__ void stage_rc(int b, int& R, int& C) { const int st = b / 1024, sb = b % 1024, swz = sb ^ (((sb >> 9) & 1) << 5); R = (st >> 1) * 16 + swz / 64; C = (st & 1) * 32 + (swz % 64) / 2; }
__host__ __device__ __forceinline__ int perm32(int rho) { const int n = rho >> 4, i = rho & 15; return 8 * (i >> 2) + 4 * n + (i & 3); }
struct Unit { int pm, pn, a0, a1; };
struct Gemm { const bf16_t* A; const bf16_t* Bt; int lda, ldb, K; };
__device__ __forceinline__ unsigned cvt_pk_bf16(float lo, float hi) { unsigned r; asm volatile("v_cvt_pk_bf16_f32 %0, %1, %2" : "=v"(r) : "v"(lo), "v"(hi)); return r; }

struct DenseOrder {
    int nM, nN, nwg, G, c, ldb;
    __device__ void init(int M, int N, int G_, int c_, int ldb_) { nM = M / BM; nN = N / BM; nwg = nM * nN; G = G_; c = c_; ldb = ldb_; }
    __device__ __forceinline__ bool map(long L, Unit& u) const {
        if (L >= nwg) return false;
        int wgid = (int)L; { const int q = nwg / NXCD, r = nwg % NXCD, xcd = wgid % NXCD, off = wgid / NXCD; wgid = (xcd < r ? xcd * (q + 1) : r * (q + 1) + (xcd - r) * q) + off; }
        const int nig = WGM * nN, gid = wgid / nig, fm = gid * WGM, gsz = (nM - fm) < WGM ? (nM - fm) : WGM;
        u.pm = fm + ((wgid % nig) % gsz); u.pn = (wgid % nig) / gsz; u.a0 = 0; u.a1 = 0; return true;
    }
    __device__ __forceinline__ bool next(int i, Unit& u) const { return map((long)i * G + c, u); }
    __device__ __forceinline__ int arow(const Unit& u, int r) const { return u.pm * BM + r; }
    __device__ __forceinline__ size_t boff(const Unit& u) const { return (size_t)u.pn * BM * ldb; }
};

template <class Epi, class Sched>
__device__ __forceinline__ void gemm_phase(PG8_LAS unsigned char* lds, const Gemm g, const Sched& S, const Epi& E) {
    const int tid = threadIdx.x, wid = __builtin_amdgcn_readfirstlane(tid >> 6), lane = tid & 63, wr = wid >> 2, wc = wid & 3, fr = lane & 15, fq = lane >> 4;
    const int nt = g.K / BK;
    int RA[2], CA[2]; unsigned voffB[2];
#pragma unroll
    for (int i = 0; i < 2; ++i) { int R, C; stage_rc(tid * 16 + i * 8192, R, C); const int Rb = Epi::PERM ? ((R & ~31) + perm32(R & 31)) : R;
        RA[i] = R; CA[i] = C * 2; voffB[i] = (unsigned)(Rb * g.ldb + C) * 2u; }
    const size_t kstep = (size_t)(BK * 2);
    const size_t hstepB = (size_t)HALF * g.ldb * 2;
    const unsigned ldsw = (unsigned)wid * 1024u;
    const int aoff = lds_byte(wr * 64 + fr, fq * 8), boff = lds_byte(wc * 32 + fr, fq * 8);
#define PG8_SA(b, h) (((b) * 2 + (h)) * HTB)
#define PG8_SB(b, h) ((4 + (b) * 2 + (h)) * HTB)
#define PG8_STAGE(bufoff, gbase, voff) do { _Pragma("unroll") for (int _i = 0; _i < 2; ++_i) \
        __builtin_amdgcn_global_load_lds((const unsigned*)((const char*)(gbase) + (voff)[_i]), (PG8_LAS unsigned*)(lds + (bufoff) + ldsw + _i * 8192), 16, 0, 0); } while (0)
#define PG8_LDA(dst, b, h) do { _Pragma("unroll") for (int m = 0; m < 4; ++m) _Pragma("unroll") for (int k = 0; k < 2; ++k) dst[m][k] = *(const PG8_LAS bf16x8*)(lds + PG8_SA(b, h) + aoff + m * 2048 + k * 1024); } while (0)
#define PG8_LDB(dst, b, h) do { _Pragma("unroll") for (int n = 0; n < 2; ++n) _Pragma("unroll") for (int k = 0; k < 2; ++k) dst[n][k] = *(const PG8_LAS bf16x8*)(lds + PG8_SB(b, h) + boff + n * 2048 + k * 1024); } while (0)
#define PG8_MMA(ai, bj, At, Bt) do { __builtin_amdgcn_s_setprio(1); _Pragma("unroll") for (int m = 0; m < 4; ++m) _Pragma("unroll") for (int n = 0; n < 2; ++n) _Pragma("unroll") for (int k = 0; k < 2; ++k) \
        acc[ai][bj][m][n] = __builtin_amdgcn_mfma_f32_16x16x32_bf16(Bt[n][k], At[m][k], acc[ai][bj][m][n], 0, 0, 0); __builtin_amdgcn_s_setprio(0); } while (0)
#define PG8_WAIT_V(n) asm volatile("s_waitcnt vmcnt(" #n ")" ::: "memory")
#define PG8_WAIT_L(n) asm volatile("s_waitcnt lgkmcnt(" #n ")" ::: "memory")
#define PG8_BAR __builtin_amdgcn_s_barrier()
#define PG8_SCHED __builtin_amdgcn_sched_barrier(0)
#define PG8_AOFFS(dst, u) do { _Pragma("unroll") for (int _h = 0; _h < 2; ++_h) _Pragma("unroll") for (int _i = 0; _i < 2; ++_i) \
        dst[_h][_i] = (unsigned)S.arow(u, _h * HALF + RA[_i]) * (unsigned)(g.lda * 2) + (unsigned)CA[_i]; } while (0)
    Unit cur, nxt; int ui = 0;
    if (!S.next(0, cur)) return;
    f32x4 acc[2][2][4][2];
#pragma unroll
    for (int a = 0; a < 2; ++a)
#pragma unroll
        for (int b = 0; b < 2; ++b)
#pragma unroll
            for (int m = 0; m < 4; ++m)
#pragma unroll
                for (int n = 0; n < 2; ++n) acc[a][b][m][n] = (f32x4){0.f, 0.f, 0.f, 0.f};
    bf16x8 At[4][2], B0[2][2], B1[2][2];
    unsigned oc[2][2], on[2][2];
    PG8_AOFFS(oc, cur);
    const char* gA = (const char*)g.A;
    const char* cB = (const char*)g.Bt + S.boff(cur) * 2;
    PG8_STAGE(PG8_SB(0, 0), cB, voffB); PG8_STAGE(PG8_SB(0, 1), cB + hstepB, voffB); PG8_STAGE(PG8_SA(0, 0), gA, oc[0]); PG8_STAGE(PG8_SA(0, 1), gA, oc[1]);
    if (wr == 1) PG8_BAR;
    PG8_WAIT_V(2); PG8_BAR;
    PG8_STAGE(PG8_SB(1, 0), cB + kstep, voffB); PG8_STAGE(PG8_SA(1, 0), gA + kstep, oc[0]); PG8_STAGE(PG8_SB(1, 1), cB + hstepB + kstep, voffB);
    PG8_WAIT_V(6); PG8_BAR;
    for (;;) {
        const bool has_next = S.next(ui + 1, nxt);
        if (has_next) { PG8_AOFFS(on, nxt); } else {
#pragma unroll
            for (int _h = 0; _h < 2; ++_h)
#pragma unroll
                for (int _i = 0; _i < 2; ++_i) on[_h][_i] = oc[_h][_i]; }
        const char* nB = has_next ? (const char*)g.Bt + S.boff(nxt) * 2 : cB;
        for (int t = 0; t < nt; t += 2) {
            const bool last = (t == nt - 2);
            const char* a1 = gA + (size_t)(t + 1) * kstep;
            const char* a2 = last ? gA : gA + (size_t)(t + 2) * kstep; const char* b2 = last ? nB : cB + (size_t)(t + 2) * kstep;
            const char* a3 = a2 + kstep; const char* b3 = b2 + kstep;
            unsigned os[2][2];
#pragma unroll
            for (int _h = 0; _h < 2; ++_h)
#pragma unroll
                for (int _i = 0; _i < 2; ++_i) os[_h][_i] = last ? on[_h][_i] : oc[_h][_i];
            PG8_LDB(B0, 0, 0); PG8_LDB(B1, 0, 1); PG8_SCHED; PG8_LDA(At, 0, 0); PG8_STAGE(PG8_SA(1, 1), a1, oc[1]);
            PG8_WAIT_V(8); PG8_WAIT_L(0); PG8_BAR; PG8_MMA(0, 0, At, B0); PG8_MMA(0, 1, At, B1); PG8_BAR; PG8_SCHED;
            PG8_LDA(At, 0, 1); PG8_STAGE(PG8_SB(0, 0), b2, voffB); PG8_STAGE(PG8_SB(0, 1), b2 + hstepB, voffB); PG8_STAGE(PG8_SA(0, 0), a2, os[0]);
            PG8_WAIT_V(8); PG8_WAIT_L(0); PG8_BAR; PG8_MMA(1, 0, At, B0); PG8_MMA(1, 1, At, B1); PG8_BAR; PG8_SCHED;
            PG8_LDB(B0, 1, 0); PG8_LDB(B1, 1, 1); PG8_SCHED; PG8_LDA(At, 1, 0); PG8_STAGE(PG8_SA(0, 1), a2, os[1]);
            PG8_WAIT_V(8); PG8_WAIT_L(0); PG8_BAR; PG8_MMA(0, 0, At, B0); PG8_MMA(0, 1, At, B1); PG8_BAR; PG8_SCHED;
            PG8_LDA(At, 1, 1); PG8_STAGE(PG8_SB(1, 0), b3, voffB); PG8_STAGE(PG8_SB(1, 1), b3 + hstepB, voffB); PG8_STAGE(PG8_SA(1, 0), a3, os[0]);
            PG8_WAIT_V(8); PG8_WAIT_L(0); PG8_BAR; PG8_MMA(1, 0, At, B0); PG8_MMA(1, 1, At, B1); PG8_BAR; PG8_SCHED;
        }
        if (wr == 0) PG8_BAR;
        E(acc, cur, wr, wc, fr, fq);
        if (!has_next) break;
#pragma unroll
        for (int a = 0; a < 2; ++a)
#pragma unroll
            for (int b = 0; b < 2; ++b)
#pragma unroll
                for (int m = 0; m < 4; ++m)
#pragma unroll
                    for (int n = 0; n < 2; ++n) acc[a][b][m][n] = (f32x4){0.f, 0.f, 0.f, 0.f};
        cur = nxt; cB = nB; ++ui;
#pragma unroll
        for (int _h = 0; _h < 2; ++_h)
#pragma unroll
            for (int _i = 0; _i < 2; ++_i) oc[_h][_i] = on[_h][_i];
        if (wr == 1) PG8_BAR;
    }
    PG8_WAIT_V(0);
    PG8_BAR;
#undef PG8_SA
#undef PG8_SB
#undef PG8_STAGE
#undef PG8_LDA
#undef PG8_LDB
#undef PG8_MMA
#undef PG8_WAIT_V
#undef PG8_WAIT_L
#undef PG8_BAR
#undef PG8_SCHED
#undef PG8_AOFFS
}
}

struct Args { const float* in[29]; float* out; unsigned char* ws; int ph_lo, ph_hi; };
struct Frame {
    LAS unsigned char* lds;
    unsigned char* ws; gu32* ctl;
    int tid, lane, wave, G, bid;
    const float* in[29];
    float* out;
};
__device__ __forceinline__ float wave_sum(float v) {
#pragma unroll
    for (int o = 1; o < 64; o <<= 1) v += __shfl_xor(v, o);
    return v;
}
__device__ __forceinline__ float silu_f(float v) { return v / (1.f + __expf(-v)); }
__device__ __forceinline__ float sigmoid_f(float v) { return 1.f / (1.f + __expf(-v)); }

__constant__ float INV_FREQ[16] = {1.0f, 0.5623413324356079f, 0.3162277638912201f, 0.17782793939113617f, 0.10000000149011612f, 0.05623413249850273f, 0.03162277489900589f, 0.017782794311642647f,
    0.009999999776482582f, 0.005623413249850273f, 0.003162277629598975f, 0.0017782794311642647f, 0.0010000000474974513f, 0.000562341301701963f, 0.0003162277571391314f, 0.00017782794020604342f};
__device__ __forceinline__ double sin_poly(double r) { double r2 = r * r, t = r, s = r; for (int i = 1; i <= 12; ++i) { t *= -r2 / (double)((2 * i) * (2 * i + 1)); s += t; } return s; }
__device__ __forceinline__ double cos_poly(double r) { double r2 = r * r, t = 1.0, s = 1.0; for (int i = 1; i <= 12; ++i) { t *= -r2 / (double)((2 * i - 1) * (2 * i)); s += t; } return s; }
__device__ __forceinline__ void p0_adaln_rope(Frame& F) {
    const float* c = F.in[1]; const float* c_ctx = F.in[3]; const float* w_ada = F.in[4]; const float* b_ada = F.in[5];
    float* MOD = (float*)(F.ws + WS_MOD);
    { float* RP = (float*)(F.ws + WS_ROPE);
      const int gi = F.bid * NTHR + F.tid;
      if (gi < 192 * 16) { const int pos = gi >> 4, f = gi & 15; const int p = pos < 128 ? pos : pos - 128;
          const float invf = INV_FREQ[f]; const float ang = (float)p * invf;
          const double a = (double)ang; const double k = rint(a * 0.15915494309189535); const double r = a - k * 6.283185307179586477;
          const float cs = (float)cos_poly(r), sn = (float)sin_poly(r);
          if (pos < 128) { RP[pos * 16 + f] = cs; RP[2048 + pos * 16 + f] = sn; } else { RP[4096 + p * 16 + f] = cs; RP[4096 + 1024 + p * 16 + f] = sn; } } }
    if (F.bid < 96) {
        LAS float* S = (LAS float*)F.lds;
        LAS float* R = S + 5 * 1024;
        for (int i = F.tid; i < 5 * 1024; i += NTHR) { const int r = i >> 10, k = i & 1023; const float v = r < 4 ? c[r * 1024 + k] : c_ctx[k]; S[i] = silu_f(v); }
        __syncthreads();
        for (int item = F.bid; item < 96; item += F.G) {
            const int c0 = item * 64; float acc[5] = {0.f, 0.f, 0.f, 0.f, 0.f};
            for (int kk = 0; kk < 128; ++kk) { const int k = F.wave * 128 + kk; const float w = w_ada[(size_t)k * 6144 + c0 + F.lane];
#pragma unroll
                for (int r = 0; r < 5; ++r) acc[r] += S[r * 1024 + k] * w; }
#pragma unroll
            for (int r = 0; r < 5; ++r) R[(F.wave * 5 + r) * 64 + F.lane] = acc[r];
            __syncthreads();
            if (F.tid < 320) { const int r = F.tid >> 6, l = F.tid & 63; float s = 0.f;
#pragma unroll
                for (int w = 0; w < 8; ++w) s += R[(w * 5 + r) * 64 + l];
                MOD[r * 6144 + c0 + l] = s + b_ada[c0 + l]; }
            __syncthreads();
        }
    }
}

__device__ __forceinline__ void norm_mod_row(const float* xrow, const float* nw, const float* scale, const float* shift, int lane, f32x4 (&v)[4]) {
    const GAS f32x4* xr = (const GAS f32x4*)xrow + lane; float ss = 0.f;
#pragma unroll
    for (int j = 0; j < 4; ++j) { v[j] = xr[64 * j]; ss += (v[j].x * v[j].x + v[j].y * v[j].y) + (v[j].z * v[j].z + v[j].w * v[j].w); }
    const float rstd = 1.0f / sqrtf(wave_sum(ss) * (1.f / D) + EPS);
#pragma unroll
    for (int j = 0; j < 4; ++j) { const int d0 = 4 * lane + 256 * j; const f32x4 w = *(const f32x4*)(nw + d0), sc = *(const f32x4*)(scale + d0), sh = *(const f32x4*)(shift + d0);
        v[j] = (v[j] * rstd * w) * (1.f + sc) + sh; }
}
__device__ __forceinline__ void store_row_bf16(bf16* orow, int lane, const f32x4 (&v)[4]) {
    GAS u32x2* o8 = (GAS u32x2*)orow + lane;
#pragma unroll
    for (int j = 0; j < 4; ++j) { u32x2 w; w.x = pk2(v[j].x, v[j].y); w.y = pk2(v[j].z, v[j].w); o8[64 * j] = w; }
}
__device__ __forceinline__ void p1a_norm1(Frame& F) {
    const float* x = F.in[0]; const float* ctx = F.in[2]; const float* nw = F.in[6];
    const float* MOD = (const float*)(F.ws + WS_MOD); bf16* XN = (bf16*)(F.ws + WS_XN);
    const int gw = F.bid * 8 + F.wave, NGW = F.G * 8;
    for (int m = gw; m < MROWS; m += NGW) {
        const float* row; int mr;
        if (m < T) { row = x + (size_t)m * D; mr = m / SEQ; } else { row = ctx + (size_t)(m - T) * D; mr = 4; }
        f32x4 v[4]; norm_mod_row(row, nw, MOD + mr * 6144 + 1024, MOD + mr * 6144, F.lane, v);
        store_row_bf16(XN + (size_t)m * D, F.lane, v);
    }
}

constexpr int NG_AS = 16 * 132, NG_BS = 16 * 68;
template <class AF, class BF>
__device__ __forceinline__ void gemm_core(float (&acc)[4][4], LAS float* As, LAS float* Bs, int K, int tid, const AF& af, const BF& bf) {
    const int ty = tid >> 4, tx = tid & 15;
    const int ar = tid >> 2, ak = (tid & 3) * 4;
    const int bk = tid >> 5, bn = (tid & 31) * 2;
    for (int k0 = 0; k0 < K; k0 += 16) {
        const u32x2 av = *(const GAS u32x2*)af(ar, k0 + ak);
        const f32x2 bv = bf(k0 + bk, bn);
        __syncthreads();
        As[(ak + 0) * 132 + ar] = bf2f(av.x & 0xffffu); As[(ak + 1) * 132 + ar] = bf2f(av.x >> 16);
        As[(ak + 2) * 132 + ar] = bf2f(av.y & 0xffffu); As[(ak + 3) * 132 + ar] = bf2f(av.y >> 16);
        Bs[bk * 68 + bn] = rbf(bv.x); Bs[bk * 68 + bn + 1] = rbf(bv.y);
        __syncthreads();
#pragma unroll
        for (int kk = 0; kk < 16; ++kk) {
            const f32x4 a = *(const LAS f32x4*)(As + kk * 132 + ty * 4), b = *(const LAS f32x4*)(Bs + kk * 68 + tx * 4);
#pragma unroll
            for (int i = 0; i < 4; ++i)
#pragma unroll
                for (int j = 0; j < 4; ++j) acc[i][j] += a[i] * b[j];
        }
    }
    __syncthreads();
}
__device__ __forceinline__ void zero_acc(float (&acc)[4][4]) {
#pragma unroll
    for (int i = 0; i < 4; ++i)
#pragma unroll
        for (int j = 0; j < 4; ++j) acc[i][j] = 0.f;
}

__device__ __forceinline__ int kv_row(int m) { if (m < T) { const int b = m / SEQ, t = m - b * SEQ; return b * KVL + CTX + t; } const int cm = m - T, b = cm / CTX, c = cm - b * CTX; return b * KVL + c; }

__device__ __forceinline__ void p1b_inproj(Frame& F) {
    const float* w_in = F.in[8];
    const bf16* XN = (const bf16*)(F.ws + WS_XN);
    LAS float* As = (LAS float*)F.lds; LAS float* Bs = As + NG_AS; LAS float* Ct = Bs + NG_BS;
    const float* RP = (const float*)(F.ws + WS_ROPE);
    bf16* QA = (bf16*)(F.ws + WS_QA); bf16* KA = (bf16*)(F.ws + WS_KA); bf16* VA = (bf16*)(F.ws + WS_VA);
    bf16* QB = (bf16*)(F.ws + WS_QB); bf16* KB = (bf16*)(F.ws + WS_KB); bf16* VB = (bf16*)(F.ws + WS_VB);
    bf16* GA = (bf16*)F.out; bf16* GB = GA + (size_t)T * D;
    constexpr int NT_LAT = (T / 128) * 104, NT_CTX = (TC / 128) * 48;
    for (int item = F.bid; item < NT_LAT + NT_CTX; item += F.G) {
        int tm, cg;
        if (item < NT_LAT) { tm = item / 104; cg = item % 104; }
        else { const int r = item - NT_LAT; tm = T / 128 + r / 48; const int c = r % 48; cg = c < 32 ? 16 + c : 56 + (c - 32); }
        const int m0 = tm * 128, n0 = cg * 64;
        float acc[4][4]; zero_acc(acc);
        gemm_core(acc, As, Bs, D, F.tid,
                  [&](int row, int k) { return XN + (size_t)(m0 + row) * D + k; },
                  [&](int k, int n) { return *(const f32x2*)(w_in + (size_t)k * NIN + n0 + n); });
        { const int ty = F.tid >> 4, tx = F.tid & 15;
#pragma unroll
          for (int i = 0; i < 4; ++i)
#pragma unroll
              for (int j = 0; j < 4; ++j) Ct[(ty * 4 + i) * 65 + tx * 4 + j] = acc[i][j]; }
        __syncthreads();
        const int row = F.tid >> 2, q4 = F.tid & 3, m = m0 + row; const LAS float* cr = Ct + row * 65;
        float v[16];
#pragma unroll
        for (int i = 0; i < 16; ++i) v[i] = cr[q4 * 16 + i];
        int kind; const float* gain = nullptr; bf16* dst; bool rope = false; float oscale = 1.f;
        if (cg < 16)      { kind = 0; gain = F.in[9];  dst = QA + (size_t)m * D + cg * 64; rope = true; oscale = C2; }
        else if (cg < 32) { kind = 0; gain = F.in[10]; dst = KA + (size_t)kv_row(m) * D + (cg - 16) * 64; rope = (m < T); }
        else if (cg < 48) { kind = 1; dst = VA + (size_t)kv_row(m) * D + (cg - 32) * 64; }
        else if (cg < 56) { kind = 0; gain = F.in[16]; dst = QB + (size_t)m * 512 + (cg - 48) * 64; oscale = C2; }
        else if (cg < 64) { kind = 0; gain = F.in[17]; dst = KB + (size_t)kv_row(m) * 512 + (cg - 56) * 64; }
        else if (cg < 72) { kind = 1; dst = VB + (size_t)kv_row(m) * 512 + (cg - 64) * 64; }
        else if (cg < 88) { kind = 2; dst = GA + (size_t)m * D + (cg - 72) * 64; }
        else              { kind = 2; dst = GB + (size_t)m * D + (cg - 88) * 64; }
        if (kind == 0) {
            float ss = 0.f;
#pragma unroll
            for (int i = 0; i < 16; ++i) ss += v[i] * v[i];
            ss += __shfl_xor(ss, 1); ss += __shfl_xor(ss, 2);
            const float rstd = 1.0f / sqrtf(ss * (1.f / 64.f) + EPS);
#pragma unroll
            for (int i = 0; i < 16; ++i) v[i] = v[i] * rstd * gain[q4 * 16 + i];
            if (rope) {
                const int t = m % SEQ, pr = t / GRIDW, pc = t % GRIDW;
                const float* cs = (q4 < 2) ? RP + pr * 16 : RP + 4096 + pc * 16;
                const float* sn = (q4 < 2) ? RP + 2048 + pr * 16 : RP + 4096 + 1024 + pc * 16;
#pragma unroll
                for (int i = 0; i < 16; ++i) { const float o = __shfl_xor(v[i], 1);
                    v[i] = (q4 & 1) ? (o * sn[i] + v[i] * cs[i]) : (v[i] * cs[i] - o * sn[i]); }
            }
#pragma unroll
            for (int i = 0; i < 16; ++i) v[i] *= oscale;
        } else if (kind == 2) {
#pragma unroll
            for (int i = 0; i < 16; ++i) v[i] = sigmoid_f(v[i]);
        }
        const bool skip = (m >= T) && (cg < 16 || (cg >= 48 && cg < 56) || cg >= 72);
        if (!skip) { u32x4 w0, w1; w0.x = pk2(v[0], v[1]); w0.y = pk2(v[2], v[3]); w0.z = pk2(v[4], v[5]); w0.w = pk2(v[6], v[7]);
            w1.x = pk2(v[8], v[9]); w1.y = pk2(v[10], v[11]); w1.z = pk2(v[12], v[13]); w1.w = pk2(v[14], v[15]);
            *(GAS u32x4*)(dst + q4 * 16) = w0; *(GAS u32x4*)(dst + q4 * 16 + 8) = w1; }
        __syncthreads();
    }
}


__device__ __forceinline__ void p0_transpose_item(const float* W, int K, int N, bf16* WT, int kb, int n0, int dst_row0, LAS float* scr, int lane) {
    const int k0 = 64 * kb;
#pragma unroll 8
    for (int i = 0; i < 32; ++i) { const int kk = 2 * i + (lane >> 5); scr[kk * 33 + (lane & 31)] = W[(size_t)(k0 + kk) * N + n0 + (lane & 31)]; }
    asm volatile("s_waitcnt lgkmcnt(0)" ::: "memory");
    const int c = lane & 7;
#pragma unroll
    for (int j = 0; j < 4; ++j) { const int n = (lane >> 3) + 8 * j; const LAS float* sp = scr + (8 * c) * 33 + n;
        u32x4 o; o.x = pk2(sp[0 * 33], sp[1 * 33]); o.y = pk2(sp[2 * 33], sp[3 * 33]); o.z = pk2(sp[4 * 33], sp[5 * 33]); o.w = pk2(sp[6 * 33], sp[7 * 33]);
        *(GAS u32x4*)(WT + (size_t)(dst_row0 + n) * K + k0 + 8 * c) = o; }
    asm volatile("s_waitcnt lgkmcnt(0)" ::: "memory");
}
__device__ __forceinline__ int inproj_dst_row(int n0) { const int pn = n0 >> 8, w = n0 & 255, g = w >> 6, a = (w >> 5) & 1; return 256 * pn + 128 * a + 32 * g; }
__device__ __forceinline__ void p0_weights(Frame& F) {
    LAS float* scr = (LAS float*)(F.lds + 65536 + F.wave * 8704);
    const int gw = F.bid * 8 + F.wave, NGW = F.G * 8;
    constexpr int I_IN = 16 * 208, I_A = 16 * 32, I_B = 8 * 32, I_O = 16 * 32, I_G = 32 * 16 * 16, I_D = 32 * 8 * 32;
    constexpr int NITEMS = I_IN + I_A + I_B + I_O + 2 * I_G + I_D;
    for (int it = gw; it < NITEMS; it += NGW) {
        int r = it;
        if (r < I_IN) { const int kb = r / 208, n0 = (r % 208) * 32; p0_transpose_item(F.in[8], 1024, NIN, (bf16*)(F.ws + WS_WIN), kb, n0, inproj_dst_row(n0), scr, F.lane); continue; } r -= I_IN;
        if (r < I_A) { const int kb = r / 32, n0 = (r % 32) * 32; p0_transpose_item(F.in[19], 1024, 1024, (bf16*)(F.ws + WS_WA), kb, n0, n0, scr, F.lane); continue; } r -= I_A;
        if (r < I_B) { const int kb = r / 32, n0 = (r % 32) * 32; p0_transpose_item(F.in[20], 512, 1024, (bf16*)(F.ws + WS_WB), kb, n0, n0, scr, F.lane); continue; } r -= I_B;
        if (r < I_O) { const int kb = r / 32, n0 = (r % 32) * 32; p0_transpose_item(F.in[21], 1024, 1024, (bf16*)(F.ws + WS_WO), kb, n0, n0, scr, F.lane); continue; } r -= I_O;
        if (r < 2 * I_G) { const int up = r >= I_G; if (up) r -= I_G; const int e = r / 256, q = r % 256, kb = q / 16, n0 = (q % 16) * 32;
            const int drow = 256 * (n0 >> 7) + 128 * up + (n0 & 127);
            p0_transpose_item(F.in[up ? 27 : 26] + (size_t)e * 1024 * EH, 1024, EH, (bf16*)(F.ws + WS_WGU) + (size_t)e * 1024 * 1024, kb, n0, drow, scr, F.lane); continue; } r -= 2 * I_G;
        { const int e = r / 256, q = r % 256, kb = q / 32, n0 = (q % 32) * 32;
            p0_transpose_item(F.in[28] + (size_t)e * EH * 1024, EH, 1024, (bf16*)(F.ws + WS_WD) + (size_t)e * 1024 * EH, kb, n0, n0, scr, F.lane); }
    }
}

struct InProjOrder {
    pg8::DenseOrder d;
    __device__ __forceinline__ bool next(int i, pg8::Unit& u) const {
        const long L = (long)i * d.G + d.c;
        if (L < d.nwg) return d.map(L, u);
        const int j = (int)(L - d.nwg); if (j >= 48) return false;
        const int c = j % 12; u.pm = 128 + j / 12; u.pn = c < 8 ? 4 + c : 14 + (c - 8); u.a0 = 0; u.a1 = 0; return true;
    }
    __device__ __forceinline__ int arow(const pg8::Unit& u, int r) const { return u.pm * 256 + r; }
    __device__ __forceinline__ size_t boff(const pg8::Unit& u) const { return (size_t)u.pn * 256 * 1024; }
};
struct EpiInProj {
    static constexpr bool PERM = false;
    unsigned char* ws; bf16* GA; const float* gq_a; const float* gk_a; const float* gq_b; const float* gk_b;
    __device__ __forceinline__ void operator()(const f32x4 (&acc)[2][2][4][2], const pg8::Unit& u, int wr, int wc, int fr, int fq) const {
        const int pn = u.pn, cg = 4 * pn + wc;
        int kind; const float* gain = nullptr; bool rope = false; float oscale = 1.f; bf16* dbase; int pitch, ccol; bool kvrow = false;
        if (cg < 16)      { kind = 0; gain = gq_a; rope = true; oscale = C2; dbase = (bf16*)(ws + WS_QA); pitch = D; ccol = cg * 64; }
        else if (cg < 32) { kind = 0; gain = gk_a; rope = true; dbase = (bf16*)(ws + WS_KA); pitch = D; ccol = (cg - 16) * 64; kvrow = true; }
        else if (cg < 48) { kind = 1; dbase = (bf16*)(ws + WS_VA); pitch = D; ccol = (cg - 32) * 64; kvrow = true; }
        else if (cg < 56) { kind = 0; gain = gq_b; oscale = C2; dbase = (bf16*)(ws + WS_QB); pitch = 512; ccol = (cg - 48) * 64; }
        else if (cg < 64) { kind = 0; gain = gk_b; dbase = (bf16*)(ws + WS_KB); pitch = 512; ccol = (cg - 56) * 64; kvrow = true; }
        else if (cg < 72) { kind = 1; dbase = (bf16*)(ws + WS_VB); pitch = 512; ccol = (cg - 64) * 64; kvrow = true; }
        else if (cg < 88) { kind = 2; dbase = GA; pitch = D; ccol = (cg - 72) * 64; }
        else              { kind = 2; dbase = GA + (size_t)T * D; pitch = D; ccol = (cg - 88) * 64; }
        const bool latent = u.pm < 128; if (!latent) rope = false;
        const float* RP = (const float*)(ws + WS_ROPE);
        f32x4 gn[2][2];
        if (kind == 0) {
#pragma unroll
            for (int bj = 0; bj < 2; ++bj)
#pragma unroll
                for (int n = 0; n < 2; ++n) gn[bj][n] = *(const f32x4*)(gain + 32 * bj + 16 * n + 4 * fq) * oscale;
        }
#pragma unroll
        for (int ai = 0; ai < 2; ++ai)
#pragma unroll
            for (int m = 0; m < 4; ++m) {
                const int row = u.pm * 256 + ai * 128 + wr * 64 + m * 16 + fr;
                f32x4 v[2][2];
#pragma unroll
                for (int bj = 0; bj < 2; ++bj)
#pragma unroll
                    for (int n = 0; n < 2; ++n) v[bj][n] = acc[ai][bj][m][n];
                if (kind == 0) {
                    float ss = 0.f;
#pragma unroll
                    for (int bj = 0; bj < 2; ++bj)
#pragma unroll
                        for (int n = 0; n < 2; ++n) ss += (v[bj][n].x * v[bj][n].x + v[bj][n].y * v[bj][n].y) + (v[bj][n].z * v[bj][n].z + v[bj][n].w * v[bj][n].w);
                    ss += __shfl_xor(ss, 16); ss += __shfl_xor(ss, 32);
                    const float rstd = 1.0f / sqrtf(ss * (1.f / 64.f) + EPS);
#pragma unroll
                    for (int bj = 0; bj < 2; ++bj)
#pragma unroll
                        for (int n = 0; n < 2; ++n) v[bj][n] = v[bj][n] * rstd * gn[bj][n];
                    if (rope) {
                        const int t = row & (SEQ - 1), pr = t >> 6, pc = t & 63;
                        const f32x4 cr = *(const f32x4*)(RP + pr * 16 + 4 * fq), sr = *(const f32x4*)(RP + 2048 + pr * 16 + 4 * fq);
                        const f32x4 cc = *(const f32x4*)(RP + 4096 + pc * 16 + 4 * fq), sc = *(const f32x4*)(RP + 5120 + pc * 16 + 4 * fq);
                        const f32x4 a0 = v[0][0] * cr - v[0][1] * sr, a1 = v[0][0] * sr + v[0][1] * cr;
                        const f32x4 b0 = v[1][0] * cc - v[1][1] * sc, b1 = v[1][0] * sc + v[1][1] * cc;
                        v[0][0] = a0; v[0][1] = a1; v[1][0] = b0; v[1][1] = b1;
                    }
                } else if (kind == 2) {
#pragma unroll
                    for (int bj = 0; bj < 2; ++bj)
#pragma unroll
                        for (int n = 0; n < 2; ++n) { v[bj][n].x = sigmoid_f(v[bj][n].x); v[bj][n].y = sigmoid_f(v[bj][n].y); v[bj][n].z = sigmoid_f(v[bj][n].z); v[bj][n].w = sigmoid_f(v[bj][n].w); }
                }
                const int drow = kvrow ? kv_row(row) : row;
                bf16* dp = dbase + (size_t)drow * pitch + ccol + 4 * fq;
#pragma unroll
                for (int bj = 0; bj < 2; ++bj)
#pragma unroll
                    for (int n = 0; n < 2; ++n) { u32x2 w; w.x = pg8::cvt_pk_bf16(v[bj][n].x, v[bj][n].y); w.y = pg8::cvt_pk_bf16(v[bj][n].z, v[bj][n].w); *(GAS u32x2*)(dp + 32 * bj + 16 * n) = w; }
            }
    }
};
__device__ __forceinline__ void p1b_inproj_mfma(Frame& F) {
    pg8::Gemm g{(const bf16*)(F.ws + WS_XN), (const bf16*)(F.ws + WS_WIN), D, D, D};
    InProjOrder S; S.d.init(T, NIN, F.G, F.bid, D);
    EpiInProj E{F.ws, (bf16*)F.out, F.in[9], F.in[10], F.in[16], F.in[17]};
    pg8::gemm_phase<EpiInProj, InProjOrder>(F.lds, g, S, E);
}

__device__ __forceinline__ float lam_value(const float* const (&in)[29]) {
    float a = 0.f, b = 0.f;
    for (int i = 0; i < 64; ++i) { a += in[11][i] * in[12][i]; b += in[13][i] * in[14][i]; }
    return expf(a) - expf(b) + 0.2f;
}
__device__ __forceinline__ float qk_bound(const float* gq, const float* gk) {
    float mq = 0.f, mk = 0.f; for (int i = 0; i < 64; ++i) { mq = fmaxf(mq, fabsf(gq[i])); mk = fmaxf(mk, fabsf(gk[i])); }
    return 8.0f * mq * mk * LOG2E * 1.02f + 0.1f;
}
__device__ __forceinline__ void p2a_diffattn(Frame& F) {
    bf16* QA = (bf16*)(F.ws + WS_QA); const bf16* KA = (const bf16*)(F.ws + WS_KA); const bf16* VA = (const bf16*)(F.ws + WS_VA);
    const float* subln = F.in[15];
    const float lam = lam_value(F.in); const float mb = qk_bound(F.in[9], F.in[10]);
    LAS float* K1s = (LAS float*)F.lds; LAS float* K2s = K1s + 32 * 64; LAS float* Vs = K2s + 32 * 64;
    LAS float* X = Vs + 32 * 128;
    LAS float* SS = X + 128 * 128;
    const int qrow = F.tid & 127, vh = (F.tid >> 7) & 1, br = F.tid >> 8;
    for (int unit = F.bid; unit < NB * NH * (SEQ / 128); unit += F.G) {
        const int bh = unit / (SEQ / 128), qt = unit % (SEQ / 128), b = bh / NH, h = bh % NH;
        const size_t qoff = (size_t)(b * SEQ + qt * 128 + qrow) * D + h * 128;
        float q[64], o[64], l = 0.f;
#pragma unroll
        for (int i = 0; i < 8; ++i) { const u32x4 w = *(const GAS u32x4*)(QA + qoff + br * 64 + i * 8);
            q[i * 8 + 0] = bf2f(w.x & 0xffffu); q[i * 8 + 1] = bf2f(w.x >> 16); q[i * 8 + 2] = bf2f(w.y & 0xffffu); q[i * 8 + 3] = bf2f(w.y >> 16);
            q[i * 8 + 4] = bf2f(w.z & 0xffffu); q[i * 8 + 5] = bf2f(w.z >> 16); q[i * 8 + 6] = bf2f(w.w & 0xffffu); q[i * 8 + 7] = bf2f(w.w >> 16); }
#pragma unroll
        for (int i = 0; i < 64; ++i) o[i] = 0.f;
        const bf16* Kb = KA + (size_t)b * KVL * D + h * 128; const bf16* Vb = VA + (size_t)b * KVL * D + h * 128;
        for (int kt = 0; kt < KVL / 32; ++kt) {
            __syncthreads();
            {
              const int r = F.tid >> 4, c8 = (F.tid & 15) * 8; const size_t go = (size_t)(kt * 32 + r) * D + c8;
              const u32x4 kw = *(const GAS u32x4*)(Kb + go); const u32x4 vw = *(const GAS u32x4*)(Vb + go);
              LAS float* kd = (c8 < 64) ? K1s + r * 64 + c8 : K2s + r * 64 + (c8 - 64);
              kd[0] = bf2f(kw.x & 0xffffu); kd[1] = bf2f(kw.x >> 16); kd[2] = bf2f(kw.y & 0xffffu); kd[3] = bf2f(kw.y >> 16);
              kd[4] = bf2f(kw.z & 0xffffu); kd[5] = bf2f(kw.z >> 16); kd[6] = bf2f(kw.w & 0xffffu); kd[7] = bf2f(kw.w >> 16);
              LAS float* vd = Vs + r * 128 + c8;
              vd[0] = bf2f(vw.x & 0xffffu); vd[1] = bf2f(vw.x >> 16); vd[2] = bf2f(vw.y & 0xffffu); vd[3] = bf2f(vw.y >> 16);
              vd[4] = bf2f(vw.z & 0xffffu); vd[5] = bf2f(vw.z >> 16); vd[6] = bf2f(vw.w & 0xffffu); vd[7] = bf2f(vw.w >> 16); }
            __syncthreads();
            const LAS float* Ks = br ? K2s : K1s;
            for (int j = 0; j < 32; ++j) {
                float s = 0.f;
#pragma unroll
                for (int d4 = 0; d4 < 16; ++d4) { const f32x4 kv = *(const LAS f32x4*)(Ks + j * 64 + d4 * 4);
                    s += q[d4 * 4] * kv.x + q[d4 * 4 + 1] * kv.y + q[d4 * 4 + 2] * kv.z + q[d4 * 4 + 3] * kv.w; }
                const float p = rbf(exp2f(s - mb)); l += p;
#pragma unroll
                for (int e4 = 0; e4 < 16; ++e4) { const f32x4 vv = *(const LAS f32x4*)(Vs + j * 128 + vh * 64 + e4 * 4);
                    o[e4 * 4] += p * vv.x; o[e4 * 4 + 1] += p * vv.y; o[e4 * 4 + 2] += p * vv.z; o[e4 * 4 + 3] += p * vv.w; }
            }
        }
        const float rl = 1.f / l;
        if (br == 1) {
#pragma unroll
            for (int i = 0; i < 64; ++i) X[qrow * 128 + vh * 64 + i] = o[i] * rl;
        }
        __syncthreads();
        float ss = 0.f;
        if (br == 0) {
#pragma unroll
            for (int i = 0; i < 64; ++i) { o[i] = o[i] * rl - lam * X[qrow * 128 + vh * 64 + i]; ss += o[i] * o[i]; }
            SS[qrow * 2 + vh] = ss;
        }
        __syncthreads();
        if (br == 0) {
            const float tot = SS[qrow * 2] + SS[qrow * 2 + 1]; const float rstd = 1.0f / sqrtf(tot * (1.f / 128.f) + EPS);
            bf16* dst = QA + qoff + vh * 64;
#pragma unroll
            for (int i = 0; i < 8; ++i) { u32x4 w; const float* sg = subln + vh * 64 + i * 8;
                w.x = pk2(o[i * 8] * rstd * sg[0] * 0.8f, o[i * 8 + 1] * rstd * sg[1] * 0.8f); w.y = pk2(o[i * 8 + 2] * rstd * sg[2] * 0.8f, o[i * 8 + 3] * rstd * sg[3] * 0.8f);
                w.z = pk2(o[i * 8 + 4] * rstd * sg[4] * 0.8f, o[i * 8 + 5] * rstd * sg[5] * 0.8f); w.w = pk2(o[i * 8 + 6] * rstd * sg[6] * 0.8f, o[i * 8 + 7] * rstd * sg[7] * 0.8f);
                *(GAS u32x4*)(dst + i * 8) = w; }
        }
        __syncthreads();
    }
}

__device__ __forceinline__ void p2b_natten(Frame& F) {
    bf16* QB = (bf16*)(F.ws + WS_QB); const bf16* KB = (const bf16*)(F.ws + WS_KB); const bf16* VB = (const bf16*)(F.ws + WS_VB);
    const float* bias = F.in[18];
    const int w = F.tid & 63, h = F.tid >> 6;
    for (int unit = F.bid; unit < NB * NROWS; unit += F.G) {
        const int b = unit / NROWS, r = unit % NROWS;
        const size_t qoff = (size_t)(b * SEQ + r * GRIDW + w) * 512 + h * 64;
        float q[64], o[64], l = 0.f, mx = -1e30f;
#pragma unroll
        for (int i = 0; i < 8; ++i) { const u32x4 ww = *(const GAS u32x4*)(QB + qoff + i * 8);
            q[i * 8 + 0] = bf2f(ww.x & 0xffffu); q[i * 8 + 1] = bf2f(ww.x >> 16); q[i * 8 + 2] = bf2f(ww.y & 0xffffu); q[i * 8 + 3] = bf2f(ww.y >> 16);
            q[i * 8 + 4] = bf2f(ww.z & 0xffffu); q[i * 8 + 5] = bf2f(ww.z >> 16); q[i * 8 + 6] = bf2f(ww.w & 0xffffu); q[i * 8 + 7] = bf2f(ww.w >> 16); }
#pragma unroll
        for (int i = 0; i < 64; ++i) o[i] = 0.f;
        int r0 = r - 4; r0 = r0 < 0 ? 0 : (r0 > NROWS - 8 ? NROWS - 8 : r0);
        int c0 = w - 8; c0 = c0 < 0 ? 0 : (c0 > GRIDW - 16 ? GRIDW - 16 : c0);
        for (int key = 0; key < 128 + CTX; ++key) {
            size_t krow; float bv = 0.f;
            if (key < 128) { const int i = key >> 4, j = key & 15; krow = (size_t)b * KVL + CTX + (r0 + i) * GRIDW + c0 + j;
                bv = bias[(h * 15 + (r0 + i - r + 7)) * 31 + (c0 + j - w + 15)] * LOG2E; }
            else krow = (size_t)b * KVL + (key - 128);
            const bf16* kp = KB + krow * 512 + h * 64; const bf16* vp = VB + krow * 512 + h * 64;
            float s = bv;
#pragma unroll
            for (int i = 0; i < 8; ++i) { const u32x4 kw = *(const GAS u32x4*)(kp + i * 8);
                s += q[i * 8] * bf2f(kw.x & 0xffffu) + q[i * 8 + 1] * bf2f(kw.x >> 16) + q[i * 8 + 2] * bf2f(kw.y & 0xffffu) + q[i * 8 + 3] * bf2f(kw.y >> 16)
                   + q[i * 8 + 4] * bf2f(kw.z & 0xffffu) + q[i * 8 + 5] * bf2f(kw.z >> 16) + q[i * 8 + 6] * bf2f(kw.w & 0xffffu) + q[i * 8 + 7] * bf2f(kw.w >> 16); }
            if (s > mx) { const float f = exp2f(mx - s); l *= f;
#pragma unroll
                for (int i = 0; i < 64; ++i) o[i] *= f;
                mx = s; }
            const float p = exp2f(s - mx); l += p;
#pragma unroll
            for (int i = 0; i < 8; ++i) { const u32x4 vw = *(const GAS u32x4*)(vp + i * 8);
                o[i * 8] += p * bf2f(vw.x & 0xffffu); o[i * 8 + 1] += p * bf2f(vw.x >> 16); o[i * 8 + 2] += p * bf2f(vw.y & 0xffffu); o[i * 8 + 3] += p * bf2f(vw.y >> 16);
                o[i * 8 + 4] += p * bf2f(vw.z & 0xffffu); o[i * 8 + 5] += p * bf2f(vw.z >> 16); o[i * 8 + 6] += p * bf2f(vw.w & 0xffffu); o[i * 8 + 7] += p * bf2f(vw.w >> 16); }
        }
        const float rl = 1.f / l;
#pragma unroll
        for (int i = 0; i < 8; ++i) { u32x4 ww; ww.x = pk2(o[i * 8] * rl, o[i * 8 + 1] * rl); ww.y = pk2(o[i * 8 + 2] * rl, o[i * 8 + 3] * rl);
            ww.z = pk2(o[i * 8 + 4] * rl, o[i * 8 + 5] * rl); ww.w = pk2(o[i * 8 + 6] * rl, o[i * 8 + 7] * rl); *(GAS u32x4*)(QB + qoff + i * 8) = ww; }
    }
}

__device__ __forceinline__ void p3a_merge(Frame& F) {
    const bf16* OA = (const bf16*)(F.ws + WS_QA); const bf16* OB = (const bf16*)(F.ws + WS_QB);
    const float* Wa = F.in[19]; const float* Wb = F.in[20];
    const bf16* GA = (const bf16*)F.out; const bf16* GB = GA + (size_t)T * D; bf16* Y = (bf16*)(F.ws + WS_Y);
    LAS float* As = (LAS float*)F.lds; LAS float* Bs = As + NG_AS;
    for (int item = F.bid; item < (T / 128) * 16; item += F.G) {
        const int tm = item / 16, tn = item % 16, m0 = tm * 128, n0 = tn * 64;
        float aa[4][4], ab[4][4]; zero_acc(aa); zero_acc(ab);
        gemm_core(aa, As, Bs, 1024, F.tid, [&](int row, int k) { return OA + (size_t)(m0 + row) * D + k; }, [&](int k, int n) { return *(const f32x2*)(Wa + (size_t)k * D + n0 + n); });
        gemm_core(ab, As, Bs, 512, F.tid, [&](int row, int k) { return OB + (size_t)(m0 + row) * 512 + k; }, [&](int k, int n) { return *(const f32x2*)(Wb + (size_t)k * D + n0 + n); });
        const int ty = F.tid >> 4, tx = F.tid & 15;
#pragma unroll
        for (int i = 0; i < 4; ++i) { const size_t off = (size_t)(m0 + ty * 4 + i) * D + n0 + tx * 4;
            const u32x2 ga = *(const GAS u32x2*)(GA + off), gb = *(const GAS u32x2*)(GB + off);
            const float y0 = bf2f(ga.x & 0xffffu) * aa[i][0] + bf2f(gb.x & 0xffffu) * ab[i][0], y1 = bf2f(ga.x >> 16) * aa[i][1] + bf2f(gb.x >> 16) * ab[i][1];
            const float y2 = bf2f(ga.y & 0xffffu) * aa[i][2] + bf2f(gb.y & 0xffffu) * ab[i][2], y3 = bf2f(ga.y >> 16) * aa[i][3] + bf2f(gb.y >> 16) * ab[i][3];
            u32x2 w; w.x = pk2(y0, y1); w.y = pk2(y2, y3); *(GAS u32x2*)(Y + off) = w; }
    }
}
__device__ __forceinline__ void p3b_out(Frame& F) {
    const bf16* Y = (const bf16*)(F.ws + WS_Y); const float* Wo = F.in[21]; const float* x = F.in[0];
    const float* MOD = (const float*)(F.ws + WS_MOD); float* XMID = (float*)(F.ws + WS_XMID);
    LAS float* As = (LAS float*)F.lds; LAS float* Bs = As + NG_AS;
    for (int item = F.bid; item < (T / 128) * 16; item += F.G) {
        const int tm = item / 16, tn = item % 16, m0 = tm * 128, n0 = tn * 64;
        float acc[4][4]; zero_acc(acc);
        gemm_core(acc, As, Bs, 1024, F.tid, [&](int row, int k) { return Y + (size_t)(m0 + row) * D + k; }, [&](int k, int n) { return *(const f32x2*)(Wo + (size_t)k * D + n0 + n); });
        const int ty = F.tid >> 4, tx = F.tid & 15; const int b = m0 / SEQ;
        const f32x4 g = *(const f32x4*)(MOD + b * 6144 + 2048 + n0 + tx * 4);
#pragma unroll
        for (int i = 0; i < 4; ++i) { const size_t off = (size_t)(m0 + ty * 4 + i) * D + n0 + tx * 4; const f32x4 xv = *(const f32x4*)(x + off);
            f32x4 o; o.x = xv.x + g.x * acc[i][0]; o.y = xv.y + g.y * acc[i][1]; o.z = xv.z + g.z * acc[i][2]; o.w = xv.w + g.w * acc[i][3]; *(f32x4*)(XMID + off) = o; }
    }
}

__device__ __forceinline__ void p4a_norm2_route(Frame& F) {
    const float* XMID = (const float*)(F.ws + WS_XMID); const float* nw = F.in[7]; const float* MOD = (const float*)(F.ws + WS_MOD);
    const float* w_rg = F.in[22]; const float* b_rg = F.in[23]; const float* w_re = F.in[24]; const float* b_re = F.in[25];
    bf16* H2 = (bf16*)(F.ws + WS_H2); float* RT = (float*)(F.ws + WS_RT); int* LIST = (int*)(F.ws + WS_LIST);
    LAS float* WG = (LAS float*)F.lds;
    LAS float* WE = WG + 4096;
    for (int i = F.tid; i < 4096; i += NTHR) WG[i] = w_rg[i];
    for (int i = F.tid; i < 4 * 1024 * 8; i += NTHR) WE[i] = w_re[i];
    __syncthreads();
    const int gw = F.bid * 8 + F.wave, NGW = F.G * 8;
    for (int m = gw; m < T; m += NGW) {
        const int b = m / SEQ; f32x4 v[4];
        norm_mod_row(XMID + (size_t)m * D, nw, MOD + b * 6144 + 4096, MOD + b * 6144 + 3072, F.lane, v);
        store_row_bf16(H2 + (size_t)m * D, F.lane, v);
        float lg[4] = {0.f, 0.f, 0.f, 0.f};
#pragma unroll
        for (int j = 0; j < 4; ++j)
#pragma unroll
            for (int e = 0; e < 4; ++e) { const int k = 4 * F.lane + 256 * j + e; const float hv = v[j][e]; const f32x4 w4 = *(const LAS f32x4*)(WG + k * 4);
                lg[0] += hv * w4.x; lg[1] += hv * w4.y; lg[2] += hv * w4.z; lg[3] += hv * w4.w; }
#pragma unroll
        for (int c = 0; c < 4; ++c) lg[c] = wave_sum(lg[c]);
        int g = 0; float gl[4];
#pragma unroll
        for (int c = 0; c < 4; ++c) gl[c] = lg[c] + b_rg[c];
        float gm = gl[0];
#pragma unroll
        for (int c = 1; c < 4; ++c) if (gl[c] > gm) { gm = gl[c]; g = c; }
        float gs = 0.f;
#pragma unroll
        for (int c = 0; c < 4; ++c) gs += expf(gl[c] - gm);
        const float g_w = 1.f / gs;
        g = __builtin_amdgcn_readfirstlane(g);
        float el[8] = {0.f, 0.f, 0.f, 0.f, 0.f, 0.f, 0.f, 0.f};
        { const LAS float* we = WE + g * 8192;
#pragma unroll
          for (int j = 0; j < 4; ++j)
#pragma unroll
              for (int e = 0; e < 4; ++e) { const int k = 4 * F.lane + 256 * j + e; const float hv = v[j][e];
                  const f32x4 wa = *(const LAS f32x4*)(we + k * 8), wb = *(const LAS f32x4*)(we + k * 8 + 4);
                  el[0] += hv * wa.x; el[1] += hv * wa.y; el[2] += hv * wa.z; el[3] += hv * wa.w; el[4] += hv * wb.x; el[5] += hv * wb.y; el[6] += hv * wb.z; el[7] += hv * wb.w; } }
#pragma unroll
        for (int e = 0; e < 8; ++e) el[e] = wave_sum(el[e]) + b_re[g * 8 + e];
        int i0 = 0; float v0 = el[0];
#pragma unroll
        for (int e = 1; e < 8; ++e) if (el[e] > v0) { v0 = el[e]; i0 = e; }
        int i1 = -1; float v1 = -3.0e38f;
#pragma unroll
        for (int e = 0; e < 8; ++e) if (e != i0 && el[e] > v1) { v1 = el[e]; i1 = e; }
        const float e1 = expf(v1 - v0), den = 1.f / (1.f + e1);
        const float w0 = g_w * den, w1 = g_w * e1 * den;
        if (F.lane == 0) {
            const int ge0 = g * 8 + i0, ge1 = 32 + g * 8 + i1;
            const unsigned p0 = atomicAdd((unsigned*)(F.ctl + CW_CNT + 64 * ge0), 1u); const unsigned p1 = atomicAdd((unsigned*)(F.ctl + CW_CNT + 64 * ge1), 1u);
            LIST[(size_t)ge0 * T + p0] = m; LIST[(size_t)ge1 * T + p1] = m;
            RT[(size_t)m * 4 + 0] = w0; RT[(size_t)m * 4 + 1] = w1;
        }
    }
}

struct GroupTab { LAS int* cnt; LAS int* tpre; LAS int* sbase; };
__device__ __forceinline__ GroupTab load_groups(Frame& F, int lds_off) {
    GroupTab G; G.cnt = (LAS int*)(F.lds + lds_off); G.tpre = G.cnt + 64; G.sbase = G.tpre + 65;
    __syncthreads();
    if (F.tid < 64) G.cnt[F.tid] = (int)__hip_atomic_load(F.ctl + CW_CNT + 64 * F.tid, __ATOMIC_RELAXED, __HIP_MEMORY_SCOPE_AGENT);
    __syncthreads();
    if (F.tid == 0) { int tp = 0, sb = 0; for (int g = 0; g < 64; ++g) { G.tpre[g] = tp; G.sbase[g] = sb; tp += (G.cnt[g] + 127) / 128; sb += (G.cnt[g] + 255) / 256 * 256; } G.tpre[64] = tp; }
    __syncthreads();
    return G;
}
__device__ __forceinline__ void p4b_gateup(Frame& F) {
    const bf16* H2 = (const bf16*)(F.ws + WS_H2); const int* LIST = (const int*)(F.ws + WS_LIST); bf16* HID = (bf16*)(F.ws + WS_HID);
    const float* Wg = F.in[26]; const float* Wu = F.in[27];
    LAS float* As = (LAS float*)F.lds; LAS float* Bs = As + NG_AS;
    const GroupTab G = load_groups(F, (NG_AS + NG_BS) * 4);
    const int ntiles = G.tpre[64];
    for (int item = F.bid; item < ntiles * 8; item += F.G) {
        const int tile = item / 8, tn = item % 8; int g = 0; while (G.tpre[g + 1] <= tile) ++g;
        const int r0 = (tile - G.tpre[g]) * 128, cnt = G.cnt[g], e = g & 31, n0 = tn * 64;
        const int* lst = LIST + (size_t)g * T;
        float ag[4][4], au[4][4]; zero_acc(ag); zero_acc(au);
        auto af = [&](int row, int k) { const int i = r0 + row; const int tok = i < cnt ? lst[i] : lst[0]; return H2 + (size_t)tok * D + k; };
        gemm_core(ag, As, Bs, 1024, F.tid, af, [&](int k, int n) { return *(const f32x2*)(Wg + ((size_t)e * 1024 + k) * EH + n0 + n); });
        gemm_core(au, As, Bs, 1024, F.tid, af, [&](int k, int n) { return *(const f32x2*)(Wu + ((size_t)e * 1024 + k) * EH + n0 + n); });
        const int ty = F.tid >> 4, tx = F.tid & 15;
#pragma unroll
        for (int i = 0; i < 4; ++i) { const int rr = r0 + ty * 4 + i; if (rr < cnt) {
            u32x2 w; w.x = pk2(silu_f(ag[i][0]) * au[i][0], silu_f(ag[i][1]) * au[i][1]); w.y = pk2(silu_f(ag[i][2]) * au[i][2], silu_f(ag[i][3]) * au[i][3]);
            *(GAS u32x2*)(HID + (size_t)(G.sbase[g] + rr) * EH + n0 + tx * 4) = w; } }
    }
}
__device__ __forceinline__ void p4c_down(Frame& F, int kk) {
    const bf16* HID = (const bf16*)(F.ws + WS_HID); const int* LIST = (const int*)(F.ws + WS_LIST); const float* RT = (const float*)(F.ws + WS_RT);
    const float* Wd = F.in[28]; const float* XMID = (const float*)(F.ws + WS_XMID); const float* MOD = (const float*)(F.ws + WS_MOD);
    LAS float* As = (LAS float*)F.lds; LAS float* Bs = As + NG_AS;
    const GroupTab G = load_groups(F, (NG_AS + NG_BS) * 4);
    const int t_lo = G.tpre[kk * 32], t_hi = G.tpre[kk * 32 + 32];
    for (int item = F.bid; item < (t_hi - t_lo) * 16; item += F.G) {
        const int tile = t_lo + item / 16, tn = item % 16; int g = kk * 32; while (G.tpre[g + 1] <= tile) ++g;
        const int r0 = (tile - G.tpre[g]) * 128, cnt = G.cnt[g], e = g & 31, n0 = tn * 64;
        const int* lst = LIST + (size_t)g * T;
        float acc[4][4]; zero_acc(acc);
        gemm_core(acc, As, Bs, 512, F.tid, [&](int row, int k) { const int i = r0 + row; return HID + (size_t)(G.sbase[g] + (i < cnt ? i : 0)) * EH + k; },
                  [&](int k, int n) { return *(const f32x2*)(Wd + ((size_t)e * EH + k) * D + n0 + n); });
        const int ty = F.tid >> 4, tx = F.tid & 15;
#pragma unroll
        for (int i = 0; i < 4; ++i) { const int rr = r0 + ty * 4 + i; if (rr < cnt) {
            const int tok = lst[rr]; const int b = tok / SEQ; const float w = RT[(size_t)tok * 4 + kk];
            const f32x4 g2 = *(const f32x4*)(MOD + b * 6144 + 5120 + n0 + tx * 4); const size_t off = (size_t)tok * D + n0 + tx * 4;
            const f32x4 base = kk == 0 ? *(const f32x4*)(XMID + off) : *(const f32x4*)(F.out + off);
            f32x4 o; o.x = base.x + g2.x * w * acc[i][0]; o.y = base.y + g2.y * w * acc[i][1]; o.z = base.z + g2.z * w * acc[i][2]; o.w = base.w + g2.w * w * acc[i][3];
            *(f32x4*)(F.out + off) = o; } }
    }
}


namespace dattn {
typedef short bf16x8 __attribute__((ext_vector_type(8)));
typedef short s16x4 __attribute__((ext_vector_type(4)));
typedef float f32x16 __attribute__((ext_vector_type(16)));
typedef short v4i16_t __attribute__((ext_vector_type(4)));
constexpr int SLOT = 32768, NT = KVL / 64, LDS_WS = 3 * SLOT, XS = 136;
typedef __attribute__((address_space(3))) const char* lds_cptr;
__device__ __forceinline__ int crow(int r, int hi) { return (r & 3) + 8 * (r >> 2) + 4 * hi; }
__device__ __forceinline__ void glds16(const void* gsrc, unsigned lds_dst) { unsigned keep;
    asm volatile("s_mov_b32 %0, m0\n\ts_mov_b32 m0, %2\n\ts_nop 0\n\tglobal_load_lds_dwordx4 %1, off\n\ts_mov_b32 m0, %0" : "=&s"(keep) : "v"(gsrc), "s"(lds_dst) : "memory"); }
__device__ __forceinline__ unsigned cvtpk(float lo, float hi) { typedef float f2 __attribute__((ext_vector_type(2))); typedef __bf16 b2 __attribute__((ext_vector_type(2))); f2 v = {lo, hi}; b2 b = __builtin_convertvector(v, b2); return __builtin_bit_cast(unsigned, b); }
__device__ __forceinline__ s16x4 vtr(lds_cptr p) { return __builtin_bit_cast(s16x4, __builtin_amdgcn_ds_read_tr16_b64_v4i16((__attribute__((address_space(3))) v4i16_t*)p)); }
#define DA_WAIT_BAR(N) asm volatile("s_waitcnt vmcnt(" #N ") lgkmcnt(0)\n\ts_barrier" ::: "memory")

__device__ __forceinline__ void unit(int b, int h, int qt, bf16* QA, const bf16* KA, const bf16* VA, LAS unsigned char* lds, float lam, float mb, const float* subln) {
    const int tid = threadIdx.x, lane = tid & 63, r32 = lane & 31, hi = lane >> 5; const int wid = __builtin_amdgcn_readfirstlane(tid >> 6);
    const int br = wid >> 2, qi = wid & 3;
    const size_t qrow0 = (size_t)b * SEQ + qt * 128 + qi * 32;
    const bf16* Qw = QA + qrow0 * D + h * 128 + br * 64;
    const unsigned lds0 = (unsigned)(uintptr_t)lds;
    const bf16* src; unsigned dst; size_t sstep;
    if (wid < 4) { src = KA + ((size_t)b * KVL + lane) * D + h * 128 + wid * 32; dst = (unsigned)wid * 4096u; sstep = 8; }
    else { src = VA + ((size_t)b * KVL + (lane >> 2)) * D + h * 128 + (wid - 4) * 32 + (lane & 3) * 8; dst = 16384u + (unsigned)(wid - 4) * 4096u; sstep = (size_t)16 * D; }
#define DA_DMA(t, slot) do { _Pragma("unroll") for (int _k = 0; _k < 4; ++_k) glds16(src + (size_t)(t) * 64 * D + _k * sstep, (unsigned)__builtin_amdgcn_readfirstlane(lds0 + (slot) + dst + _k * 1024)); } while (0)
    DA_DMA(0, 0); DA_DMA(1, SLOT);
    bf16x8 qr[4];
#pragma unroll
    for (int d0 = 0; d0 < 4; ++d0) qr[d0] = *(const bf16x8*)(Qw + (size_t)r32 * D + d0 * 16 + hi * 8);
    f32x16 o[4];
#pragma unroll
    for (int i = 0; i < 4; ++i) o[i] = f32x16{};
    f32x16 negm;
#pragma unroll
    for (int r = 0; r < 16; ++r) negm[r] = -mb;
    float l = 0.f;
    const lds_cptr l3 = (lds_cptr)lds;
    const lds_cptr kp0 = l3 + br * 8192 + hi * 1024 + r32 * 16;
    const lds_cptr vp0 = l3 + 16384 + ((lane >> 4) & 1) * 32 + (lane & 3) * 8 + (4 * hi + ((lane & 15) >> 2)) * 64;
    int sl_cur = 0, sl_pf = 2 * SLOT;
    for (int t = 0; t < NT; ++t) {
        if (t + 1 < NT) DA_WAIT_BAR(4); else DA_WAIT_BAR(0);
        if (t + 2 < NT) DA_DMA(t + 2, sl_pf);
        const lds_cptr kp = kp0 + sl_cur, vp = vp0 + sl_cur;
        f32x16 p0, p1;
#pragma unroll
        for (int d0 = 0; d0 < 4; ++d0) {
            const bf16x8 k0 = *(const __attribute__((address_space(3))) bf16x8*)(kp + d0 * 2048), k1 = *(const __attribute__((address_space(3))) bf16x8*)(kp + d0 * 2048 + 512);
            p0 = __builtin_amdgcn_mfma_f32_32x32x16_bf16(k0, qr[d0], d0 == 0 ? negm : p0, 0, 0, 0);
            p1 = __builtin_amdgcn_mfma_f32_32x32x16_bf16(k1, qr[d0], d0 == 0 ? negm : p1, 0, 0, 0);
        }
        float sacc = 0.f;
#pragma unroll
        for (int r = 0; r < 16; ++r) { p0[r] = __builtin_amdgcn_exp2f(p0[r]); p1[r] = __builtin_amdgcn_exp2f(p1[r]); sacc += p0[r] + p1[r]; }
        l += sacc;
        u32x4 pw[4];
#pragma unroll
        for (int s2 = 0; s2 < 2; ++s2) {
            pw[s2]     = (u32x4){cvtpk(p0[8 * s2], p0[8 * s2 + 1]), cvtpk(p0[8 * s2 + 2], p0[8 * s2 + 3]), cvtpk(p0[8 * s2 + 4], p0[8 * s2 + 5]), cvtpk(p0[8 * s2 + 6], p0[8 * s2 + 7])};
            pw[2 + s2] = (u32x4){cvtpk(p1[8 * s2], p1[8 * s2 + 1]), cvtpk(p1[8 * s2 + 2], p1[8 * s2 + 3]), cvtpk(p1[8 * s2 + 4], p1[8 * s2 + 5]), cvtpk(p1[8 * s2 + 6], p1[8 * s2 + 7])};
        }
#pragma unroll
        for (int ks = 0; ks < 4; ++ks) {
            const bf16x8 pa = __builtin_bit_cast(bf16x8, pw[ks]);
#pragma unroll
            for (int db = 0; db < 4; ++db) {
                const s16x4 lo = vtr(vp + db * 4096 + ks * 1024), hh = vtr(vp + db * 4096 + ks * 1024 + 512);
                const bf16x8 vf = (bf16x8){lo[0], lo[1], lo[2], lo[3], hh[0], hh[1], hh[2], hh[3]};
                o[db] = __builtin_amdgcn_mfma_f32_32x32x16_bf16(pa, vf, o[db], 0, 0, 0);
            }
        }
        sl_cur = (sl_cur == 2 * SLOT) ? 0 : sl_cur + SLOT; sl_pf = (sl_pf == 2 * SLOT) ? 0 : sl_pf + SLOT;
    }
    { auto rr = __builtin_amdgcn_permlane32_swap(__float_as_uint(l), __float_as_uint(l), false, false); l = __uint_as_float(rr[0]) + __uint_as_float(rr[1]); }
    LAS float* wsf = (LAS float*)(lds + LDS_WS) + wid * 64;
    if (hi == 0) wsf[r32] = 1.0f / l;
    asm volatile("s_waitcnt lgkmcnt(0)" ::: "memory");
    float rli[16];
#pragma unroll
    for (int r = 0; r < 16; ++r) rli[r] = wsf[crow(r, hi)];
    DA_WAIT_BAR(0);
    LAS float* X = (LAS float*)lds + (size_t)(qi * 32) * XS;
    if (br == 1) {
#pragma unroll
        for (int db = 0; db < 4; ++db)
#pragma unroll
            for (int r = 0; r < 16; ++r) X[crow(r, hi) * XS + db * 32 + r32] = o[db][r] * rli[r];
    }
    DA_WAIT_BAR(0);
    if (br == 0) {
#pragma unroll
        for (int db = 0; db < 4; ++db)
#pragma unroll
            for (int r = 0; r < 16; ++r) { const int xi = crow(r, hi) * XS + db * 32 + r32; X[xi] = o[db][r] * rli[r] - lam * X[xi]; }
        asm volatile("s_waitcnt lgkmcnt(0)" ::: "memory");
        const int row = lane >> 1, half = lane & 1;
        f32x4 v[8][2]; float ss = 0.f;
#pragma unroll
        for (int i = 0; i < 8; ++i)
#pragma unroll
            for (int c = 0; c < 2; ++c) { v[i][c] = *(const LAS f32x4*)(X + row * XS + (2 * i + half) * 8 + c * 4); ss += (v[i][c].x * v[i][c].x + v[i][c].y * v[i][c].y) + (v[i][c].z * v[i][c].z + v[i][c].w * v[i][c].w); }
        ss += __shfl_xor(ss, 1);
        const float rstd = 0.8f / sqrtf(ss * (1.f / 128.f) + EPS);
        bf16* dst = QA + (qrow0 + row) * D + h * 128;
#pragma unroll
        for (int i = 0; i < 8; ++i) { const int d = (2 * i + half) * 8; const f32x4 g0 = *(const f32x4*)(subln + d), g1 = *(const f32x4*)(subln + d + 4);
            u32x4 w; w.x = cvtpk(v[i][0].x * rstd * g0.x, v[i][0].y * rstd * g0.y); w.y = cvtpk(v[i][0].z * rstd * g0.z, v[i][0].w * rstd * g0.w);
            w.z = cvtpk(v[i][1].x * rstd * g1.x, v[i][1].y * rstd * g1.y); w.w = cvtpk(v[i][1].z * rstd * g1.z, v[i][1].w * rstd * g1.w);
            *(GAS u32x4*)(dst + d) = w; }
    }
    DA_WAIT_BAR(0);
#undef DA_DMA
}
}
__device__ __forceinline__ void p2a_diffattn_mfma(Frame& F) {
    bf16* QA = (bf16*)(F.ws + WS_QA); const bf16* KA = (const bf16*)(F.ws + WS_KA); const bf16* VA = (const bf16*)(F.ws + WS_VA);
    const float lam = lam_value(F.in); const float mb = qk_bound(F.in[9], F.in[10]);
    constexpr int NU = NB * NH * (SEQ / 128);
    for (int i = 0; ; ++i) {
        int bh, qt;
        if (F.G == 256) { if (i >= 8) break; const int x = F.bid & 7, j = F.bid >> 3; bh = x + 8 * (i >> 1); qt = (i & 1) * 32 + j; }
        else { const int u = F.bid + i * F.G; if (u >= NU) break; bh = u / (SEQ / 128); qt = u % (SEQ / 128); }
        dattn::unit(bh / NH, bh % NH, qt, QA, KA, VA, F.lds, lam, mb, F.in[15]);
    }
}

struct EpiMergeA {
    static constexpr bool PERM = true; const bf16* GA; bf16* Y;
    __device__ __forceinline__ void operator()(const f32x4 (&acc)[2][2][4][2], const pg8::Unit& u, int wr, int wc, int fr, int fq) const {
#pragma unroll
        for (int ai = 0; ai < 2; ++ai)
#pragma unroll
            for (int m = 0; m < 4; ++m) { const size_t ro = (size_t)(u.pm * 256 + ai * 128 + wr * 64 + m * 16 + fr) * D + u.pn * 256 + wc * 32 + 8 * fq;
#pragma unroll
                for (int bj = 0; bj < 2; ++bj) { const u32x4 gv = *(const GAS u32x4*)(GA + ro + bj * 128); const f32x4 a = acc[ai][bj][m][0], b = acc[ai][bj][m][1];
                    u32x4 w; w.x = pg8::cvt_pk_bf16(bf2f(gv.x & 0xffffu) * a.x, bf2f(gv.x >> 16) * a.y); w.y = pg8::cvt_pk_bf16(bf2f(gv.y & 0xffffu) * a.z, bf2f(gv.y >> 16) * a.w);
                    w.z = pg8::cvt_pk_bf16(bf2f(gv.z & 0xffffu) * b.x, bf2f(gv.z >> 16) * b.y); w.w = pg8::cvt_pk_bf16(bf2f(gv.w & 0xffffu) * b.z, bf2f(gv.w >> 16) * b.w);
                    *(GAS u32x4*)(Y + ro + bj * 128) = w; } }
    }
};
struct EpiMergeB {
    static constexpr bool PERM = true; const bf16* GB; bf16* Y;
    __device__ __forceinline__ void operator()(const f32x4 (&acc)[2][2][4][2], const pg8::Unit& u, int wr, int wc, int fr, int fq) const {
#pragma unroll
        for (int ai = 0; ai < 2; ++ai)
#pragma unroll
            for (int m = 0; m < 4; ++m) { const size_t ro = (size_t)(u.pm * 256 + ai * 128 + wr * 64 + m * 16 + fr) * D + u.pn * 256 + wc * 32 + 8 * fq;
#pragma unroll
                for (int bj = 0; bj < 2; ++bj) { const u32x4 gv = *(const GAS u32x4*)(GB + ro + bj * 128); const u32x4 yv = *(const GAS u32x4*)(Y + ro + bj * 128); const f32x4 a = acc[ai][bj][m][0], b = acc[ai][bj][m][1];
                    u32x4 w; w.x = pg8::cvt_pk_bf16(bf2f(yv.x & 0xffffu) + bf2f(gv.x & 0xffffu) * a.x, bf2f(yv.x >> 16) + bf2f(gv.x >> 16) * a.y);
                    w.y = pg8::cvt_pk_bf16(bf2f(yv.y & 0xffffu) + bf2f(gv.y & 0xffffu) * a.z, bf2f(yv.y >> 16) + bf2f(gv.y >> 16) * a.w);
                    w.z = pg8::cvt_pk_bf16(bf2f(yv.z & 0xffffu) + bf2f(gv.z & 0xffffu) * b.x, bf2f(yv.z >> 16) + bf2f(gv.z >> 16) * b.y);
                    w.w = pg8::cvt_pk_bf16(bf2f(yv.w & 0xffffu) + bf2f(gv.w & 0xffffu) * b.z, bf2f(yv.w >> 16) + bf2f(gv.w >> 16) * b.w);
                    *(GAS u32x4*)(Y + ro + bj * 128) = w; } }
    }
};
struct EpiOut {
    static constexpr bool PERM = false; const float* x; const float* MOD; float* XMID;
    __device__ __forceinline__ void operator()(const f32x4 (&acc)[2][2][4][2], const pg8::Unit& u, int wr, int wc, int fr, int fq) const {
        const int b = (u.pm * 256) / SEQ; const int col0 = u.pn * 256 + wc * 32 + 4 * fq;
        f32x4 g[2][2];
#pragma unroll
        for (int bj = 0; bj < 2; ++bj)
#pragma unroll
            for (int n = 0; n < 2; ++n) g[bj][n] = *(const f32x4*)(MOD + b * 6144 + 2048 + col0 + bj * 128 + n * 16);
#pragma unroll
        for (int ai = 0; ai < 2; ++ai)
#pragma unroll
            for (int m = 0; m < 4; ++m) { const size_t ro = (size_t)(u.pm * 256 + ai * 128 + wr * 64 + m * 16 + fr) * D + col0;
#pragma unroll
                for (int bj = 0; bj < 2; ++bj)
#pragma unroll
                    for (int n = 0; n < 2; ++n) { const f32x4 xv = *(const f32x4*)(x + ro + bj * 128 + n * 16); *(f32x4*)(XMID + ro + bj * 128 + n * 16) = xv + g[bj][n] * acc[ai][bj][m][n]; } }
    }
};
__device__ __forceinline__ void p3_merge_out_mfma(Frame& F, int part) {
    bf16* Y = (bf16*)(F.ws + WS_Y); const bf16* GA = (const bf16*)F.out;
    if (part == 0) {
        { pg8::Gemm g{(const bf16*)(F.ws + WS_QA), (const bf16*)(F.ws + WS_WA), D, D, D}; pg8::DenseOrder S; S.init(T, D, F.G, F.bid, D); EpiMergeA E{GA, Y}; pg8::gemm_phase<EpiMergeA, pg8::DenseOrder>(F.lds, g, S, E); }
        asm volatile("s_waitcnt vmcnt(0)" ::: "memory"); __syncthreads();
        { pg8::Gemm g{(const bf16*)(F.ws + WS_QB), (const bf16*)(F.ws + WS_WB), 512, 512, 512}; pg8::DenseOrder S; S.init(T, D, F.G, F.bid, 512); EpiMergeB E{GA + (size_t)T * D, Y}; pg8::gemm_phase<EpiMergeB, pg8::DenseOrder>(F.lds, g, S, E); }
    } else {
        pg8::Gemm g{Y, (const bf16*)(F.ws + WS_WO), D, D, D}; pg8::DenseOrder S; S.init(T, D, F.G, F.bid, D);
        EpiOut E{F.in[0], (const float*)(F.ws + WS_MOD), (float*)(F.ws + WS_XMID)}; pg8::gemm_phase<EpiOut, pg8::DenseOrder>(F.lds, g, S, E);
    }
}

constexpr int MOE_TAB_OFF = 132096;
struct MoeTab { LAS int* cnt; LAS int* tpre; LAS int* sbase; };
__device__ __forceinline__ MoeTab moe_tables(Frame& F) {
    MoeTab G; G.cnt = (LAS int*)(F.lds + MOE_TAB_OFF); G.tpre = G.cnt + 64; G.sbase = G.tpre + 65;
    __syncthreads();
    if (F.tid < 64) G.cnt[F.tid] = (int)__hip_atomic_load(F.ctl + CW_CNT + 64 * F.tid, __ATOMIC_RELAXED, __HIP_MEMORY_SCOPE_AGENT);
    __syncthreads();
    if (F.tid == 0) { int tp = 0; for (int g = 0; g < 64; ++g) { G.tpre[g] = tp; G.sbase[g] = tp * 256; tp += (G.cnt[g] + 255) / 256; } G.tpre[64] = tp; }
    __syncthreads();
    return G;
}
struct MoeOrder {
    MoeTab G; int t_lo, t_hi, Gn, c; const int* LIST; int ldb; bool gather;
    __device__ __forceinline__ bool next(int i, pg8::Unit& u) const {
        const long L = (long)i * Gn + c; const int tile = t_lo + (int)(L >> 2); if (tile >= t_hi) return false;
        int g = 0;
        for (int k = 0; k < 64; ++k) g += (G.tpre[k + 1] <= tile) ? 1 : 0;
        u.pm = tile - G.tpre[g]; u.pn = (int)(L & 3); u.a0 = g; u.a1 = tile * 256; return true;
    }
    __device__ __forceinline__ int arow(const pg8::Unit& u, int r) const {
        if (!gather) return u.a1 + r;
        const int idx = u.pm * 256 + r; const int cnt = G.cnt[u.a0]; return LIST[(size_t)u.a0 * T + (idx < cnt ? idx : 0)];
    }
    __device__ __forceinline__ size_t boff(const pg8::Unit& u) const { return ((size_t)(u.a0 & 31) * 1024 + (size_t)u.pn * 256) * ldb; }
};
struct EpiGateUp {
    static constexpr bool PERM = true; bf16* HID;
    __device__ __forceinline__ void operator()(const f32x4 (&acc)[2][2][4][2], const pg8::Unit& u, int wr, int wc, int fr, int fq) const {
#pragma unroll
        for (int ai = 0; ai < 2; ++ai)
#pragma unroll
            for (int m = 0; m < 4; ++m) { const size_t ro = (size_t)(u.a1 + ai * 128 + wr * 64 + m * 16 + fr) * EH + u.pn * 128 + wc * 32 + 8 * fq;
                const f32x4 ga = acc[ai][0][m][0], gb = acc[ai][0][m][1], ua = acc[ai][1][m][0], ub = acc[ai][1][m][1];
                u32x4 w; w.x = pg8::cvt_pk_bf16(silu_f(ga.x) * ua.x, silu_f(ga.y) * ua.y); w.y = pg8::cvt_pk_bf16(silu_f(ga.z) * ua.z, silu_f(ga.w) * ua.w);
                w.z = pg8::cvt_pk_bf16(silu_f(gb.x) * ub.x, silu_f(gb.y) * ub.y); w.w = pg8::cvt_pk_bf16(silu_f(gb.z) * ub.z, silu_f(gb.w) * ub.w);
                *(GAS u32x4*)(HID + ro) = w; }
    }
};
struct EpiDown {
    static constexpr bool PERM = false; MoeTab G; const int* LIST; const float* RT; const float* MOD; const float* base; float* out; int kk;
    __device__ __forceinline__ void operator()(const f32x4 (&acc)[2][2][4][2], const pg8::Unit& u, int wr, int wc, int fr, int fq) const {
        const int cnt = G.cnt[u.a0]; const int col0 = u.pn * 256 + wc * 32 + 4 * fq;
#pragma unroll
        for (int ai = 0; ai < 2; ++ai)
#pragma unroll
            for (int m = 0; m < 4; ++m) { const int idx = u.pm * 256 + ai * 128 + wr * 64 + m * 16 + fr;
                if (idx < cnt) { const int tok = LIST[(size_t)u.a0 * T + idx]; const int b = tok / SEQ; const float w = RT[(size_t)tok * 4 + kk]; const size_t ro = (size_t)tok * D + col0;
#pragma unroll
                    for (int bj = 0; bj < 2; ++bj)
#pragma unroll
                        for (int n = 0; n < 2; ++n) { const f32x4 g2 = *(const f32x4*)(MOD + b * 6144 + 5120 + col0 + bj * 128 + n * 16); const f32x4 bv = *(const f32x4*)(base + ro + bj * 128 + n * 16);
                            *(f32x4*)(out + ro + bj * 128 + n * 16) = bv + g2 * w * acc[ai][bj][m][n]; } } }
    }
};
__device__ __forceinline__ void p4_moe_mfma(Frame& F, int part) {
    const MoeTab G = moe_tables(F); const int* LIST = (const int*)(F.ws + WS_LIST);
    if (part == 0) {
        pg8::Gemm g{(const bf16*)(F.ws + WS_H2), (const bf16*)(F.ws + WS_WGU), D, D, D};
        MoeOrder S{G, 0, G.tpre[64], F.G, F.bid, LIST, D, true}; EpiGateUp E{(bf16*)(F.ws + WS_HID)};
        pg8::gemm_phase<EpiGateUp, MoeOrder>(F.lds, g, S, E);
    } else {
        const int kk = part - 1;
        pg8::Gemm g{(const bf16*)(F.ws + WS_HID), (const bf16*)(F.ws + WS_WD), EH, EH, EH};
        MoeOrder S{G, G.tpre[32 * kk], G.tpre[32 * kk + 32], F.G, F.bid, LIST, EH, false};
        EpiDown E{G, LIST, (const float*)(F.ws + WS_RT), (const float*)(F.ws + WS_MOD), kk == 0 ? (const float*)(F.ws + WS_XMID) : (const float*)F.out, F.out, kk};
        pg8::gemm_phase<EpiDown, MoeOrder>(F.lds, g, S, E);
    }
}

constexpr int NPHASE = 11;
__global__ void __launch_bounds__(NTHR, 2) mk_fwd(Args args) {
    extern __shared__ __attribute__((aligned(16))) unsigned char lds[];
    Frame F;
    F.lds = (LAS unsigned char*)lds; F.ws = args.ws; F.ctl = (gu32*)(args.ws + WS_CTL);
    F.tid = threadIdx.x; F.lane = F.tid & 63; F.wave = __builtin_amdgcn_readfirstlane(F.tid >> 6); F.G = gridDim.x; F.bid = blockIdx.x;
#pragma unroll
    for (int i = 0; i < 29; ++i) F.in[i] = args.in[i];
    F.out = args.out;
    volatile LAS unsigned* MISC = (volatile LAS unsigned*)(F.lds + LDS_BYTES - 64);
    if (F.tid < 16) MISC[F.tid] = 0u;
    __syncthreads();
    XcdBarrier bar; bar.bar = (unsigned*)(F.ctl + CW_BAR); bar.x = 0; bar.st = nullptr;
    if (MK_N_LAUNCHES == 1) bar = xcd_barrier_post((unsigned*)(F.ctl + CW_BAR), MISC);
    const int lo = args.ph_lo, hi = args.ph_hi;
#ifndef PH_MASK
#define PH_MASK 0x7ff
#endif
#define IN(k) (((PH_MASK >> (k)) & 1) && lo <= (k) && (k) < hi)
#define SEAM(k) do { if (IN(k) && IN((k) + 1)) xcd_barrier(bar); } while (0)
    if (IN(0)) { p0_adaln_rope(F); p0_weights(F); }
    SEAM(0);
    if (IN(1)) p1a_norm1(F);
    SEAM(1);
#ifdef NAIVE_INPROJ
    if (IN(2)) p1b_inproj(F);
#else
    if (IN(2)) p1b_inproj_mfma(F);
#endif
    SEAM(2);
#ifdef NAIVE_DATTN
    if (IN(3)) p2a_diffattn(F);
#else
    if (IN(3)) p2a_diffattn_mfma(F);
#endif
    SEAM(3);
    if (IN(4)) p2b_natten(F);
    SEAM(4);
#ifdef NAIVE_MERGE
    if (IN(5)) p3a_merge(F);
#else
    if (IN(5)) p3_merge_out_mfma(F, 0);
#endif
    SEAM(5);
#ifdef NAIVE_MERGE
    if (IN(6)) p3b_out(F);
#else
    if (IN(6)) p3_merge_out_mfma(F, 1);
#endif
    SEAM(6);
    if (IN(7)) p4a_norm2_route(F);
    SEAM(7);
#ifdef NAIVE_MOE
    if (IN(8)) p4b_gateup(F);
#else
    if (IN(8)) p4_moe_mfma(F, 0);
#endif
    SEAM(8);
#ifdef NAIVE_MOE
    if (IN(9)) p4c_down(F, 0);
#else
    if (IN(9)) p4_moe_mfma(F, 1);
#endif
    SEAM(9);
#ifdef NAIVE_MOE
    if (IN(10)) p4c_down(F, 1);
#else
    if (IN(10)) p4_moe_mfma(F, 2);
#endif
#undef IN
#undef SEAM
}

extern "C" void kernel_launch(void* const* d_in, const int* in_sizes, int n_in, void* d_out, int out_size, void* d_ws, size_t ws_size, hipStream_t stream) {
    static int grid = 0;
    if (grid == 0) {
        if (n_in != 29 || out_size != T * D || ws_size < WS_END) { fprintf(stderr, "kernel_launch: unexpected shapes: n_in %d out %d ws %zu\n", n_in, out_size, ws_size); grid = -1; return; }
        int dev = 0, cus = 0, per_cu = 0;
        if (hipGetDevice(&dev) != hipSuccess || hipDeviceGetAttribute(&cus, hipDeviceAttributeMultiprocessorCount, dev) != hipSuccess) { grid = -1; return; }
        if (hipFuncSetAttribute((const void*)mk_fwd, hipFuncAttributeMaxDynamicSharedMemorySize, LDS_BYTES) != hipSuccess) { fprintf(stderr, "kernel_launch: hipFuncSetAttribute failed\n"); grid = -1; return; }
        if (hipOccupancyMaxActiveBlocksPerMultiprocessor(&per_cu, (const void*)mk_fwd, NTHR, LDS_BYTES) != hipSuccess || per_cu < 1) fprintf(stderr, "kernel_launch: occupancy query says %d\n", per_cu);
        (void)hipGetLastError();
        grid = cus;
    }
    if (grid < 0) return;
    if (hipMemsetAsync((char*)d_ws + WS_CTL, 0, CTL_ZERO_BYTES, stream) != hipSuccess) return;
    Args a{};
    for (int i = 0; i < 29; ++i) a.in[i] = (const float*)d_in[i];
    a.out = (float*)d_out; a.ws = (unsigned char*)d_ws;
    if (MK_N_LAUNCHES == 1) { a.ph_lo = 0; a.ph_hi = NPHASE; hipLaunchKernelGGL(mk_fwd, dim3(grid), dim3(NTHR), LDS_BYTES, stream, a); }
    else for (int p = 0; p < NPHASE; ++p) { a.ph_lo = p; a.ph_hi = p + 1; hipLaunchKernelGGL(mk_fwd, dim3(grid), dim3(NTHR), LDS_BYTES, stream, a); }
}
```

```cpp
#include <hip/hip_runtime.h>
#include <cstdio>
#include <cstdint>

#ifndef MK_N_LAUNCHES
#define MK_N_LAUNCHES 1
#endif

constexpr int NB = 4, SEQ = 8192, D = 1024, T = NB * SEQ, CTX = 256, TC = NB * CTX, MROWS = T + TC;
constexpr int KVL = CTX + SEQ;
constexpr int NIN = 6656, GRIDW = 64, NROWS = SEQ / GRIDW;
constexpr int NH = 8, HD = 64;
constexpr int NEXP = 32, EH = 512, NGRP = 4, EPG = 8;
constexpr int NLIST = 64;
constexpr float EPS = 1e-6f;
constexpr float LOG2E = 1.4426950408889634f;
constexpr float C2 = 0.125f * LOG2E;

constexpr size_t MiB = 1u << 20;
constexpr size_t WS_CTL = 0, CTL_ZERO_BYTES = 1 * MiB;
constexpr size_t WS_MOD = 1 * MiB;
constexpr size_t WS_ROPE = 1 * MiB + 256 * 1024;
constexpr size_t WS_RT = 2 * MiB;
constexpr size_t WS_LIST = 4 * MiB;
constexpr size_t WS_WIN = 12 * MiB;
constexpr size_t WS_WA = 25 * MiB, WS_WB = 27 * MiB, WS_WO = 28 * MiB;
constexpr size_t WS_WGU = 30 * MiB;
constexpr size_t WS_WD = 94 * MiB;
constexpr size_t WS_XN = 126 * MiB;
constexpr size_t WS_QA = 192 * MiB;
constexpr size_t WS_QB = 256 * MiB;
constexpr size_t WS_KA = 288 * MiB;
constexpr size_t WS_VA = 354 * MiB;
constexpr size_t WS_KB = 420 * MiB;
constexpr size_t WS_VB = 453 * MiB;
constexpr size_t WS_END = 486 * MiB;
constexpr size_t WS_Y = WS_XN, WS_H2 = WS_XN, WS_HID = WS_QA, WS_XMID = WS_KA;
constexpr int CW_TMO = 0, CW_BAR = 4096, CW_CNT = 16384;

constexpr int LDS_BYTES = 155648;
constexpr int NTHR = 512;

#define GAS __attribute__((address_space(1)))
#define LAS __attribute__((address_space(3)))
typedef unsigned short bf16;
typedef float f32x4 __attribute__((ext_vector_type(4)));
typedef float f32x2 __attribute__((ext_vector_type(2)));
typedef unsigned u32x4 __attribute__((ext_vector_type(4)));
typedef unsigned u32x2 __attribute__((ext_vector_type(2)));
typedef GAS unsigned gu32;

__device__ __forceinline__ unsigned f2bf(float f) { unsigned u = __builtin_bit_cast(unsigned, f); return (u + 0x7fffu + ((u >> 16) & 1u)) >> 16; }
__device__ __forceinline__ float bf2f(unsigned h) { return __builtin_bit_cast(float, h << 16); }
__device__ __forceinline__ float rbf(float f) { return bf2f(f2bf(f)); }
__device__ __forceinline__ unsigned pk2(float lo, float hi) { return f2bf(lo) | (f2bf(hi) << 16); }

#define XB_TMO      128
#define XB_XCNT(j)  (256  + 64 * (j))
#define XB_XSUB(j)  (1280 + 64 * (j))
#define XB_XGEN(j)  (2304 + 64 * (j))
#define XB_TOP      3328
#define XB_TOPGEN   3392
#define XCD_BAR_WORDS 3456
#define XB_SPIN_CAP (1u << 18)
__device__ __forceinline__ unsigned xb_ld(unsigned* p)              { return __hip_atomic_load(p, __ATOMIC_RELAXED, __HIP_MEMORY_SCOPE_AGENT); }
__device__ __forceinline__ unsigned xb_add(unsigned* p, unsigned v) { return __hip_atomic_fetch_add(p, v, __ATOMIC_RELAXED, __HIP_MEMORY_SCOPE_AGENT); }
__device__ __forceinline__ unsigned xb_xcc_id() { return (unsigned)__builtin_amdgcn_s_getreg((3 << 11) | 20) & 0xFu; }
#define XB_SPIN(cond, bar) do { unsigned _sp = 0; while (cond) { __builtin_amdgcn_s_sleep(1); \
    if ((++_sp & 255u) == 0u) { if (xb_ld(&(bar)[XB_TMO])) break; if (_sp > XB_SPIN_CAP) { atomicAdd(&(bar)[XB_TMO], 1u); break; } } } } while (0)
struct XcdBarrier { unsigned* bar; unsigned x; volatile LAS unsigned* st; };
__device__ __forceinline__ XcdBarrier xcd_barrier_post(unsigned* bar, volatile LAS unsigned* st) {
    XcdBarrier b; b.bar = bar; b.x = xb_xcc_id(); b.st = st;
    if (threadIdx.x == 0) (void)xb_add(&bar[XB_XCNT(b.x)], 1u);
    return b;
}
__device__ __forceinline__ void xcd_barrier_complete(unsigned* bar, unsigned x, unsigned& nloc, unsigned& nx) {
    const unsigned G = gridDim.x * gridDim.y * gridDim.z;
    unsigned sum, cnt, mine, sp = 0u;
    for (;;) {
        sum = 0u; cnt = 0u; mine = 0u;
#pragma unroll
        for (unsigned j = 0; j < 16; ++j) { const unsigned c = xb_ld(&bar[XB_XCNT(j)]); sum += c; cnt += (c > 0u) ? 1u : 0u; mine = (j == x) ? c : mine; }
        if (sum == G) break;
        __builtin_amdgcn_s_sleep(1);
        if ((++sp & 255u) == 0u) { if (xb_ld(&bar[XB_TMO])) break; if (sp > XB_SPIN_CAP) { atomicAdd(&bar[XB_TMO], 1u); break; } }
    }
    nloc = mine > 0u ? mine : 1u; nx = cnt > 0u ? cnt : 1u;
}
__device__ __forceinline__ void xcd_barrier(const XcdBarrier& b) {
    asm volatile("s_waitcnt vmcnt(0)" ::: "memory");
    __syncthreads();
    if (threadIdx.x == 0) {
        unsigned* bar = b.bar;
        __builtin_amdgcn_s_waitcnt(0);
        unsigned nloc = b.st[0], nx = b.st[1];
        if (nloc == 0u) { xcd_barrier_complete(bar, b.x, nloc, nx); b.st[0] = nloc; b.st[1] = nx; }
        const unsigned old = xb_add(&bar[XB_XSUB(b.x)], 1u);
        const unsigned gen = old / nloc;
        if (old + 1u == (gen + 1u) * nloc) {
            __builtin_amdgcn_fence(__ATOMIC_RELEASE, "agent");
            asm volatile("s_waitcnt vmcnt(0)" ::: "memory");
            const unsigned og = xb_add(&bar[XB_TOP], 1u);
            const unsigned tg = og / nx;
            if (og + 1u == (tg + 1u) * nx) xb_add(&bar[XB_TOPGEN], 1u);
            else XB_SPIN(xb_ld(&bar[XB_TOPGEN]) == tg, bar);
            __builtin_amdgcn_fence(__ATOMIC_ACQUIRE, "agent");
            xb_add(&bar[XB_XGEN(b.x)], 1u);
            asm volatile("s_waitcnt vmcnt(0)" ::: "memory");
        } else {
            XB_SPIN(xb_ld(&bar[XB_XGEN(b.x)]) == gen, bar);
            __builtin_amdgcn_fence(__ATOMIC_ACQUIRE, "agent");
            asm volatile("s_waitcnt vmcnt(0)" ::: "memory");
        }
    }
    __syncthreads();
}

namespace pg8 {
#define PG8_LAS __attribute__((address_space(3)))
typedef unsigned short bf16_t;
typedef short bf16x8 __attribute__((ext_vector_type(8)));
constexpr int BM = 256, BK = 64, HALF = 128, HTB = HALF * BK * 2, STAGE_BYTES = 8 * HTB, NXCD = 8, WGM = 8;
__host__ __device__ __forceinline__ int lds_byte(int r, int c) { const int st = (r >> 4) * 2 + (c >> 5), rr = r & 15, cc = c & 31, ob = rr * 64 + cc * 2; return st * 1024 + (ob ^ (((ob >> 9) & 1) << 5)); }
__host__ __device__ __forceinline__ void stage_rc(int b, int& R, int& C) { const int st = b / 1024, sb = b % 1024, swz = sb ^ (((sb >> 9) & 1) << 5); R = (st >> 1) * 16 + swz / 64; C = (st & 1) * 32 + (swz % 64) / 2; }
__host__ __device__ __forceinline__ int perm32(int rho) { const int n = rho >> 4, i = rho & 15; return 8 * (i >> 2) + 4 * n + (i & 3); }
struct Unit { int pm, pn, a0, a1; };
struct Gemm { const bf16_t* A; const bf16_t* Bt; int lda, ldb, K; };
__device__ __forceinline__ unsigned cvt_pk_bf16(float lo, float hi) { unsigned r; asm volatile("v_cvt_pk_bf16_f32 %0, %1, %2" : "=v"(r) : "v"(lo), "v"(hi)); return r; }

struct DenseOrder {
    int nM, nN, nwg, G, c, ldb;
    __device__ void init(int M, int N, int G_, int c_, int ldb_) { nM = M / BM; nN = N / BM; nwg = nM * nN; G = G_; c = c_; ldb = ldb_; }
    __device__ __forceinline__ bool map(long L, Unit& u) const {
        if (L >= nwg) return false;
        int wgid = (int)L; { const int q = nwg / NXCD, r = nwg % NXCD, xcd = wgid % NXCD, off = wgid / NXCD; wgid = (xcd < r ? xcd * (q + 1) : r * (q + 1) + (xcd - r) * q) + off; }
        const int nig = WGM * nN, gid = wgid / nig, fm = gid * WGM, gsz = (nM - fm) < WGM ? (nM - fm) : WGM;
        u.pm = fm + ((wgid % nig) % gsz); u.pn = (wgid % nig) / gsz; u.a0 = 0; u.a1 = 0; return true;
    }
    __device__ __forceinline__ bool next(int i, Unit& u) const { return map((long)i * G + c, u); }
    __device__ __forceinline__ int arow(const Unit& u, int r) const { return u.pm * BM + r; }
    __device__ __forceinline__ size_t boff(const Unit& u) const { return (size_t)u.pn * BM * ldb; }
};

template <class Epi, class Sched>
__device__ __forceinline__ void gemm_phase(PG8_LAS unsigned char* lds, const Gemm g, const Sched& S, const Epi& E) {
    const int tid = threadIdx.x, wid = __builtin_amdgcn_readfirstlane(tid >> 6), lane = tid & 63, wr = wid >> 2, wc = wid & 3, fr = lane & 15, fq = lane >> 4;
    const int nt = g.K / BK;
    int RA[2], CA[2]; unsigned voffB[2];
#pragma unroll
    for (int i = 0; i < 2; ++i) { int R, C; stage_rc(tid * 16 + i * 8192, R, C); const int Rb = Epi::PERM ? ((R & ~31) + perm32(R & 31)) : R;
        RA[i] = R; CA[i] = C * 2; voffB[i] = (unsigned)(Rb * g.ldb + C) * 2u; }
    const size_t kstep = (size_t)(BK * 2);
    const size_t hstepB = (size_t)HALF * g.ldb * 2;
    const unsigned ldsw = (unsigned)wid * 1024u;
    const int aoff = lds_byte(wr * 64 + fr, fq * 8), boff = lds_byte(wc * 32 + fr, fq * 8);
#define PG8_SA(b, h) (((b) * 2 + (h)) * HTB)
#define PG8_SB(b, h) ((4 + (b) * 2 + (h)) * HTB)
#define PG8_STAGE(bufoff, gbase, voff) do { _Pragma("unroll") for (int _i = 0; _i < 2; ++_i) \
        __builtin_amdgcn_global_load_lds((const unsigned*)((const char*)(gbase) + (voff)[_i]), (PG8_LAS unsigned*)(lds + (bufoff) + ldsw + _i * 8192), 16, 0, 0); } while (0)
#define PG8_LDA(dst, b, h) do { _Pragma("unroll") for (int m = 0; m < 4; ++m) _Pragma("unroll") for (int k = 0; k < 2; ++k) dst[m][k] = *(const PG8_LAS bf16x8*)(lds + PG8_SA(b, h) + aoff + m * 2048 + k * 1024); } while (0)
#define PG8_LDB(dst, b, h) do { _Pragma("unroll") for (int n = 0; n < 2; ++n) _Pragma("unroll") for (int k = 0; k < 2; ++k) dst[n][k] = *(const PG8_LAS bf16x8*)(lds + PG8_SB(b, h) + boff + n * 2048 + k * 1024); } while (0)
#define PG8_MMA(ai, bj, At, Bt) do { __builtin_amdgcn_s_setprio(1); _Pragma("unroll") for (int m = 0; m < 4; ++m) _Pragma("unroll") for (int n = 0; n < 2; ++n) _Pragma("unroll") for (int k = 0; k < 2; ++k) \
        acc[ai][bj][m][n] = __builtin_amdgcn_mfma_f32_16x16x32_bf16(Bt[n][k], At[m][k], acc[ai][bj][m][n], 0, 0, 0); __builtin_amdgcn_s_setprio(0); } while (0)
#define PG8_WAIT_V(n) asm volatile("s_waitcnt vmcnt(" #n ")" ::: "memory")
#define PG8_WAIT_L(n) asm volatile("s_waitcnt lgkmcnt(" #n ")" ::: "memory")
#define PG8_BAR __builtin_amdgcn_s_barrier()
#define PG8_SCHED __builtin_amdgcn_sched_barrier(0)
#define PG8_AOFFS(dst, u) do { _Pragma("unroll") for (int _h = 0; _h < 2; ++_h) _Pragma("unroll") for (int _i = 0; _i < 2; ++_i) \
        dst[_h][_i] = (unsigned)S.arow(u, _h * HALF + RA[_i]) * (unsigned)(g.lda * 2) + (unsigned)CA[_i]; } while (0)
    Unit cur, nxt; int ui = 0;
    if (!S.next(0, cur)) return;
    f32x4 acc[2][2][4][2];
#pragma unroll
    for (int a = 0; a < 2; ++a)
#pragma unroll
        for (int b = 0; b < 2; ++b)
#pragma unroll
            for (int m = 0; m < 4; ++m)
#pragma unroll
                for (int n = 0; n < 2; ++n) acc[a][b][m][n] = (f32x4){0.f, 0.f, 0.f, 0.f};
    bf16x8 At[4][2], B0[2][2], B1[2][2];
    unsigned oc[2][2], on[2][2];
    PG8_AOFFS(oc, cur);
    const char* gA = (const char*)g.A;
    const char* cB = (const char*)g.Bt + S.boff(cur) * 2;
    PG8_STAGE(PG8_SB(0, 0), cB, voffB); PG8_STAGE(PG8_SB(0, 1), cB + hstepB, voffB); PG8_STAGE(PG8_SA(0, 0), gA, oc[0]); PG8_STAGE(PG8_SA(0, 1), gA, oc[1]);
    if (wr == 1) PG8_BAR;
    PG8_WAIT_V(2); PG8_BAR;
    PG8_STAGE(PG8_SB(1, 0), cB + kstep, voffB); PG8_STAGE(PG8_SA(1, 0), gA + kstep, oc[0]); PG8_STAGE(PG8_SB(1, 1), cB + hstepB + kstep, voffB);
    PG8_WAIT_V(6); PG8_BAR;
    for (;;) {
        const bool has_next = S.next(ui + 1, nxt);
        if (has_next) { PG8_AOFFS(on, nxt); } else {
#pragma unroll
            for (int _h = 0; _h < 2; ++_h)
#pragma unroll
                for (int _i = 0; _i < 2; ++_i) on[_h][_i] = oc[_h][_i]; }
        const char* nB = has_next ? (const char*)g.Bt + S.boff(nxt) * 2 : cB;
        for (int t = 0; t < nt; t += 2) {
            const bool last = (t == nt - 2);
            const char* a1 = gA + (size_t)(t + 1) * kstep;
            const char* a2 = last ? gA : gA + (size_t)(t + 2) * kstep; const char* b2 = last ? nB : cB + (size_t)(t + 2) * kstep;
            const char* a3 = a2 + kstep; const char* b3 = b2 + kstep;
            unsigned os[2][2];
#pragma unroll
            for (int _h = 0; _h < 2; ++_h)
#pragma unroll
                for (int _i = 0; _i < 2; ++_i) os[_h][_i] = last ? on[_h][_i] : oc[_h][_i];
            PG8_LDB(B0, 0, 0); PG8_LDB(B1, 0, 1); PG8_SCHED; PG8_LDA(At, 0, 0); PG8_STAGE(PG8_SA(1, 1), a1, oc[1]);
            PG8_WAIT_V(8); PG8_WAIT_L(0); PG8_BAR; PG8_MMA(0, 0, At, B0); PG8_MMA(0, 1, At, B1); PG8_BAR; PG8_SCHED;
            PG8_LDA(At, 0, 1); PG8_STAGE(PG8_SB(0, 0), b2, voffB); PG8_STAGE(PG8_SB(0, 1), b2 + hstepB, voffB); PG8_STAGE(PG8_SA(0, 0), a2, os[0]);
            PG8_WAIT_V(8); PG8_WAIT_L(0); PG8_BAR; PG8_MMA(1, 0, At, B0); PG8_MMA(1, 1, At, B1); PG8_BAR; PG8_SCHED;
            PG8_LDB(B0, 1, 0); PG8_LDB(B1, 1, 1); PG8_SCHED; PG8_LDA(At, 1, 0); PG8_STAGE(PG8_SA(0, 1), a2, os[1]);
            PG8_WAIT_V(8); PG8_WAIT_L(0); PG8_BAR; PG8_MMA(0, 0, At, B0); PG8_MMA(0, 1, At, B1); PG8_BAR; PG8_SCHED;
            PG8_LDA(At, 1, 1); PG8_STAGE(PG8_SB(1, 0), b3, voffB); PG8_STAGE(PG8_SB(1, 1), b3 + hstepB, voffB); PG8_STAGE(PG8_SA(1, 0), a3, os[0]);
            PG8_WAIT_V(8); PG8_WAIT_L(0); PG8_BAR; PG8_MMA(1, 0, At, B0); PG8_MMA(1, 1, At, B1); PG8_BAR; PG8_SCHED;
        }
        if (wr == 0) PG8_BAR;
        E(acc, cur, wr, wc, fr, fq);
        if (!has_next) break;
#pragma unroll
        for (int a = 0; a < 2; ++a)
#pragma unroll
            for (int b = 0; b < 2; ++b)
#pragma unroll
                for (int m = 0; m < 4; ++m)
#pragma unroll
                    for (int n = 0; n < 2; ++n) acc[a][b][m][n] = (f32x4){0.f, 0.f, 0.f, 0.f};
        cur = nxt; cB = nB; ++ui;
#pragma unroll
        for (int _h = 0; _h < 2; ++_h)
#pragma unroll
            for (int _i = 0; _i < 2; ++_i) oc[_h][_i] = on[_h][_i];
        if (wr == 1) PG8_BAR;
    }
    PG8_WAIT_V(0);
    PG8_BAR;
#undef PG8_SA
#undef PG8_SB
#undef PG8_STAGE
#undef PG8_LDA
#undef PG8_LDB
#undef PG8_MMA
#undef PG8_WAIT_V
#undef PG8_WAIT_L
#undef PG8_BAR
#undef PG8_SCHED
#undef PG8_AOFFS
}
}

struct Args { const float* in[29]; float* out; unsigned char* ws; int ph_lo, ph_hi; };
struct Frame {
    LAS unsigned char* lds;
    unsigned char* ws; gu32* ctl;
    int tid, lane, wave, G, bid;
    const float* in[29];
    float* out;
};
__device__ __forceinline__ float wave_sum(float v) {
#pragma unroll
    for (int o = 1; o < 64; o <<= 1) v += __shfl_xor(v, o);
    return v;
}
__device__ __forceinline__ float silu_f(float v) { return v / (1.f + __expf(-v)); }
__device__ __forceinline__ float sigmoid_f(float v) { return 1.f / (1.f + __expf(-v)); }

__constant__ float INV_FREQ[16] = {1.0f, 0.5623413324356079f, 0.3162277638912201f, 0.17782793939113617f, 0.10000000149011612f, 0.05623413249850273f, 0.03162277489900589f, 0.017782794311642647f,
    0.009999999776482582f, 0.005623413249850273f, 0.003162277629598975f, 0.0017782794311642647f, 0.0010000000474974513f, 0.000562341301701963f, 0.0003162277571391314f, 0.00017782794020604342f};
__device__ __forceinline__ double sin_poly(double r) { double r2 = r * r, t = r, s = r; for (int i = 1; i <= 12; ++i) { t *= -r2 / (double)((2 * i) * (2 * i + 1)); s += t; } return s; }
__device__ __forceinline__ double cos_poly(double r) { double r2 = r * r, t = 1.0, s = 1.0; for (int i = 1; i <= 12; ++i) { t *= -r2 / (double)((2 * i - 1) * (2 * i)); s += t; } return s; }
__device__ __forceinline__ void p0_adaln_rope(Frame& F) {
    const float* c = F.in[1]; const float* c_ctx = F.in[3]; const float* w_ada = F.in[4]; const float* b_ada = F.in[5];
    float* MOD = (float*)(F.ws + WS_MOD);
    { float* RP = (float*)(F.ws + WS_ROPE);
      const int gi = F.bid * NTHR + F.tid;
      if (gi < 192 * 16) { const int pos = gi >> 4, f = gi & 15; const int p = pos < 128 ? pos : pos - 128;
          const float invf = INV_FREQ[f]; const float ang = (float)p * invf;
          const double a = (double)ang; const double k = rint(a * 0.15915494309189535); const double r = a - k * 6.283185307179586477;
          const float cs = (float)cos_poly(r), sn = (float)sin_poly(r);
          if (pos < 128) { RP[pos * 16 + f] = cs; RP[2048 + pos * 16 + f] = sn; } else { RP[4096 + p * 16 + f] = cs; RP[4096 + 1024 + p * 16 + f] = sn; } } }
    if (F.bid < 96) {
        LAS float* S = (LAS float*)F.lds;
        LAS float* R = S + 5 * 1024;
        for (int i = F.tid; i < 5 * 1024; i += NTHR) { const int r = i >> 10, k = i & 1023; const float v = r < 4 ? c[r * 1024 + k] : c_ctx[k]; S[i] = silu_f(v); }
        __syncthreads();
        for (int item = F.bid; item < 96; item += F.G) {
            const int c0 = item * 64; float acc[5] = {0.f, 0.f, 0.f, 0.f, 0.f};
            for (int kk = 0; kk < 128; ++kk) { const int k = F.wave * 128 + kk; const float w = w_ada[(size_t)k * 6144 + c0 + F.lane];
#pragma unroll
                for (int r = 0; r < 5; ++r) acc[r] += S[r * 1024 + k] * w; }
#pragma unroll
            for (int r = 0; r < 5; ++r) R[(F.wave * 5 + r) * 64 + F.lane] = acc[r];
            __syncthreads();
            if (F.tid < 320) { const int r = F.tid >> 6, l = F.tid & 63; float s = 0.f;
#pragma unroll
                for (int w = 0; w < 8; ++w) s += R[(w * 5 + r) * 64 + l];
                MOD[r * 6144 + c0 + l] = s + b_ada[c0 + l]; }
            __syncthreads();
        }
    }
}

__device__ __forceinline__ void norm_mod_row(const float* xrow, const float* nw, const float* scale, const float* shift, int lane, f32x4 (&v)[4]) {
    const GAS f32x4* xr = (const GAS f32x4*)xrow + lane; float ss = 0.f;
#pragma unroll
    for (int j = 0; j < 4; ++j) { v[j] = xr[64 * j]; ss += (v[j].x * v[j].x + v[j].y * v[j].y) + (v[j].z * v[j].z + v[j].w * v[j].w); }
    const float rstd = 1.0f / sqrtf(wave_sum(ss) * (1.f / D) + EPS);
#pragma unroll
    for (int j = 0; j < 4; ++j) { const int d0 = 4 * lane + 256 * j; const f32x4 w = *(const f32x4*)(nw + d0), sc = *(const f32x4*)(scale + d0), sh = *(const f32x4*)(shift + d0);
        v[j] = (v[j] * rstd * w) * (1.f + sc) + sh; }
}
__device__ __forceinline__ void store_row_bf16(bf16* orow, int lane, const f32x4 (&v)[4]) {
    GAS u32x2* o8 = (GAS u32x2*)orow + lane;
#pragma unroll
    for (int j = 0; j < 4; ++j) { u32x2 w; w.x = pk2(v[j].x, v[j].y); w.y = pk2(v[j].z, v[j].w); o8[64 * j] = w; }
}
__device__ __forceinline__ void p1a_norm1(Frame& F) {
    const float* x = F.in[0]; const float* ctx = F.in[2]; const float* nw = F.in[6];
    const float* MOD = (const float*)(F.ws + WS_MOD); bf16* XN = (bf16*)(F.ws + WS_XN);
    const int gw = F.bid * 8 + F.wave, NGW = F.G * 8;
    for (int m = gw; m < MROWS; m += NGW) {
        const float* row; int mr;
        if (m < T) { row = x + (size_t)m * D; mr = m / SEQ; } else { row = ctx + (size_t)(m - T) * D; mr = 4; }
        f32x4 v[4]; norm_mod_row(row, nw, MOD + mr * 6144 + 1024, MOD + mr * 6144, F.lane, v);
        store_row_bf16(XN + (size_t)m * D, F.lane, v);
    }
}

constexpr int NG_AS = 16 * 132, NG_BS = 16 * 68;
template <class AF, class BF>
__device__ __forceinline__ void gemm_core(float (&acc)[4][4], LAS float* As, LAS float* Bs, int K, int tid, const AF& af, const BF& bf) {
    const int ty = tid >> 4, tx = tid & 15;
    const int ar = tid >> 2, ak = (tid & 3) * 4;
    const int bk = tid >> 5, bn = (tid & 31) * 2;
    for (int k0 = 0; k0 < K; k0 += 16) {
        const u32x2 av = *(const GAS u32x2*)af(ar, k0 + ak);
        const f32x2 bv = bf(k0 + bk, bn);
        __syncthreads();
        As[(ak + 0) * 132 + ar] = bf2f(av.x & 0xffffu); As[(ak + 1) * 132 + ar] = bf2f(av.x >> 16);
        As[(ak + 2) * 132 + ar] = bf2f(av.y & 0xffffu); As[(ak + 3) * 132 + ar] = bf2f(av.y >> 16);
        Bs[bk * 68 + bn] = rbf(bv.x); Bs[bk * 68 + bn + 1] = rbf(bv.y);
        __syncthreads();
#pragma unroll
        for (int kk = 0; kk < 16; ++kk) {
            const f32x4 a = *(const LAS f32x4*)(As + kk * 132 + ty * 4), b = *(const LAS f32x4*)(Bs + kk * 68 + tx * 4);
#pragma unroll
            for (int i = 0; i < 4; ++i)
#pragma unroll
                for (int j = 0; j < 4; ++j) acc[i][j] += a[i] * b[j];
        }
    }
    __syncthreads();
}
__device__ __forceinline__ void zero_acc(float (&acc)[4][4]) {
#pragma unroll
    for (int i = 0; i < 4; ++i)
#pragma unroll
        for (int j = 0; j < 4; ++j) acc[i][j] = 0.f;
}

__device__ __forceinline__ int kv_row(int m) { if (m < T) { const int b = m / SEQ, t = m - b * SEQ; return b * KVL + CTX + t; } const int cm = m - T, b = cm / CTX, c = cm - b * CTX; return b * KVL + c; }

__device__ __forceinline__ void p1b_inproj(Frame& F) {
    const float* w_in = F.in[8];
    const bf16* XN = (const bf16*)(F.ws + WS_XN);
    LAS float* As = (LAS float*)F.lds; LAS float* Bs = As + NG_AS; LAS float* Ct = Bs + NG_BS;
    const float* RP = (const float*)(F.ws + WS_ROPE);
    bf16* QA = (bf16*)(F.ws + WS_QA); bf16* KA = (bf16*)(F.ws + WS_KA); bf16* VA = (bf16*)(F.ws + WS_VA);
    bf16* QB = (bf16*)(F.ws + WS_QB); bf16* KB = (bf16*)(F.ws + WS_KB); bf16* VB = (bf16*)(F.ws + WS_VB);
    bf16* GA = (bf16*)F.out; bf16* GB = GA + (size_t)T * D;
    constexpr int NT_LAT = (T / 128) * 104, NT_CTX = (TC / 128) * 48;
    for (int item = F.bid; item < NT_LAT + NT_CTX; item += F.G) {
        int tm, cg;
        if (item < NT_LAT) { tm = item / 104; cg = item % 104; }
        else { const int r = item - NT_LAT; tm = T / 128 + r / 48; const int c = r % 48; cg = c < 32 ? 16 + c : 56 + (c - 32); }
        const int m0 = tm * 128, n0 = cg * 64;
        float acc[4][4]; zero_acc(acc);
        gemm_core(acc, As, Bs, D, F.tid,
                  [&](int row, int k) { return XN + (size_t)(m0 + row) * D + k; },
                  [&](int k, int n) { return *(const f32x2*)(w_in + (size_t)k * NIN + n0 + n); });
        { const int ty = F.tid >> 4, tx = F.tid & 15;
#pragma unroll
          for (int i = 0; i < 4; ++i)
#pragma unroll
              for (int j = 0; j < 4; ++j) Ct[(ty * 4 + i) * 65 + tx * 4 + j] = acc[i][j]; }
        __syncthreads();
        const int row = F.tid >> 2, q4 = F.tid & 3, m = m0 + row; const LAS float* cr = Ct + row * 65;
        float v[16];
#pragma unroll
        for (int i = 0; i < 16; ++i) v[i] = cr[q4 * 16 + i];
        int kind; const float* gain = nullptr; bf16* dst; bool rope = false; float oscale = 1.f;
        if (cg < 16)      { kind = 0; gain = F.in[9];  dst = QA + (size_t)m * D + cg * 64; rope = true; oscale = C2; }
        else if (cg < 32) { kind = 0; gain = F.in[10]; dst = KA + (size_t)kv_row(m) * D + (cg - 16) * 64; rope = (m < T); }
        else if (cg < 48) { kind = 1; dst = VA + (size_t)kv_row(m) * D + (cg - 32) * 64; }
        else if (cg < 56) { kind = 0; gain = F.in[16]; dst = QB + (size_t)m * 512 + (cg - 48) * 64; oscale = C2; }
        else if (cg < 64) { kind = 0; gain = F.in[17]; dst = KB + (size_t)kv_row(m) * 512 + (cg - 56) * 64; }
        else if (cg < 72) { kind = 1; dst = VB + (size_t)kv_row(m) * 512 + (cg - 64) * 64; }
        else if (cg < 88) { kind = 2; dst = GA + (size_t)m * D + (cg - 72) * 64; }
        else              { kind = 2; dst = GB + (size_t)m * D + (cg - 88) * 64; }
        if (kind == 0) {
            float ss = 0.f;
#pragma unroll
            for (int i = 0; i < 16; ++i) ss += v[i] * v[i];
            ss += __shfl_xor(ss, 1); ss += __shfl_xor(ss, 2);
            const float rstd = 1.0f / sqrtf(ss * (1.f / 64.f) + EPS);
#pragma unroll
            for (int i = 0; i < 16; ++i) v[i] = v[i] * rstd * gain[q4 * 16 + i];
            if (rope) {
                const int t = m % SEQ, pr = t / GRIDW, pc = t % GRIDW;
                const float* cs = (q4 < 2) ? RP + pr * 16 : RP + 4096 + pc * 16;
                const float* sn = (q4 < 2) ? RP + 2048 + pr * 16 : RP + 4096 + 1024 + pc * 16;
#pragma unroll
                for (int i = 0; i < 16; ++i) { const float o = __shfl_xor(v[i], 1);
                    v[i] = (q4 & 1) ? (o * sn[i] + v[i] * cs[i]) : (v[i] * cs[i] - o * sn[i]); }
            }
#pragma unroll
            for (int i = 0; i < 16; ++i) v[i] *= oscale;
        } else if (kind == 2) {
#pragma unroll
            for (int i = 0; i < 16; ++i) v[i] = sigmoid_f(v[i]);
        }
        const bool skip = (m >= T) && (cg < 16 || (cg >= 48 && cg < 56) || cg >= 72);
        if (!skip) { u32x4 w0, w1; w0.x = pk2(v[0], v[1]); w0.y = pk2(v[2], v[3]); w0.z = pk2(v[4], v[5]); w0.w = pk2(v[6], v[7]);
            w1.x = pk2(v[8], v[9]); w1.y = pk2(v[10], v[11]); w1.z = pk2(v[12], v[13]); w1.w = pk2(v[14], v[15]);
            *(GAS u32x4*)(dst + q4 * 16) = w0; *(GAS u32x4*)(dst + q4 * 16 + 8) = w1; }
        __syncthreads();
    }
}


__device__ __forceinline__ void p0_transpose_item(const float* W, int K, int N, bf16* WT, int kb, int n0, int dst_row0, LAS float* scr, int lane) {
    const int k0 = 64 * kb;
#pragma unroll 8
    for (int i = 0; i < 32; ++i) { const int kk = 2 * i + (lane >> 5); scr[kk * 33 + (lane & 31)] = W[(size_t)(k0 + kk) * N + n0 + (lane & 31)]; }
    asm volatile("s_waitcnt lgkmcnt(0)" ::: "memory");
    const int c = lane & 7;
#pragma unroll
    for (int j = 0; j < 4; ++j) { const int n = (lane >> 3) + 8 * j; const LAS float* sp = scr + (8 * c) * 33 + n;
        u32x4 o; o.x = pk2(sp[0 * 33], sp[1 * 33]); o.y = pk2(sp[2 * 33], sp[3 * 33]); o.z = pk2(sp[4 * 33], sp[5 * 33]); o.w = pk2(sp[6 * 33], sp[7 * 33]);
        *(GAS u32x4*)(WT + (size_t)(dst_row0 + n) * K + k0 + 8 * c) = o; }
    asm volatile("s_waitcnt lgkmcnt(0)" ::: "memory");
}
__device__ __forceinline__ int inproj_dst_row(int n0) { const int pn = n0 >> 8, w = n0 & 255, g = w >> 6, a = (w >> 5) & 1; return 256 * pn + 128 * a + 32 * g; }
__device__ __forceinline__ void p0_weights(Frame& F) {
    LAS float* scr = (LAS float*)(F.lds + 65536 + F.wave * 8704);
    const int gw = F.bid * 8 + F.wave, NGW = F.G * 8;
    constexpr int I_IN = 16 * 208, I_A = 16 * 32, I_B = 8 * 32, I_O = 16 * 32, I_G = 32 * 16 * 16, I_D = 32 * 8 * 32;
    constexpr int NITEMS = I_IN + I_A + I_B + I_O + 2 * I_G + I_D;
    for (int it = gw; it < NITEMS; it += NGW) {
        int r = it;
        if (r < I_IN) { const int kb = r / 208, n0 = (r % 208) * 32; p0_transpose_item(F.in[8], 1024, NIN, (bf16*)(F.ws + WS_WIN), kb, n0, inproj_dst_row(n0), scr, F.lane); continue; } r -= I_IN;
        if (r < I_A) { const int kb = r / 32, n0 = (r % 32) * 32; p0_transpose_item(F.in[19], 1024, 1024, (bf16*)(F.ws + WS_WA), kb, n0, n0, scr, F.lane); continue; } r -= I_A;
        if (r < I_B) { const int kb = r / 32, n0 = (r % 32) * 32; p0_transpose_item(F.in[20], 512, 1024, (bf16*)(F.ws + WS_WB), kb, n0, n0, scr, F.lane); continue; } r -= I_B;
        if (r < I_O) { const int kb = r / 32, n0 = (r % 32) * 32; p0_transpose_item(F.in[21], 1024, 1024, (bf16*)(F.ws + WS_WO), kb, n0, n0, scr, F.lane); continue; } r -= I_O;
        if (r < 2 * I_G) { const int up = r >= I_G; if (up) r -= I_G; const int e = r / 256, q = r % 256, kb = q / 16, n0 = (q % 16) * 32;
            const int drow = 256 * (n0 >> 7) + 128 * up + (n0 & 127);
            p0_transpose_item(F.in[up ? 27 : 26] + (size_t)e * 1024 * EH, 1024, EH, (bf16*)(F.ws + WS_WGU) + (size_t)e * 1024 * 1024, kb, n0, drow, scr, F.lane); continue; } r -= 2 * I_G;
        { const int e = r / 256, q = r % 256, kb = q / 32, n0 = (q % 32) * 32;
            p0_transpose_item(F.in[28] + (size_t)e * EH * 1024, EH, 1024, (bf16*)(F.ws + WS_WD) + (size_t)e * 1024 * EH, kb, n0, n0, scr, F.lane); }
    }
}

struct InProjOrder {
    pg8::DenseOrder d;
    __device__ __forceinline__ bool next(int i, pg8::Unit& u) const {
        long L = (long)i * d.G + d.c;
#if defined(PROBE_INPROJ2)
        if (L >= d.nwg + 48) L -= d.nwg + 48;
        if (i >= 27) return false;
#endif
        if (L < d.nwg) return d.map(L, u);
        const int j = (int)(L - d.nwg); if (j >= 48) return false;
        const int c = j % 12; u.pm = 128 + j / 12; u.pn = c < 8 ? 4 + c : 14 + (c - 8); u.a0 = 0; u.a1 = 0; return true;
    }
    __device__ __forceinline__ int arow(const pg8::Unit& u, int r) const { return u.pm * 256 + r; }
    __device__ __forceinline__ size_t boff(const pg8::Unit& u) const { return (size_t)u.pn * 256 * 1024; }
};
struct EpiInProj {
    static constexpr bool PERM = false;
    unsigned char* ws; bf16* GA; const float* gq_a; const float* gk_a; const float* gq_b; const float* gk_b;
    __device__ __forceinline__ void operator()(const f32x4 (&acc)[2][2][4][2], const pg8::Unit& u, int wr, int wc, int fr, int fq) const {
        const int pn = u.pn, cg = 4 * pn + wc;
        int kind; const float* gain = nullptr; bool rope = false; float oscale = 1.f; bf16* dbase; int pitch, ccol; bool kvrow = false;
        if (cg < 16)      { kind = 0; gain = gq_a; rope = true; oscale = C2; dbase = (bf16*)(ws + WS_QA); pitch = D; ccol = cg * 64; }
        else if (cg < 32) { kind = 0; gain = gk_a; rope = true; dbase = (bf16*)(ws + WS_KA); pitch = D; ccol = (cg - 16) * 64; kvrow = true; }
        else if (cg < 48) { kind = 1; dbase = (bf16*)(ws + WS_VA); pitch = D; ccol = (cg - 32) * 64; kvrow = true; }
        else if (cg < 56) { kind = 0; gain = gq_b; oscale = C2; dbase = (bf16*)(ws + WS_QB); pitch = 512; ccol = (cg - 48) * 64; }
        else if (cg < 64) { kind = 0; gain = gk_b; dbase = (bf16*)(ws + WS_KB); pitch = 512; ccol = (cg - 56) * 64; kvrow = true; }
        else if (cg < 72) { kind = 1; dbase = (bf16*)(ws + WS_VB); pitch = 512; ccol = (cg - 64) * 64; kvrow = true; }
        else if (cg < 88) { kind = 2; dbase = GA; pitch = D; ccol = (cg - 72) * 64; }
        else              { kind = 2; dbase = GA + (size_t)T * D; pitch = D; ccol = (cg - 88) * 64; }
        const bool latent = u.pm < 128; if (!latent) rope = false;
        const float* RP = (const float*)(ws + WS_ROPE);
        f32x4 gn[2][2];
        if (kind == 0) {
#pragma unroll
            for (int bj = 0; bj < 2; ++bj)
#pragma unroll
                for (int n = 0; n < 2; ++n) gn[bj][n] = *(const f32x4*)(gain + 32 * bj + 16 * n + 4 * fq) * oscale;
        }
#pragma unroll
        for (int ai = 0; ai < 2; ++ai)
#pragma unroll
            for (int m = 0; m < 4; ++m) {
                const int row = u.pm * 256 + ai * 128 + wr * 64 + m * 16 + fr;
                f32x4 v[2][2];
#pragma unroll
                for (int bj = 0; bj < 2; ++bj)
#pragma unroll
                    for (int n = 0; n < 2; ++n) v[bj][n] = acc[ai][bj][m][n];
                if (kind == 0) {
                    float ss = 0.f;
#pragma unroll
                    for (int bj = 0; bj < 2; ++bj)
#pragma unroll
                        for (int n = 0; n < 2; ++n) ss += (v[bj][n].x * v[bj][n].x + v[bj][n].y * v[bj][n].y) + (v[bj][n].z * v[bj][n].z + v[bj][n].w * v[bj][n].w);
                    ss += __shfl_xor(ss, 16); ss += __shfl_xor(ss, 32);
                    const float rstd = 1.0f / sqrtf(ss * (1.f / 64.f) + EPS);
#pragma unroll
                    for (int bj = 0; bj < 2; ++bj)
#pragma unroll
                        for (int n = 0; n < 2; ++n) v[bj][n] = v[bj][n] * rstd * gn[bj][n];
                    if (rope) {
                        const int t = row & (SEQ - 1), pr = t >> 6, pc = t & 63;
                        const f32x4 cr = *(const f32x4*)(RP + pr * 16 + 4 * fq), sr = *(const f32x4*)(RP + 2048 + pr * 16 + 4 * fq);
                        const f32x4 cc = *(const f32x4*)(RP + 4096 + pc * 16 + 4 * fq), sc = *(const f32x4*)(RP + 5120 + pc * 16 + 4 * fq);
                        const f32x4 a0 = v[0][0] * cr - v[0][1] * sr, a1 = v[0][0] * sr + v[0][1] * cr;
                        const f32x4 b0 = v[1][0] * cc - v[1][1] * sc, b1 = v[1][0] * sc + v[1][1] * cc;
                        v[0][0] = a0; v[0][1] = a1; v[1][0] = b0; v[1][1] = b1;
                    }
                } else if (kind == 2) {
#pragma unroll
                    for (int bj = 0; bj < 2; ++bj)
#pragma unroll
                        for (int n = 0; n < 2; ++n) { v[bj][n].x = sigmoid_f(v[bj][n].x); v[bj][n].y = sigmoid_f(v[bj][n].y); v[bj][n].z = sigmoid_f(v[bj][n].z); v[bj][n].w = sigmoid_f(v[bj][n].w); }
                }
                const int drow = kvrow ? kv_row(row) : row;
                bf16* dp = dbase + (size_t)drow * pitch + ccol + 4 * fq;
#pragma unroll
                for (int bj = 0; bj < 2; ++bj)
#pragma unroll
                    for (int n = 0; n < 2; ++n) { u32x2 w; w.x = pg8::cvt_pk_bf16(v[bj][n].x, v[bj][n].y); w.y = pg8::cvt_pk_bf16(v[bj][n].z, v[bj][n].w); *(GAS u32x2*)(dp + 32 * bj + 16 * n) = w; }
            }
    }
};
__device__ __forceinline__ void p1b_inproj_mfma(Frame& F) {
    pg8::Gemm g{(const bf16*)(F.ws + WS_XN), (const bf16*)(F.ws + WS_WIN), D, D, D};
    InProjOrder S; S.d.init(T, NIN, F.G, F.bid, D);
    EpiInProj E{F.ws, (bf16*)F.out, F.in[9], F.in[10], F.in[16], F.in[17]};
    pg8::gemm_phase<EpiInProj, InProjOrder>(F.lds, g, S, E);
}

__device__ __forceinline__ float lam_value(const float* const (&in)[29]) {
    float a = 0.f, b = 0.f;
    for (int i = 0; i < 64; ++i) { a += in[11][i] * in[12][i]; b += in[13][i] * in[14][i]; }
    return expf(a) - expf(b) + 0.2f;
}
__device__ __forceinline__ float qk_bound(const float* gq, const float* gk) {
    float mq = 0.f, mk = 0.f; for (int i = 0; i < 64; ++i) { mq = fmaxf(mq, fabsf(gq[i])); mk = fmaxf(mk, fabsf(gk[i])); }
    return 8.0f * mq * mk * LOG2E * 1.02f + 0.1f;
}
__device__ __forceinline__ void p2a_diffattn(Frame& F) {
    bf16* QA = (bf16*)(F.ws + WS_QA); const bf16* KA = (const bf16*)(F.ws + WS_KA); const bf16* VA = (const bf16*)(F.ws + WS_VA);
    const float* subln = F.in[15];
    const float lam = lam_value(F.in); const float mb = qk_bound(F.in[9], F.in[10]);
    LAS float* K1s = (LAS float*)F.lds; LAS float* K2s = K1s + 32 * 64; LAS float* Vs = K2s + 32 * 64;
    LAS float* X = Vs + 32 * 128;
    LAS float* SS = X + 128 * 128;
    const int qrow = F.tid & 127, vh = (F.tid >> 7) & 1, br = F.tid >> 8;
    for (int unit = F.bid; unit < NB * NH * (SEQ / 128); unit += F.G) {
        const int bh = unit / (SEQ / 128), qt = unit % (SEQ / 128), b = bh / NH, h = bh % NH;
        const size_t qoff = (size_t)(b * SEQ + qt * 128 + qrow) * D + h * 128;
        float q[64], o[64], l = 0.f;
#pragma unroll
        for (int i = 0; i < 8; ++i) { const u32x4 w = *(const GAS u32x4*)(QA + qoff + br * 64 + i * 8);
            q[i * 8 + 0] = bf2f(w.x & 0xffffu); q[i * 8 + 1] = bf2f(w.x >> 16); q[i * 8 + 2] = bf2f(w.y & 0xffffu); q[i * 8 + 3] = bf2f(w.y >> 16);
            q[i * 8 + 4] = bf2f(w.z & 0xffffu); q[i * 8 + 5] = bf2f(w.z >> 16); q[i * 8 + 6] = bf2f(w.w & 0xffffu); q[i * 8 + 7] = bf2f(w.w >> 16); }
#pragma unroll
        for (int i = 0; i < 64; ++i) o[i] = 0.f;
        const bf16* Kb = KA + (size_t)b * KVL * D + h * 128; const bf16* Vb = VA + (size_t)b * KVL * D + h * 128;
        for (int kt = 0; kt < KVL / 32; ++kt) {
            __syncthreads();
            {
              const int r = F.tid >> 4, c8 = (F.tid & 15) * 8; const size_t go = (size_t)(kt * 32 + r) * D + c8;
              const u32x4 kw = *(const GAS u32x4*)(Kb + go); const u32x4 vw = *(const GAS u32x4*)(Vb + go);
              LAS float* kd = (c8 < 64) ? K1s + r * 64 + c8 : K2s + r * 64 + (c8 - 64);
              kd[0] = bf2f(kw.x & 0xffffu); kd[1] = bf2f(kw.x >> 16); kd[2] = bf2f(kw.y & 0xffffu); kd[3] = bf2f(kw.y >> 16);
              kd[4] = bf2f(kw.z & 0xffffu); kd[5] = bf2f(kw.z >> 16); kd[6] = bf2f(kw.w & 0xffffu); kd[7] = bf2f(kw.w >> 16);
              LAS float* vd = Vs + r * 128 + c8;
              vd[0] = bf2f(vw.x & 0xffffu); vd[1] = bf2f(vw.x >> 16); vd[2] = bf2f(vw.y & 0xffffu); vd[3] = bf2f(vw.y >> 16);
              vd[4] = bf2f(vw.z & 0xffffu); vd[5] = bf2f(vw.z >> 16); vd[6] = bf2f(vw.w & 0xffffu); vd[7] = bf2f(vw.w >> 16); }
            __syncthreads();
            const LAS float* Ks = br ? K2s : K1s;
            for (int j = 0; j < 32; ++j) {
                float s = 0.f;
#pragma unroll
                for (int d4 = 0; d4 < 16; ++d4) { const f32x4 kv = *(const LAS f32x4*)(Ks + j * 64 + d4 * 4);
                    s += q[d4 * 4] * kv.x + q[d4 * 4 + 1] * kv.y + q[d4 * 4 + 2] * kv.z + q[d4 * 4 + 3] * kv.w; }
                const float p = rbf(exp2f(s - mb)); l += p;
#pragma unroll
                for (int e4 = 0; e4 < 16; ++e4) { const f32x4 vv = *(const LAS f32x4*)(Vs + j * 128 + vh * 64 + e4 * 4);
                    o[e4 * 4] += p * vv.x; o[e4 * 4 + 1] += p * vv.y; o[e4 * 4 + 2] += p * vv.z; o[e4 * 4 + 3] += p * vv.w; }
            }
        }
        const float rl = 1.f / l;
        if (br == 1) {
#pragma unroll
            for (int i = 0; i < 64; ++i) X[qrow * 128 + vh * 64 + i] = o[i] * rl;
        }
        __syncthreads();
        float ss = 0.f;
        if (br == 0) {
#pragma unroll
            for (int i = 0; i < 64; ++i) { o[i] = o[i] * rl - lam * X[qrow * 128 + vh * 64 + i]; ss += o[i] * o[i]; }
            SS[qrow * 2 + vh] = ss;
        }
        __syncthreads();
        if (br == 0) {
            const float tot = SS[qrow * 2] + SS[qrow * 2 + 1]; const float rstd = 1.0f / sqrtf(tot * (1.f / 128.f) + EPS);
            bf16* dst = QA + qoff + vh * 64;
#pragma unroll
            for (int i = 0; i < 8; ++i) { u32x4 w; const float* sg = subln + vh * 64 + i * 8;
                w.x = pk2(o[i * 8] * rstd * sg[0] * 0.8f, o[i * 8 + 1] * rstd * sg[1] * 0.8f); w.y = pk2(o[i * 8 + 2] * rstd * sg[2] * 0.8f, o[i * 8 + 3] * rstd * sg[3] * 0.8f);
                w.z = pk2(o[i * 8 + 4] * rstd * sg[4] * 0.8f, o[i * 8 + 5] * rstd * sg[5] * 0.8f); w.w = pk2(o[i * 8 + 6] * rstd * sg[6] * 0.8f, o[i * 8 + 7] * rstd * sg[7] * 0.8f);
                *(GAS u32x4*)(dst + i * 8) = w; }
        }
        __syncthreads();
    }
}

__device__ __forceinline__ void p2b_natten(Frame& F) {
    bf16* QB = (bf16*)(F.ws + WS_QB); const bf16* KB = (const bf16*)(F.ws + WS_KB); const bf16* VB = (const bf16*)(F.ws + WS_VB);
    const float* bias = F.in[18];
    const int w = F.tid & 63, h = F.tid >> 6;
    for (int unit = F.bid; unit < NB * NROWS; unit += F.G) {
        const int b = unit / NROWS, r = unit % NROWS;
        const size_t qoff = (size_t)(b * SEQ + r * GRIDW + w) * 512 + h * 64;
        float q[64], o[64], l = 0.f, mx = -1e30f;
#pragma unroll
        for (int i = 0; i < 8; ++i) { const u32x4 ww = *(const GAS u32x4*)(QB + qoff + i * 8);
            q[i * 8 + 0] = bf2f(ww.x & 0xffffu); q[i * 8 + 1] = bf2f(ww.x >> 16); q[i * 8 + 2] = bf2f(ww.y & 0xffffu); q[i * 8 + 3] = bf2f(ww.y >> 16);
            q[i * 8 + 4] = bf2f(ww.z & 0xffffu); q[i * 8 + 5] = bf2f(ww.z >> 16); q[i * 8 + 6] = bf2f(ww.w & 0xffffu); q[i * 8 + 7] = bf2f(ww.w >> 16); }
#pragma unroll
        for (int i = 0; i < 64; ++i) o[i] = 0.f;
        int r0 = r - 4; r0 = r0 < 0 ? 0 : (r0 > NROWS - 8 ? NROWS - 8 : r0);
        int c0 = w - 8; c0 = c0 < 0 ? 0 : (c0 > GRIDW - 16 ? GRIDW - 16 : c0);
        for (int key = 0; key < 128 + CTX; ++key) {
            size_t krow; float bv = 0.f;
            if (key < 128) { const int i = key >> 4, j = key & 15; krow = (size_t)b * KVL + CTX + (r0 + i) * GRIDW + c0 + j;
                bv = bias[(h * 15 + (r0 + i - r + 7)) * 31 + (c0 + j - w + 15)] * LOG2E; }
            else krow = (size_t)b * KVL + (key - 128);
            const bf16* kp = KB + krow * 512 + h * 64; const bf16* vp = VB + krow * 512 + h * 64;
            float s = bv;
#pragma unroll
            for (int i = 0; i < 8; ++i) { const u32x4 kw = *(const GAS u32x4*)(kp + i * 8);
                s += q[i * 8] * bf2f(kw.x & 0xffffu) + q[i * 8 + 1] * bf2f(kw.x >> 16) + q[i * 8 + 2] * bf2f(kw.y & 0xffffu) + q[i * 8 + 3] * bf2f(kw.y >> 16)
                   + q[i * 8 + 4] * bf2f(kw.z & 0xffffu) + q[i * 8 + 5] * bf2f(kw.z >> 16) + q[i * 8 + 6] * bf2f(kw.w & 0xffffu) + q[i * 8 + 7] * bf2f(kw.w >> 16); }
            if (s > mx) { const float f = exp2f(mx - s); l *= f;
#pragma unroll
                for (int i = 0; i < 64; ++i) o[i] *= f;
                mx = s; }
            const float p = exp2f(s - mx); l += p;
#pragma unroll
            for (int i = 0; i < 8; ++i) { const u32x4 vw = *(const GAS u32x4*)(vp + i * 8);
                o[i * 8] += p * bf2f(vw.x & 0xffffu); o[i * 8 + 1] += p * bf2f(vw.x >> 16); o[i * 8 + 2] += p * bf2f(vw.y & 0xffffu); o[i * 8 + 3] += p * bf2f(vw.y >> 16);
                o[i * 8 + 4] += p * bf2f(vw.z & 0xffffu); o[i * 8 + 5] += p * bf2f(vw.z >> 16); o[i * 8 + 6] += p * bf2f(vw.w & 0xffffu); o[i * 8 + 7] += p * bf2f(vw.w >> 16); }
        }
        const float rl = 1.f / l;
#pragma unroll
        for (int i = 0; i < 8; ++i) { u32x4 ww; ww.x = pk2(o[i * 8] * rl, o[i * 8 + 1] * rl); ww.y = pk2(o[i * 8 + 2] * rl, o[i * 8 + 3] * rl);
            ww.z = pk2(o[i * 8 + 4] * rl, o[i * 8 + 5] * rl); ww.w = pk2(o[i * 8 + 6] * rl, o[i * 8 + 7] * rl); *(GAS u32x4*)(QB + qoff + i * 8) = ww; }
    }
}

__device__ __forceinline__ void p3a_merge(Frame& F) {
    const bf16* OA = (const bf16*)(F.ws + WS_QA); const bf16* OB = (const bf16*)(F.ws + WS_QB);
    const float* Wa = F.in[19]; const float* Wb = F.in[20];
    const bf16* GA = (const bf16*)F.out; const bf16* GB = GA + (size_t)T * D; bf16* Y = (bf16*)(F.ws + WS_Y);
    LAS float* As = (LAS float*)F.lds; LAS float* Bs = As + NG_AS;
    for (int item = F.bid; item < (T / 128) * 16; item += F.G) {
        const int tm = item / 16, tn = item % 16, m0 = tm * 128, n0 = tn * 64;
        float aa[4][4], ab[4][4]; zero_acc(aa); zero_acc(ab);
        gemm_core(aa, As, Bs, 1024, F.tid, [&](int row, int k) { return OA + (size_t)(m0 + row) * D + k; }, [&](int k, int n) { return *(const f32x2*)(Wa + (size_t)k * D + n0 + n); });
        gemm_core(ab, As, Bs, 512, F.tid, [&](int row, int k) { return OB + (size_t)(m0 + row) * 512 + k; }, [&](int k, int n) { return *(const f32x2*)(Wb + (size_t)k * D + n0 + n); });
        const int ty = F.tid >> 4, tx = F.tid & 15;
#pragma unroll
        for (int i = 0; i < 4; ++i) { const size_t off = (size_t)(m0 + ty * 4 + i) * D + n0 + tx * 4;
            const u32x2 ga = *(const GAS u32x2*)(GA + off), gb = *(const GAS u32x2*)(GB + off);
            const float y0 = bf2f(ga.x & 0xffffu) * aa[i][0] + bf2f(gb.x & 0xffffu) * ab[i][0], y1 = bf2f(ga.x >> 16) * aa[i][1] + bf2f(gb.x >> 16) * ab[i][1];
            const float y2 = bf2f(ga.y & 0xffffu) * aa[i][2] + bf2f(gb.y & 0xffffu) * ab[i][2], y3 = bf2f(ga.y >> 16) * aa[i][3] + bf2f(gb.y >> 16) * ab[i][3];
            u32x2 w; w.x = pk2(y0, y1); w.y = pk2(y2, y3); *(GAS u32x2*)(Y + off) = w; }
    }
}
__device__ __forceinline__ void p3b_out(Frame& F) {
    const bf16* Y = (const bf16*)(F.ws + WS_Y); const float* Wo = F.in[21]; const float* x = F.in[0];
    const float* MOD = (const float*)(F.ws + WS_MOD); float* XMID = (float*)(F.ws + WS_XMID);
    LAS float* As = (LAS float*)F.lds; LAS float* Bs = As + NG_AS;
    for (int item = F.bid; item < (T / 128) * 16; item += F.G) {
        const int tm = item / 16, tn = item % 16, m0 = tm * 128, n0 = tn * 64;
        float acc[4][4]; zero_acc(acc);
        gemm_core(acc, As, Bs, 1024, F.tid, [&](int row, int k) { return Y + (size_t)(m0 + row) * D + k; }, [&](int k, int n) { return *(const f32x2*)(Wo + (size_t)k * D + n0 + n); });
        const int ty = F.tid >> 4, tx = F.tid & 15; const int b = m0 / SEQ;
        const f32x4 g = *(const f32x4*)(MOD + b * 6144 + 2048 + n0 + tx * 4);
#pragma unroll
        for (int i = 0; i < 4; ++i) { const size_t off = (size_t)(m0 + ty * 4 + i) * D + n0 + tx * 4; const f32x4 xv = *(const f32x4*)(x + off);
            f32x4 o; o.x = xv.x + g.x * acc[i][0]; o.y = xv.y + g.y * acc[i][1]; o.z = xv.z + g.z * acc[i][2]; o.w = xv.w + g.w * acc[i][3]; *(f32x4*)(XMID + off) = o; }
    }
}

__device__ __forceinline__ void p4a_norm2_route(Frame& F, bool dry) {
    const float* XMID = (const float*)(F.ws + WS_XMID); const float* nw = F.in[7]; const float* MOD = (const float*)(F.ws + WS_MOD);
    const float* w_rg = F.in[22]; const float* b_rg = F.in[23]; const float* w_re = F.in[24]; const float* b_re = F.in[25];
    bf16* H2 = (bf16*)(F.ws + WS_H2); float* RT = (float*)(F.ws + WS_RT); int* LIST = (int*)(F.ws + WS_LIST);
    LAS float* WG = (LAS float*)F.lds;
    LAS float* WE = WG + 4096;
    for (int i = F.tid; i < 4096; i += NTHR) WG[i] = w_rg[i];
    for (int i = F.tid; i < 4 * 1024 * 8; i += NTHR) WE[i] = w_re[i];
    __syncthreads();
    const int gw = F.bid * 8 + F.wave, NGW = F.G * 8;
    for (int m = gw; m < T; m += NGW) {
        const int b = m / SEQ; f32x4 v[4];
        norm_mod_row(XMID + (size_t)m * D, nw, MOD + b * 6144 + 4096, MOD + b * 6144 + 3072, F.lane, v);
        store_row_bf16(H2 + (size_t)m * D, F.lane, v);
        float lg[4] = {0.f, 0.f, 0.f, 0.f};
#pragma unroll
        for (int j = 0; j < 4; ++j)
#pragma unroll
            for (int e = 0; e < 4; ++e) { const int k = 4 * F.lane + 256 * j + e; const float hv = v[j][e]; const f32x4 w4 = *(const LAS f32x4*)(WG + k * 4);
                lg[0] += hv * w4.x; lg[1] += hv * w4.y; lg[2] += hv * w4.z; lg[3] += hv * w4.w; }
#pragma unroll
        for (int c = 0; c < 4; ++c) lg[c] = wave_sum(lg[c]);
        int g = 0; float gl[4];
#pragma unroll
        for (int c = 0; c < 4; ++c) gl[c] = lg[c] + b_rg[c];
        float gm = gl[0];
#pragma unroll
        for (int c = 1; c < 4; ++c) if (gl[c] > gm) { gm = gl[c]; g = c; }
        float gs = 0.f;
#pragma unroll
        for (int c = 0; c < 4; ++c) gs += expf(gl[c] - gm);
        const float g_w = 1.f / gs;
        g = __builtin_amdgcn_readfirstlane(g);
        float el[8] = {0.f, 0.f, 0.f, 0.f, 0.f, 0.f, 0.f, 0.f};
        { const LAS float* we = WE + g * 8192;
#pragma unroll
          for (int j = 0; j < 4; ++j)
#pragma unroll
              for (int e = 0; e < 4; ++e) { const int k = 4 * F.lane + 256 * j + e; const float hv = v[j][e];
                  const f32x4 wa = *(const LAS f32x4*)(we + k * 8), wb = *(const LAS f32x4*)(we + k * 8 + 4);
                  el[0] += hv * wa.x; el[1] += hv * wa.y; el[2] += hv * wa.z; el[3] += hv * wa.w; el[4] += hv * wb.x; el[5] += hv * wb.y; el[6] += hv * wb.z; el[7] += hv * wb.w; } }
#pragma unroll
        for (int e = 0; e < 8; ++e) el[e] = wave_sum(el[e]) + b_re[g * 8 + e];
        int i0 = 0; float v0 = el[0];
#pragma unroll
        for (int e = 1; e < 8; ++e) if (el[e] > v0) { v0 = el[e]; i0 = e; }
        int i1 = -1; float v1 = -3.0e38f;
#pragma unroll
        for (int e = 0; e < 8; ++e) if (e != i0 && el[e] > v1) { v1 = el[e]; i1 = e; }
        const float e1 = expf(v1 - v0), den = 1.f / (1.f + e1);
        const float w0 = g_w * den, w1 = g_w * e1 * den;
        if (F.lane == 0 && !dry) {
            const int ge0 = g * 8 + i0, ge1 = 32 + g * 8 + i1;
            const unsigned p0 = atomicAdd((unsigned*)(F.ctl + CW_CNT + 64 * ge0), 1u); const unsigned p1 = atomicAdd((unsigned*)(F.ctl + CW_CNT + 64 * ge1), 1u);
            LIST[(size_t)ge0 * T + p0] = m; LIST[(size_t)ge1 * T + p1] = m;
            RT[(size_t)m * 4 + 0] = w0; RT[(size_t)m * 4 + 1] = w1;
        }
    }
}

struct GroupTab { LAS int* cnt; LAS int* tpre; LAS int* sbase; };
__device__ __forceinline__ GroupTab load_groups(Frame& F, int lds_off) {
    GroupTab G; G.cnt = (LAS int*)(F.lds + lds_off); G.tpre = G.cnt + 64; G.sbase = G.tpre + 65;
    __syncthreads();
    if (F.tid < 64) G.cnt[F.tid] = (int)__hip_atomic_load(F.ctl + CW_CNT + 64 * F.tid, __ATOMIC_RELAXED, __HIP_MEMORY_SCOPE_AGENT);
    __syncthreads();
    if (F.tid == 0) { int tp = 0, sb = 0; for (int g = 0; g < 64; ++g) { G.tpre[g] = tp; G.sbase[g] = sb; tp += (G.cnt[g] + 127) / 128; sb += (G.cnt[g] + 255) / 256 * 256; } G.tpre[64] = tp; }
    __syncthreads();
    return G;
}
__device__ __forceinline__ void p4b_gateup(Frame& F) {
    const bf16* H2 = (const bf16*)(F.ws + WS_H2); const int* LIST = (const int*)(F.ws + WS_LIST); bf16* HID = (bf16*)(F.ws + WS_HID);
    const float* Wg = F.in[26]; const float* Wu = F.in[27];
    LAS float* As = (LAS float*)F.lds; LAS float* Bs = As + NG_AS;
    const GroupTab G = load_groups(F, (NG_AS + NG_BS) * 4);
    const int ntiles = G.tpre[64];
    for (int item = F.bid; item < ntiles * 8; item += F.G) {
        const int tile = item / 8, tn = item % 8; int g = 0; while (G.tpre[g + 1] <= tile) ++g;
        const int r0 = (tile - G.tpre[g]) * 128, cnt = G.cnt[g], e = g & 31, n0 = tn * 64;
        const int* lst = LIST + (size_t)g * T;
        float ag[4][4], au[4][4]; zero_acc(ag); zero_acc(au);
        auto af = [&](int row, int k) { const int i = r0 + row; const int tok = i < cnt ? lst[i] : lst[0]; return H2 + (size_t)tok * D + k; };
        gemm_core(ag, As, Bs, 1024, F.tid, af, [&](int k, int n) { return *(const f32x2*)(Wg + ((size_t)e * 1024 + k) * EH + n0 + n); });
        gemm_core(au, As, Bs, 1024, F.tid, af, [&](int k, int n) { return *(const f32x2*)(Wu + ((size_t)e * 1024 + k) * EH + n0 + n); });
        const int ty = F.tid >> 4, tx = F.tid & 15;
#pragma unroll
        for (int i = 0; i < 4; ++i) { const int rr = r0 + ty * 4 + i; if (rr < cnt) {
            u32x2 w; w.x = pk2(silu_f(ag[i][0]) * au[i][0], silu_f(ag[i][1]) * au[i][1]); w.y = pk2(silu_f(ag[i][2]) * au[i][2], silu_f(ag[i][3]) * au[i][3]);
            *(GAS u32x2*)(HID + (size_t)(G.sbase[g] + rr) * EH + n0 + tx * 4) = w; } }
    }
}
__device__ __forceinline__ void p4c_down(Frame& F, int kk) {
    const bf16* HID = (const bf16*)(F.ws + WS_HID); const int* LIST = (const int*)(F.ws + WS_LIST); const float* RT = (const float*)(F.ws + WS_RT);
    const float* Wd = F.in[28]; const float* XMID = (const float*)(F.ws + WS_XMID); const float* MOD = (const float*)(F.ws + WS_MOD);
    LAS float* As = (LAS float*)F.lds; LAS float* Bs = As + NG_AS;
    const GroupTab G = load_groups(F, (NG_AS + NG_BS) * 4);
    const int t_lo = G.tpre[kk * 32], t_hi = G.tpre[kk * 32 + 32];
    for (int item = F.bid; item < (t_hi - t_lo) * 16; item += F.G) {
        const int tile = t_lo + item / 16, tn = item % 16; int g = kk * 32; while (G.tpre[g + 1] <= tile) ++g;
        const int r0 = (tile - G.tpre[g]) * 128, cnt = G.cnt[g], e = g & 31, n0 = tn * 64;
        const int* lst = LIST + (size_t)g * T;
        float acc[4][4]; zero_acc(acc);
        gemm_core(acc, As, Bs, 512, F.tid, [&](int row, int k) { const int i = r0 + row; return HID + (size_t)(G.sbase[g] + (i < cnt ? i : 0)) * EH + k; },
                  [&](int k, int n) { return *(const f32x2*)(Wd + ((size_t)e * EH + k) * D + n0 + n); });
        const int ty = F.tid >> 4, tx = F.tid & 15;
#pragma unroll
        for (int i = 0; i < 4; ++i) { const int rr = r0 + ty * 4 + i; if (rr < cnt) {
            const int tok = lst[rr]; const int b = tok / SEQ; const float w = RT[(size_t)tok * 4 + kk];
            const f32x4 g2 = *(const f32x4*)(MOD + b * 6144 + 5120 + n0 + tx * 4); const size_t off = (size_t)tok * D + n0 + tx * 4;
            const f32x4 base = kk == 0 ? *(const f32x4*)(XMID + off) : *(const f32x4*)(F.out + off);
            f32x4 o; o.x = base.x + g2.x * w * acc[i][0]; o.y = base.y + g2.y * w * acc[i][1]; o.z = base.z + g2.z * w * acc[i][2]; o.w = base.w + g2.w * w * acc[i][3];
            *(f32x4*)(F.out + off) = o; } }
    }
}


namespace dattn {
typedef short bf16x8 __attribute__((ext_vector_type(8)));
typedef short s16x4 __attribute__((ext_vector_type(4)));
typedef float f32x16 __attribute__((ext_vector_type(16)));
typedef short v4i16_t __attribute__((ext_vector_type(4)));
constexpr int SLOT = 32768, NT = KVL / 64, LDS_WS = 3 * SLOT, XS = 136;
typedef __attribute__((address_space(3))) const char* lds_cptr;
__device__ __forceinline__ int crow(int r, int hi) { return (r & 3) + 8 * (r >> 2) + 4 * hi; }
__device__ __forceinline__ void glds16(const void* gsrc, unsigned lds_dst) { unsigned keep;
    asm volatile("s_mov_b32 %0, m0\n\ts_mov_b32 m0, %2\n\ts_nop 0\n\tglobal_load_lds_dwordx4 %1, off\n\ts_mov_b32 m0, %0" : "=&s"(keep) : "v"(gsrc), "s"(lds_dst) : "memory"); }
__device__ __forceinline__ unsigned cvtpk(float lo, float hi) { typedef float f2 __attribute__((ext_vector_type(2))); typedef __bf16 b2 __attribute__((ext_vector_type(2))); f2 v = {lo, hi}; b2 b = __builtin_convertvector(v, b2); return __builtin_bit_cast(unsigned, b); }
__device__ __forceinline__ s16x4 vtr(lds_cptr p) { return __builtin_bit_cast(s16x4, __builtin_amdgcn_ds_read_tr16_b64_v4i16((__attribute__((address_space(3))) v4i16_t*)p)); }
#define DA_WAIT_BAR(N) asm volatile("s_waitcnt vmcnt(" #N ") lgkmcnt(0)\n\ts_barrier" ::: "memory")

template <int VAR> __device__ __forceinline__ void unit(int b, int h, int qt, const bf16* QA, bf16* OA, const bf16* KA, const bf16* VA, LAS unsigned char* lds, float lam, float mb, const float* subln) {
    const int tid = threadIdx.x, lane = tid & 63, r32 = lane & 31, hi = lane >> 5; const int wid = __builtin_amdgcn_readfirstlane(tid >> 6);
    const int br = wid >> 2, qi = wid & 3;
    const size_t qrow0 = (size_t)b * SEQ + qt * 128 + qi * 32;
    const bf16* Qw = QA + qrow0 * D + h * 128 + br * 64;
    const unsigned lds0 = (unsigned)(uintptr_t)lds;
    const bf16* src; unsigned dst; size_t sstep;
    if (wid < 4) { src = KA + ((size_t)b * KVL + lane) * D + h * 128 + wid * 32; dst = (unsigned)wid * 4096u; sstep = 8; }
    else { src = VA + ((size_t)b * KVL + (lane >> 2)) * D + h * 128 + (wid - 4) * 32 + (lane & 3) * 8; dst = 16384u + (unsigned)(wid - 4) * 4096u; sstep = (size_t)16 * D; }
#define DA_DMA(t, slot) do { _Pragma("unroll") for (int _k = 0; _k < 4; ++_k) glds16(src + (size_t)(t) * 64 * D + _k * sstep, (unsigned)__builtin_amdgcn_readfirstlane(lds0 + (slot) + dst + _k * 1024)); } while (0)
    DA_DMA(0, 0); DA_DMA(1, SLOT);
    bf16x8 qr[4];
#pragma unroll
    for (int d0 = 0; d0 < 4; ++d0) qr[d0] = *(const bf16x8*)(Qw + (size_t)r32 * D + d0 * 16 + hi * 8);
    f32x16 o[4];
#pragma unroll
    for (int i = 0; i < 4; ++i) o[i] = f32x16{};
    f32x16 negm;
#pragma unroll
    for (int r = 0; r < 16; ++r) negm[r] = -mb;
    float l = 0.f;
    const lds_cptr l3 = (lds_cptr)lds;
    const lds_cptr kp0 = l3 + br * 8192 + hi * 1024 + r32 * 16;
    const lds_cptr vp0 = l3 + 16384 + ((lane >> 4) & 1) * 32 + (lane & 3) * 8 + (4 * hi + ((lane & 15) >> 2)) * 64;
    int sl_cur = 0, sl_pf = 2 * SLOT;
    for (int t = 0; t < NT; ++t) {
        if (t + 1 < NT) DA_WAIT_BAR(4); else DA_WAIT_BAR(0);
        if (VAR != 1) { if (t + 2 < NT) DA_DMA(t + 2, sl_pf); }
        if (VAR == 2) { sl_cur = (sl_cur == 2 * SLOT) ? 0 : sl_cur + SLOT; sl_pf = (sl_pf == 2 * SLOT) ? 0 : sl_pf + SLOT; continue; }
        const lds_cptr kp = kp0 + sl_cur, vp = vp0 + sl_cur;
        f32x16 p0, p1;
#pragma unroll
        for (int d0 = 0; d0 < 4; ++d0) {
            const bf16x8 k0 = *(const __attribute__((address_space(3))) bf16x8*)(kp + d0 * 2048), k1 = *(const __attribute__((address_space(3))) bf16x8*)(kp + d0 * 2048 + 512);
            p0 = __builtin_amdgcn_mfma_f32_32x32x16_bf16(k0, qr[d0], d0 == 0 ? negm : p0, 0, 0, 0);
            p1 = __builtin_amdgcn_mfma_f32_32x32x16_bf16(k1, qr[d0], d0 == 0 ? negm : p1, 0, 0, 0);
        }
        float sacc = 0.f;
#pragma unroll
        for (int r = 0; r < 16; ++r) { p0[r] = __builtin_amdgcn_exp2f(p0[r]); p1[r] = __builtin_amdgcn_exp2f(p1[r]); sacc += p0[r] + p1[r]; }
        l += sacc;
        u32x4 pw[4];
#pragma unroll
        for (int s2 = 0; s2 < 2; ++s2) {
            pw[s2]     = (u32x4){cvtpk(p0[8 * s2], p0[8 * s2 + 1]), cvtpk(p0[8 * s2 + 2], p0[8 * s2 + 3]), cvtpk(p0[8 * s2 + 4], p0[8 * s2 + 5]), cvtpk(p0[8 * s2 + 6], p0[8 * s2 + 7])};
            pw[2 + s2] = (u32x4){cvtpk(p1[8 * s2], p1[8 * s2 + 1]), cvtpk(p1[8 * s2 + 2], p1[8 * s2 + 3]), cvtpk(p1[8 * s2 + 4], p1[8 * s2 + 5]), cvtpk(p1[8 * s2 + 6], p1[8 * s2 + 7])};
        }
#pragma unroll
        for (int ks = 0; ks < 4; ++ks) {
            const bf16x8 pa = __builtin_bit_cast(bf16x8, pw[ks]);
#pragma unroll
            for (int db = 0; db < 4; ++db) {
                const s16x4 lo = vtr(vp + db * 4096 + ks * 1024), hh = vtr(vp + db * 4096 + ks * 1024 + 512);
                const bf16x8 vf = (bf16x8){lo[0], lo[1], lo[2], lo[3], hh[0], hh[1], hh[2], hh[3]};
                o[db] = __builtin_amdgcn_mfma_f32_32x32x16_bf16(pa, vf, o[db], 0, 0, 0);
            }
        }
        sl_cur = (sl_cur == 2 * SLOT) ? 0 : sl_cur + SLOT; sl_pf = (sl_pf == 2 * SLOT) ? 0 : sl_pf + SLOT;
    }
    { auto rr = __builtin_amdgcn_permlane32_swap(__float_as_uint(l), __float_as_uint(l), false, false); l = __uint_as_float(rr[0]) + __uint_as_float(rr[1]); }
    LAS float* wsf = (LAS float*)(lds + LDS_WS) + wid * 64;
    if (hi == 0) wsf[r32] = 1.0f / l;
    asm volatile("s_waitcnt lgkmcnt(0)" ::: "memory");
    float rli[16];
#pragma unroll
    for (int r = 0; r < 16; ++r) rli[r] = wsf[crow(r, hi)];
    DA_WAIT_BAR(0);
    LAS float* X = (LAS float*)lds + (size_t)(qi * 32) * XS;
    if (br == 1) {
#pragma unroll
        for (int db = 0; db < 4; ++db)
#pragma unroll
            for (int r = 0; r < 16; ++r) X[crow(r, hi) * XS + db * 32 + r32] = o[db][r] * rli[r];
    }
    DA_WAIT_BAR(0);
    if (br == 0) {
#pragma unroll
        for (int db = 0; db < 4; ++db)
#pragma unroll
            for (int r = 0; r < 16; ++r) { const int xi = crow(r, hi) * XS + db * 32 + r32; X[xi] = o[db][r] * rli[r] - lam * X[xi]; }
        asm volatile("s_waitcnt lgkmcnt(0)" ::: "memory");
        const int row = lane >> 1, half = lane & 1;
        f32x4 v[8][2]; float ss = 0.f;
#pragma unroll
        for (int i = 0; i < 8; ++i)
#pragma unroll
            for (int c = 0; c < 2; ++c) { v[i][c] = *(const LAS f32x4*)(X + row * XS + (2 * i + half) * 8 + c * 4); ss += (v[i][c].x * v[i][c].x + v[i][c].y * v[i][c].y) + (v[i][c].z * v[i][c].z + v[i][c].w * v[i][c].w); }
        ss += __shfl_xor(ss, 1);
        const float rstd = 0.8f / sqrtf(ss * (1.f / 128.f) + EPS);
        bf16* dst = OA + (qrow0 + row) * D + h * 128;
#pragma unroll
        for (int i = 0; i < 8; ++i) { const int d = (2 * i + half) * 8; const f32x4 g0 = *(const f32x4*)(subln + d), g1 = *(const f32x4*)(subln + d + 4);
            u32x4 w; w.x = cvtpk(v[i][0].x * rstd * g0.x, v[i][0].y * rstd * g0.y); w.y = cvtpk(v[i][0].z * rstd * g0.z, v[i][0].w * rstd * g0.w);
            w.z = cvtpk(v[i][1].x * rstd * g1.x, v[i][1].y * rstd * g1.y); w.w = cvtpk(v[i][1].z * rstd * g1.z, v[i][1].w * rstd * g1.w);
            *(GAS u32x4*)(dst + d) = w; }
    }
    DA_WAIT_BAR(0);
#undef DA_DMA
}
}

namespace dattn2 {
using dattn::bf16x8; using dattn::s16x4; using dattn::f32x16; using dattn::lds_cptr; using dattn::crow; using dattn::cvtpk; using dattn::vtr;
constexpr int NT = KVL / 64, KSL = 16384, VBASE = 3 * KSL, LDS_WS = 6 * KSL, XS = 136;
__device__ __forceinline__ void glds16s(unsigned voff, const void* sbase, unsigned lds_dst) { unsigned keep;
    asm volatile("s_mov_b32 %0, m0\n\ts_mov_b32 m0, %3\n\ts_nop 0\n\tglobal_load_lds_dwordx4 %1, %2\n\ts_mov_b32 m0, %0" : "=&s"(keep) : "v"(voff), "s"(sbase), "s"(lds_dst) : "memory"); }
#define D2_WAIT_BAR(N) asm volatile("s_waitcnt vmcnt(" #N ") lgkmcnt(0)\n\ts_barrier" ::: "memory")
#define D2_SBAR() __builtin_amdgcn_sched_barrier(0)
typedef __attribute__((address_space(3))) const bf16x8* lds_b8;

__device__ __forceinline__ void unit(int b, int h, int qt, const bf16* QA, bf16* OA, const bf16* KA, const bf16* VA, LAS unsigned char* lds, float lam, const float* subln) {
    const int tid = threadIdx.x, lane = tid & 63, r32 = lane & 31, hi = lane >> 5; const int wid = __builtin_amdgcn_readfirstlane(tid >> 6);
    const int br = wid >> 2, qi = wid & 3;
    const size_t qrow0 = (size_t)b * SEQ + qt * 128 + qi * 32;
    const bf16* Qw = QA + qrow0 * D + h * 128 + br * 64;
    const unsigned lds0 = (unsigned)(uintptr_t)lds;
    unsigned koff[2], voff[2];
#pragma unroll
    for (int j = 0; j < 2; ++j) { const int row = 8 * wid + 4 * j + (lane >> 4), s16 = lane & 15;
        koff[j] = (unsigned)((row * D + h * 128 + ((s16 ^ (row & 15)) * 8)) * 2);
        voff[j] = (unsigned)((row * D + h * 128 + (((s16 >> 2) ^ (row & 3)) * 32) + (s16 & 3) * 8) * 2); }
    const char* Kb = (const char*)(KA + (size_t)b * KVL * D); const char* Vb = (const char*)(VA + (size_t)b * KVL * D);
    const unsigned dst0 = lds0 + (unsigned)wid * 2048u;
#define D2_KDMA(t, slot) do { const char* _p = Kb + (size_t)(t) * (64 * D * 2); const unsigned _d = (unsigned)__builtin_amdgcn_readfirstlane(dst0 + (slot)); glds16s(koff[0], _p, _d); glds16s(koff[1], _p, _d + 1024u); } while (0)
#define D2_VDMA(t, slot) do { const char* _p = Vb + (size_t)(t) * (64 * D * 2); const unsigned _d = (unsigned)__builtin_amdgcn_readfirstlane(dst0 + VBASE + (slot)); glds16s(voff[0], _p, _d); glds16s(voff[1], _p, _d + 1024u); } while (0)
    D2_KDMA(0, 0); D2_VDMA(0, 0); D2_KDMA(1, KSL);
    bf16x8 qr[4];
#pragma unroll
    for (int d0 = 0; d0 < 4; ++d0) qr[d0] = *(const bf16x8*)(Qw + (size_t)r32 * D + d0 * 16 + hi * 8);
    f32x16 o[4];
#pragma unroll
    for (int i = 0; i < 4; ++i) o[i] = f32x16{};
    const f32x16 z16 = f32x16{};
    float l = 0.f;
    const unsigned kad = (unsigned)(r32 * 256 + ((((br * 8 + hi) ^ (r32 & 15))) << 4));
    unsigned vad[4];
    { const int q = (lane & 15) >> 2;
#pragma unroll
      for (int db = 0; db < 4; ++db) vad[db] = (unsigned)(VBASE + (4 * hi + q) * 256 + ((db ^ q) << 6) + ((lane >> 4) & 1) * 32 + (lane & 3) * 8); }
    const lds_cptr l3 = (lds_cptr)lds;
#define D2_KF(slot, f) (*(lds_b8)(l3 + (slot) + (kad ^ (unsigned)(((f) >> 1) << 5)) + ((f) & 1) * 8192))
#define D2_VF(dst, slot, m) do { const lds_cptr _a = l3 + (slot) + vad[(m) & 3] + ((m) >> 2) * 4096; const s16x4 _lo = vtr(_a), _hh = vtr(_a + 2048); \
        dst = (bf16x8){_lo[0], _lo[1], _lo[2], _lo[3], _hh[0], _hh[1], _hh[2], _hh[3]}; } while (0)
    D2_WAIT_BAR(0);
    D2_KDMA(2, 2 * KSL); D2_VDMA(1, KSL);
    f32x16 pA0, pA1, pB0, pB1;
#pragma unroll
    for (int d0 = 0; d0 < 4; ++d0) {
        pA0 = __builtin_amdgcn_mfma_f32_32x32x16_bf16(D2_KF(0, 2 * d0), qr[d0], d0 == 0 ? z16 : pA0, 0, 0, 0);
        pA1 = __builtin_amdgcn_mfma_f32_32x32x16_bf16(D2_KF(0, 2 * d0 + 1), qr[d0], d0 == 0 ? z16 : pA1, 0, 0, 0); }
#pragma unroll
    for (int r = 0; r < 16; ++r) { pA0[r] = __builtin_amdgcn_exp2f(pA0[r]); pA1[r] = __builtin_amdgcn_exp2f(pA1[r]); }
    int r0 = KSL, r1 = 2 * KSL, r2 = 0;
    u32x4 pw0, pw1, pw2, pw3; bf16x8 kfa, kfb, kfc, vfa, vfb, vfc;
#define D2_PK(P, B) cvtpk(P[B], P[(B) + 1])
#define D2_PA(k) __builtin_bit_cast(bf16x8, pw##k)
#define D2_EX(v) __builtin_amdgcn_exp2f(v)
#define D2_GA(C, CIN, KC, QD, KN, NF, A0, A1, A2, A3, W0, W1) do { C = __builtin_amdgcn_mfma_f32_32x32x16_bf16(KC, qr[QD], CIN, 0, 0, 0); if ((NF) < 8) KN = D2_KF(r0, NF); \
        sacc += A0; sacc += A1; sacc += A2; sacc += A3; W0; W1; D2_SBAR(); } while (0)
#define D2_GB(M, VC, VN, NM, X0, X1) do { o[(M) & 3] = __builtin_amdgcn_mfma_f32_32x32x16_bf16(((M) >> 2) == 0 ? D2_PA(0) : ((M) >> 2) == 1 ? D2_PA(1) : ((M) >> 2) == 2 ? D2_PA(2) : D2_PA(3), VC, o[(M) & 3], 0, 0, 0); \
        if ((NM) < 16) D2_VF(VN, r2, NM); X0 = D2_EX(X0); X1 = D2_EX(X1); D2_SBAR(); } while (0)
#define D2_STEP(C0, C1, P0, P1, t, GK, GV, WN) do { \
        D2_WAIT_BAR(WN); \
        if (GK) D2_KDMA((t) + 2, r2); if (GV) D2_VDMA((t) + 1, r1); \
        kfa = D2_KF(r0, 0); kfb = D2_KF(r0, 1); kfc = D2_KF(r0, 2); D2_SBAR(); \
        float sacc = P0[0] + P0[1]; \
        D2_GA(C0, z16, kfa, 0, kfa, 3, P0[2], P0[3], P0[4], P0[5],     pw0[0] = D2_PK(P0, 0),  pw0[1] = D2_PK(P0, 2)); \
        D2_GA(C1, z16, kfb, 0, kfb, 4, P0[6], P0[7], P0[8], P0[9],     pw0[2] = D2_PK(P0, 4),  pw0[3] = D2_PK(P0, 6)); \
        D2_GA(C0, C0,  kfc, 1, kfc, 5, P0[10], P0[11], P0[12], P0[13], pw1[0] = D2_PK(P0, 8),  pw1[1] = D2_PK(P0, 10)); \
        D2_GA(C1, C1,  kfa, 1, kfa, 6, P0[14], P0[15], P1[0], P1[1],   pw1[2] = D2_PK(P0, 12), pw1[3] = D2_PK(P0, 14)); \
        D2_GA(C0, C0,  kfb, 2, kfb, 7, P1[2], P1[3], P1[4], P1[5],     pw2[0] = D2_PK(P1, 0),  pw2[1] = D2_PK(P1, 2)); \
        D2_VF(vfa, r2, 0); \
        D2_GA(C1, C1,  kfc, 2, kfc, 8, P1[6], P1[7], P1[8], P1[9],     pw2[2] = D2_PK(P1, 4),  pw2[3] = D2_PK(P1, 6)); \
        D2_VF(vfb, r2, 1); \
        D2_GA(C0, C0,  kfa, 3, kfa, 8, P1[10], P1[11], P1[12], P1[13], pw3[0] = D2_PK(P1, 8),  pw3[1] = D2_PK(P1, 10)); \
        D2_VF(vfc, r2, 2); \
        D2_GA(C1, C1,  kfb, 3, kfb, 8, P1[14], P1[15], 0.f, 0.f,       pw3[2] = D2_PK(P1, 12), pw3[3] = D2_PK(P1, 14)); \
        l += sacc; \
        D2_GB(0,  vfa, vfa, 3,  C0[0],  C0[1]);  D2_GB(1,  vfb, vfb, 4,  C0[2],  C0[3]);  D2_GB(2,  vfc, vfc, 5,  C0[4],  C0[5]);  D2_GB(3,  vfa, vfa, 6,  C0[6],  C0[7]); \
        D2_GB(4,  vfb, vfb, 7,  C0[8],  C0[9]);  D2_GB(5,  vfc, vfc, 8,  C0[10], C0[11]); D2_GB(6,  vfa, vfa, 9,  C0[12], C0[13]); D2_GB(7,  vfb, vfb, 10, C0[14], C0[15]); \
        D2_GB(8,  vfc, vfc, 11, C1[0],  C1[1]);  D2_GB(9,  vfa, vfa, 12, C1[2],  C1[3]);  D2_GB(10, vfb, vfb, 13, C1[4],  C1[5]);  D2_GB(11, vfc, vfc, 14, C1[6],  C1[7]); \
        D2_GB(12, vfa, vfa, 15, C1[8],  C1[9]);  D2_GB(13, vfb, vfb, 16, C1[10], C1[11]); D2_GB(14, vfc, vfc, 16, C1[12], C1[13]); D2_GB(15, vfa, vfa, 16, C1[14], C1[15]); \
        { const int _t = r0; r0 = r1; r1 = r2; r2 = _t; } \
    } while (0)
    int t = 1;
    for (; t + 1 <= NT - 3; t += 2) {
        D2_STEP(pB0, pB1, pA0, pA1, t, true, true, 4);
        D2_STEP(pA0, pA1, pB0, pB1, t + 1, true, true, 4);
    }
    D2_STEP(pB0, pB1, pA0, pA1, NT - 3, true, true, 4);
    D2_STEP(pA0, pA1, pB0, pB1, NT - 2, false, true, 4);
    D2_STEP(pB0, pB1, pA0, pA1, NT - 1, false, false, 2);
    D2_WAIT_BAR(0);
    { float sacc = 0.f;
#pragma unroll
      for (int r = 0; r < 16; ++r) sacc += pB0[r] + pB1[r];
      l += sacc;
      pw0 = (u32x4){D2_PK(pB0, 0), D2_PK(pB0, 2), D2_PK(pB0, 4), D2_PK(pB0, 6)}; pw1 = (u32x4){D2_PK(pB0, 8), D2_PK(pB0, 10), D2_PK(pB0, 12), D2_PK(pB0, 14)};
      pw2 = (u32x4){D2_PK(pB1, 0), D2_PK(pB1, 2), D2_PK(pB1, 4), D2_PK(pB1, 6)}; pw3 = (u32x4){D2_PK(pB1, 8), D2_PK(pB1, 10), D2_PK(pB1, 12), D2_PK(pB1, 14)};
#pragma unroll
      for (int m = 0; m < 16; ++m) { bf16x8 vf; D2_VF(vf, r2, m);
          o[m & 3] = __builtin_amdgcn_mfma_f32_32x32x16_bf16((m >> 2) == 0 ? D2_PA(0) : (m >> 2) == 1 ? D2_PA(1) : (m >> 2) == 2 ? D2_PA(2) : D2_PA(3), vf, o[m & 3], 0, 0, 0); } }
    { auto rr = __builtin_amdgcn_permlane32_swap(__float_as_uint(l), __float_as_uint(l), false, false); l = __uint_as_float(rr[0]) + __uint_as_float(rr[1]); }
    LAS float* wsf = (LAS float*)(lds + LDS_WS) + wid * 64;
    if (hi == 0) wsf[r32] = 1.0f / l;
    asm volatile("s_waitcnt lgkmcnt(0)" ::: "memory");
    float rli[16];
    { const LAS float* wb = wsf + 4 * hi;
#pragma unroll
      for (int r = 0; r < 16; ++r) rli[r] = wb[(r & 3) + 8 * (r >> 2)]; }
    D2_WAIT_BAR(0);
    LAS float* X = (LAS float*)lds + (size_t)(qi * 32 + 4 * hi) * XS + r32;
    if (br == 1) {
#pragma unroll
        for (int db = 0; db < 4; ++db)
#pragma unroll
            for (int r = 0; r < 16; ++r) X[((r & 3) + 8 * (r >> 2)) * XS + db * 32] = o[db][r] * rli[r];
    }
    D2_WAIT_BAR(0);
    if (br == 0) {
#pragma unroll
        for (int db = 0; db < 4; ++db)
#pragma unroll
            for (int r = 0; r < 16; ++r) { const int xi = ((r & 3) + 8 * (r >> 2)) * XS + db * 32; X[xi] = o[db][r] * rli[r] - lam * X[xi]; }
        asm volatile("s_waitcnt lgkmcnt(0)" ::: "memory");
        const int row = lane >> 1, half = lane & 1;
        const LAS float* Xr = (const LAS float*)lds + (size_t)(qi * 32 + row) * XS + half * 8;
        f32x4 v[8][2]; float ss = 0.f;
#pragma unroll
        for (int i = 0; i < 8; ++i)
#pragma unroll
            for (int c = 0; c < 2; ++c) { v[i][c] = *(const LAS f32x4*)(Xr + i * 16 + c * 4); ss += (v[i][c].x * v[i][c].x + v[i][c].y * v[i][c].y) + (v[i][c].z * v[i][c].z + v[i][c].w * v[i][c].w); }
        ss += __shfl_xor(ss, 1);
        const float rstd = 0.8f / sqrtf(ss * (1.f / 128.f) + EPS);
        bf16* dst = OA + (qrow0 + row) * D + h * 128 + half * 8;
        const float* sg = subln + half * 8;
#pragma unroll
        for (int i = 0; i < 8; ++i) { const f32x4 g0 = *(const f32x4*)(sg + i * 16), g1 = *(const f32x4*)(sg + i * 16 + 4);
            u32x4 w; w.x = cvtpk(v[i][0].x * rstd * g0.x, v[i][0].y * rstd * g0.y); w.y = cvtpk(v[i][0].z * rstd * g0.z, v[i][0].w * rstd * g0.w);
            w.z = cvtpk(v[i][1].x * rstd * g1.x, v[i][1].y * rstd * g1.y); w.w = cvtpk(v[i][1].z * rstd * g1.z, v[i][1].w * rstd * g1.w);
            *(GAS u32x4*)(dst + i * 16) = w; }
    }
    D2_WAIT_BAR(0);
#undef D2_KDMA
#undef D2_VDMA
#undef D2_KF
#undef D2_VF
#undef D2_PK
#undef D2_PA
#undef D2_EX
#undef D2_GA
#undef D2_GB
#undef D2_STEP
}
}

template <int VAR> __device__ __forceinline__ void p2a_diffattn_mfma(Frame& F, bf16* OA) {
    bf16* QA = (bf16*)(F.ws + WS_QA); const bf16* KA = (const bf16*)(F.ws + WS_KA); const bf16* VA = (const bf16*)(F.ws + WS_VA);
    const float lam = lam_value(F.in); const float mb = qk_bound(F.in[9], F.in[10]);
    constexpr int NU = NB * NH * (SEQ / 128);
    for (int i = 0; ; ++i) {
        int bh, qt;
        if (F.G == 256) { if (i >= 8) break; const int x = F.bid & 7, j = F.bid >> 3; bh = x + 8 * (i >> 1); qt = (i & 1) * 32 + j; }
        else { const int u = F.bid + i * F.G; if (u >= NU) break; bh = u / (SEQ / 128); qt = u % (SEQ / 128); }
        if (VAR == 0 && mb < 64.f) dattn2::unit(bh / NH, bh % NH, qt, QA, OA, KA, VA, F.lds, lam, F.in[15]);
        else dattn::unit<VAR>(bh / NH, bh % NH, qt, QA, OA, KA, VA, F.lds, lam, mb, F.in[15]);
    }
}


namespace nattn {
using dattn::bf16x8; using dattn::s16x4; using dattn::f32x16; using dattn::lds_cptr; using dattn::crow; using dattn::glds16; using dattn::cvtpk; using dattn::vtr;
__device__ __forceinline__ void unit(int b, int r, const bf16* QB, bf16* OB, const bf16* KB, const bf16* VB, LAS unsigned char* lds, float mb) {
    const int tid = threadIdx.x, lane = tid & 63, r32 = lane & 31, hi = lane >> 5; const int h = __builtin_amdgcn_readfirstlane(tid >> 6);
    const size_t qrow0 = (size_t)b * SEQ + r * GRIDW;
    const unsigned lds0 = (unsigned)(uintptr_t)lds;
    LAS unsigned char* vbuf = lds + h * 16384;
    const LAS float* BL = (const LAS float*)(lds + 131072 + h * 2048);
    LAS float* wsf = (LAS float*)(lds + 147456) + h * 128;
    int r0 = r - 4; r0 = r0 < 0 ? 0 : (r0 > NROWS - 8 ? NROWS - 8 : r0);
    bf16x8 qr[2][4];
#pragma unroll
    for (int qb = 0; qb < 2; ++qb)
#pragma unroll
        for (int d0 = 0; d0 < 4; ++d0) qr[qb][d0] = *(const bf16x8*)(QB + (qrow0 + qb * 32 + r32) * 512 + h * 64 + d0 * 16 + hi * 8);
    f32x16 o[2][2];
#pragma unroll
    for (int i = 0; i < 2; ++i)
#pragma unroll
        for (int j = 0; j < 2; ++j) o[i][j] = f32x16{};
    const f32x16 zero16 = f32x16{};
    float l[2] = {0.f, 0.f};
    const bf16* vsrc0 = VB + (size_t)(lane >> 2) * 512 + h * 64 + (lane & 3) * 8;
    const lds_cptr vp0 = (lds_cptr)vbuf + ((lane >> 4) & 1) * 32 + (lane & 3) * 8 + (4 * hi + ((lane & 15) >> 2)) * 64;
#define NA_KROW(t) ((size_t)b * KVL + ((t) < 8 ? CTX + (r0 + (t)) * GRIDW : ((t) - 8) * 64))
#define NA_DMA(t) do { const bf16* _s = vsrc0 + NA_KROW(t) * 512; const unsigned _d = lds0 + h * 16384 + ((t) & 1) * 8192; \
        _Pragma("unroll") for (int _db = 0; _db < 2; ++_db) _Pragma("unroll") for (int _rc = 0; _rc < 4; ++_rc) \
            glds16(_s + (size_t)_rc * 16 * 512 + _db * 32, (unsigned)__builtin_amdgcn_readfirstlane(_d + _db * 4096 + _rc * 1024)); } while (0)
    NA_DMA(0);
#pragma unroll 1
    for (int t = 0; t < 12; ++t) {
        const bf16* kbase = KB + (NA_KROW(t) + r32) * 512 + h * 64 + hi * 8;
        bf16x8 kf[2][4];
#pragma unroll
        for (int kh = 0; kh < 2; ++kh)
#pragma unroll
            for (int d0 = 0; d0 < 4; ++d0) kf[kh][d0] = *(const bf16x8*)(kbase + (size_t)kh * 32 * 512 + d0 * 16);
        if (t + 1 < 12) { NA_DMA(t + 1); asm volatile("s_waitcnt vmcnt(8)" ::: "memory"); } else asm volatile("s_waitcnt vmcnt(0)" ::: "memory");
        const lds_cptr vp = vp0 + (t & 1) * 8192;
#pragma unroll
        for (int qb = 0; qb < 2; ++qb) {
            f32x16 p0, p1;
#pragma unroll
            for (int d0 = 0; d0 < 4; ++d0) {
                p0 = __builtin_amdgcn_mfma_f32_32x32x16_bf16(kf[0][d0], qr[qb][d0], d0 == 0 ? zero16 : p0, 0, 0, 0);
                p1 = __builtin_amdgcn_mfma_f32_32x32x16_bf16(kf[1][d0], qr[qb][d0], d0 == 0 ? zero16 : p1, 0, 0, 0);
            }
            if (t < 8) {
                const int w = qb * 32 + r32; int c0 = w - 8; c0 = c0 < 0 ? 0 : (c0 > GRIDW - 16 ? GRIDW - 16 : c0);
                const LAS float* brow = BL + (r0 + t - r + 7) * 31 + (15 - w) + 4 * hi;
#pragma unroll
                for (int i = 0; i < 16; ++i) { const int kcc = (i & 3) + 8 * (i >> 2); const int kc = kcc + 4 * hi, kc1 = kc + 32;
                    const bool v0 = (kc >= c0) && (kc < c0 + 16), v1 = (kc1 >= c0) && (kc1 < c0 + 16);
                    const float b0 = brow[kcc], b1 = brow[kcc + 32];
                    p0[i] = v0 ? p0[i] + b0 : -1.0e30f; p1[i] = v1 ? p1[i] + b1 : -1.0e30f; }
            }
            float sacc = 0.f;
#pragma unroll
            for (int i = 0; i < 16; ++i) { p0[i] = __builtin_amdgcn_exp2f(p0[i] - mb); p1[i] = __builtin_amdgcn_exp2f(p1[i] - mb); sacc += p0[i] + p1[i]; }
            l[qb] += sacc;
            u32x4 pw[4];
#pragma unroll
            for (int s2 = 0; s2 < 2; ++s2) {
                pw[s2]     = (u32x4){cvtpk(p0[8 * s2], p0[8 * s2 + 1]), cvtpk(p0[8 * s2 + 2], p0[8 * s2 + 3]), cvtpk(p0[8 * s2 + 4], p0[8 * s2 + 5]), cvtpk(p0[8 * s2 + 6], p0[8 * s2 + 7])};
                pw[2 + s2] = (u32x4){cvtpk(p1[8 * s2], p1[8 * s2 + 1]), cvtpk(p1[8 * s2 + 2], p1[8 * s2 + 3]), cvtpk(p1[8 * s2 + 4], p1[8 * s2 + 5]), cvtpk(p1[8 * s2 + 6], p1[8 * s2 + 7])};
            }
#pragma unroll
            for (int ks = 0; ks < 4; ++ks)
#pragma unroll
                for (int db = 0; db < 2; ++db) {
                    const s16x4 lo = vtr(vp + db * 4096 + ks * 1024), hh = vtr(vp + db * 4096 + ks * 1024 + 512);
                    const bf16x8 vf = (bf16x8){lo[0], lo[1], lo[2], lo[3], hh[0], hh[1], hh[2], hh[3]};
                    o[qb][db] = __builtin_amdgcn_mfma_f32_32x32x16_bf16(__builtin_bit_cast(bf16x8, pw[ks]), vf, o[qb][db], 0, 0, 0);
                }
            asm volatile("" ::: "memory");
        }
    }
#pragma unroll
    for (int qb = 0; qb < 2; ++qb) { auto rr = __builtin_amdgcn_permlane32_swap(__float_as_uint(l[qb]), __float_as_uint(l[qb]), false, false); l[qb] = __uint_as_float(rr[0]) + __uint_as_float(rr[1]);
        if (hi == 0) wsf[qb * 32 + r32] = 1.0f / l[qb]; }
    asm volatile("s_waitcnt lgkmcnt(0)" ::: "memory");
    LAS bf16* stg = (LAS bf16*)vbuf;
    { LAS bf16* sb = stg + (4 * hi) * 64 + r32; const LAS float* wb = wsf + 4 * hi;
#pragma unroll
      for (int qb = 0; qb < 2; ++qb)
#pragma unroll
          for (int i = 0; i < 16; ++i) { const int qc = qb * 32 + (i & 3) + 8 * (i >> 2); const float rl = wb[qc];
#pragma unroll
              for (int db = 0; db < 2; ++db) sb[qc * 64 + db * 32] = (bf16)f2bf(o[qb][db][i] * rl); } }
    asm volatile("s_waitcnt lgkmcnt(0)" ::: "memory");
#pragma unroll
    for (int i = 0; i < 8; ++i) { const int row = i * 8 + (lane >> 3), ch = lane & 7; const u32x4 v = *(const LAS u32x4*)(stg + row * 64 + ch * 8);
        *(GAS u32x4*)(OB + (qrow0 + row) * 512 + h * 64 + ch * 8) = v; }
    asm volatile("s_waitcnt vmcnt(0) lgkmcnt(0)" ::: "memory");
#undef NA_DMA
#undef NA_KROW
}
}
__device__ __forceinline__ void p2b_natten_mfma(Frame& F, bf16* OB) {
    bf16* QB = (bf16*)(F.ws + WS_QB); const bf16* KB = (const bf16*)(F.ws + WS_KB); const bf16* VB = (const bf16*)(F.ws + WS_VB);
    const float* bias = F.in[18];
    float bm = 0.f; for (int i = F.lane; i < NH * 15 * 31; i += 64) bm = fmaxf(bm, fabsf(bias[i]));
#pragma unroll
    for (int o = 1; o < 64; o <<= 1) bm = fmaxf(bm, __shfl_xor(bm, o));
    const float mb = qk_bound(F.in[16], F.in[17]) + bm * LOG2E;
    LAS float* BL = (LAS float*)(F.lds + 131072);
    for (int i = F.tid; i < NH * 512; i += NTHR) { const int h = i >> 9, e = i & 511; BL[i] = e < 465 ? bias[h * 465 + e] * LOG2E : 0.f; }
    __syncthreads();
#if defined(PROBE_NA2)
    for (int u = F.bid; u < 2 * NB * NROWS; u += F.G) { const int uu = u % (NB * NROWS); nattn::unit(uu / NROWS, uu % NROWS, QB, u < NB * NROWS ? (bf16*)(F.ws + WS_XN) : OB, KB, VB, F.lds, mb); }
#else
    for (int u = F.bid; u < NB * NROWS; u += F.G) nattn::unit(u / NROWS, u % NROWS, QB, OB, KB, VB, F.lds, mb);
#endif
    __syncthreads();
}

struct EpiMergeA {
    static constexpr bool PERM = true; const bf16* GA; bf16* Y;
    __device__ __forceinline__ void operator()(const f32x4 (&acc)[2][2][4][2], const pg8::Unit& u, int wr, int wc, int fr, int fq) const {
#pragma unroll
        for (int ai = 0; ai < 2; ++ai)
#pragma unroll
            for (int m = 0; m < 4; ++m) { const size_t ro = (size_t)(u.pm * 256 + ai * 128 + wr * 64 + m * 16 + fr) * D + u.pn * 256 + wc * 32 + 8 * fq;
#pragma unroll
                for (int bj = 0; bj < 2; ++bj) { const u32x4 gv = *(const GAS u32x4*)(GA + ro + bj * 128); const f32x4 a = acc[ai][bj][m][0], b = acc[ai][bj][m][1];
                    u32x4 w; w.x = pg8::cvt_pk_bf16(bf2f(gv.x & 0xffffu) * a.x, bf2f(gv.x >> 16) * a.y); w.y = pg8::cvt_pk_bf16(bf2f(gv.y & 0xffffu) * a.z, bf2f(gv.y >> 16) * a.w);
                    w.z = pg8::cvt_pk_bf16(bf2f(gv.z & 0xffffu) * b.x, bf2f(gv.z >> 16) * b.y); w.w = pg8::cvt_pk_bf16(bf2f(gv.w & 0xffffu) * b.z, bf2f(gv.w >> 16) * b.w);
                    *(GAS u32x4*)(Y + ro + bj * 128) = w; } }
    }
};
struct EpiMergeB {
    static constexpr bool PERM = true; const bf16* GB; bf16* Y;
    __device__ __forceinline__ void operator()(const f32x4 (&acc)[2][2][4][2], const pg8::Unit& u, int wr, int wc, int fr, int fq) const {
#pragma unroll
        for (int ai = 0; ai < 2; ++ai)
#pragma unroll
            for (int m = 0; m < 4; ++m) { const size_t ro = (size_t)(u.pm * 256 + ai * 128 + wr * 64 + m * 16 + fr) * D + u.pn * 256 + wc * 32 + 8 * fq;
#pragma unroll
                for (int bj = 0; bj < 2; ++bj) { const u32x4 gv = *(const GAS u32x4*)(GB + ro + bj * 128); const u32x4 yv = *(const GAS u32x4*)(Y + ro + bj * 128); const f32x4 a = acc[ai][bj][m][0], b = acc[ai][bj][m][1];
                    u32x4 w; w.x = pg8::cvt_pk_bf16(bf2f(yv.x & 0xffffu) + bf2f(gv.x & 0xffffu) * a.x, bf2f(yv.x >> 16) + bf2f(gv.x >> 16) * a.y);
                    w.y = pg8::cvt_pk_bf16(bf2f(yv.y & 0xffffu) + bf2f(gv.y & 0xffffu) * a.z, bf2f(yv.y >> 16) + bf2f(gv.y >> 16) * a.w);
                    w.z = pg8::cvt_pk_bf16(bf2f(yv.z & 0xffffu) + bf2f(gv.z & 0xffffu) * b.x, bf2f(yv.z >> 16) + bf2f(gv.z >> 16) * b.y);
                    w.w = pg8::cvt_pk_bf16(bf2f(yv.w & 0xffffu) + bf2f(gv.w & 0xffffu) * b.z, bf2f(yv.w >> 16) + bf2f(gv.w >> 16) * b.w);
                    *(GAS u32x4*)(Y + ro + bj * 128) = w; } }
    }
};
struct EpiOut {
    static constexpr bool PERM = false; const float* x; const float* MOD; float* XMID;
    __device__ __forceinline__ void operator()(const f32x4 (&acc)[2][2][4][2], const pg8::Unit& u, int wr, int wc, int fr, int fq) const {
        const int b = (u.pm * 256) / SEQ; const int col0 = u.pn * 256 + wc * 32 + 4 * fq;
        f32x4 g[2][2];
#pragma unroll
        for (int bj = 0; bj < 2; ++bj)
#pragma unroll
            for (int n = 0; n < 2; ++n) g[bj][n] = *(const f32x4*)(MOD + b * 6144 + 2048 + col0 + bj * 128 + n * 16);
#pragma unroll
        for (int ai = 0; ai < 2; ++ai)
#pragma unroll
            for (int m = 0; m < 4; ++m) { const size_t ro = (size_t)(u.pm * 256 + ai * 128 + wr * 64 + m * 16 + fr) * D + col0;
#pragma unroll
                for (int bj = 0; bj < 2; ++bj)
#pragma unroll
                    for (int n = 0; n < 2; ++n) { const f32x4 xv = *(const f32x4*)(x + ro + bj * 128 + n * 16); *(f32x4*)(XMID + ro + bj * 128 + n * 16) = xv + g[bj][n] * acc[ai][bj][m][n]; } }
    }
};
__device__ __forceinline__ void p3_merge_out_mfma(Frame& F, int part) {
    bf16* Y = (bf16*)(F.ws + WS_Y); const bf16* GA = (const bf16*)F.out;
    if (part == 0) {
        { pg8::Gemm g{(const bf16*)(F.ws + WS_QA), (const bf16*)(F.ws + WS_WA), D, D, D}; pg8::DenseOrder S; S.init(T, D, F.G, F.bid, D); EpiMergeA E{GA, Y}; pg8::gemm_phase<EpiMergeA, pg8::DenseOrder>(F.lds, g, S, E); }
        asm volatile("s_waitcnt vmcnt(0)" ::: "memory"); __syncthreads();
        { pg8::Gemm g{(const bf16*)(F.ws + WS_QB), (const bf16*)(F.ws + WS_WB), 512, 512, 512}; pg8::DenseOrder S; S.init(T, D, F.G, F.bid, 512); EpiMergeB E{GA + (size_t)T * D, Y}; pg8::gemm_phase<EpiMergeB, pg8::DenseOrder>(F.lds, g, S, E); }
    } else {
        pg8::Gemm g{Y, (const bf16*)(F.ws + WS_WO), D, D, D}; pg8::DenseOrder S; S.init(T, D, F.G, F.bid, D);
        EpiOut E{F.in[0], (const float*)(F.ws + WS_MOD), (float*)(F.ws + WS_XMID)}; pg8::gemm_phase<EpiOut, pg8::DenseOrder>(F.lds, g, S, E);
    }
}

constexpr int MOE_TAB_OFF = 132096;
struct MoeTab { LAS int* cnt; LAS int* tpre; LAS int* sbase; };
__device__ __forceinline__ MoeTab moe_tables(Frame& F) {
    MoeTab G; G.cnt = (LAS int*)(F.lds + MOE_TAB_OFF); G.tpre = G.cnt + 64; G.sbase = G.tpre + 65;
    __syncthreads();
    if (F.tid < 64) G.cnt[F.tid] = (int)__hip_atomic_load(F.ctl + CW_CNT + 64 * F.tid, __ATOMIC_RELAXED, __HIP_MEMORY_SCOPE_AGENT);
    __syncthreads();
    if (F.tid == 0) { int tp = 0; for (int g = 0; g < 64; ++g) { G.tpre[g] = tp; G.sbase[g] = tp * 256; tp += (G.cnt[g] + 255) / 256; } G.tpre[64] = tp; }
    __syncthreads();
    return G;
}
struct MoeOrder {
    MoeTab G; int t_lo, t_hi, Gn, c; const int* LIST; int ldb; bool gather;
    __device__ __forceinline__ bool next(int i, pg8::Unit& u) const {
        const long L = (long)i * Gn + c; const int tile = t_lo + (int)(L >> 2); if (tile >= t_hi) return false;
        int g = 0;
        for (int k = 0; k < 64; ++k) g += (G.tpre[k + 1] <= tile) ? 1 : 0;
        u.pm = tile - G.tpre[g]; u.pn = (int)(L & 3); u.a0 = g; u.a1 = tile * 256; return true;
    }
    __device__ __forceinline__ int arow(const pg8::Unit& u, int r) const {
        if (!gather) return u.a1 + r;
        const int idx = u.pm * 256 + r; const int cnt = G.cnt[u.a0]; return LIST[(size_t)u.a0 * T + (idx < cnt ? idx : 0)];
    }
    __device__ __forceinline__ size_t boff(const pg8::Unit& u) const { return ((size_t)(u.a0 & 31) * 1024 + (size_t)u.pn * 256) * ldb; }
};
struct EpiGateUp {
    static constexpr bool PERM = true; bf16* HID;
    __device__ __forceinline__ void operator()(const f32x4 (&acc)[2][2][4][2], const pg8::Unit& u, int wr, int wc, int fr, int fq) const {
#pragma unroll
        for (int ai = 0; ai < 2; ++ai)
#pragma unroll
            for (int m = 0; m < 4; ++m) { const size_t ro = (size_t)(u.a1 + ai * 128 + wr * 64 + m * 16 + fr) * EH + u.pn * 128 + wc * 32 + 8 * fq;
                const f32x4 ga = acc[ai][0][m][0], gb = acc[ai][0][m][1], ua = acc[ai][1][m][0], ub = acc[ai][1][m][1];
                u32x4 w; w.x = pg8::cvt_pk_bf16(silu_f(ga.x) * ua.x, silu_f(ga.y) * ua.y); w.y = pg8::cvt_pk_bf16(silu_f(ga.z) * ua.z, silu_f(ga.w) * ua.w);
                w.z = pg8::cvt_pk_bf16(silu_f(gb.x) * ub.x, silu_f(gb.y) * ub.y); w.w = pg8::cvt_pk_bf16(silu_f(gb.z) * ub.z, silu_f(gb.w) * ub.w);
                *(GAS u32x4*)(HID + ro) = w; }
    }
};
struct EpiDown {
    static constexpr bool PERM = false; MoeTab G; const int* LIST; const float* RT; const float* MOD; const float* base; float* out; int kk;
    __device__ __forceinline__ void operator()(const f32x4 (&acc)[2][2][4][2], const pg8::Unit& u, int wr, int wc, int fr, int fq) const {
        const int cnt = G.cnt[u.a0]; const int col0 = u.pn * 256 + wc * 32 + 4 * fq;
#pragma unroll
        for (int ai = 0; ai < 2; ++ai)
#pragma unroll
            for (int m = 0; m < 4; ++m) { const int idx = u.pm * 256 + ai * 128 + wr * 64 + m * 16 + fr;
                if (idx < cnt) { const int tok = LIST[(size_t)u.a0 * T + idx]; const int b = tok / SEQ; const float w = RT[(size_t)tok * 4 + kk]; const size_t ro = (size_t)tok * D + col0;
#pragma unroll
                    for (int bj = 0; bj < 2; ++bj)
#pragma unroll
                        for (int n = 0; n < 2; ++n) { const f32x4 g2 = *(const f32x4*)(MOD + b * 6144 + 5120 + col0 + bj * 128 + n * 16); const f32x4 bv = *(const f32x4*)(base + ro + bj * 128 + n * 16);
                            *(f32x4*)(out + ro + bj * 128 + n * 16) = bv + g2 * w * acc[ai][bj][m][n]; } } }
    }
};
__device__ __forceinline__ void p4_moe_mfma(Frame& F, int part) {
    const MoeTab G = moe_tables(F); const int* LIST = (const int*)(F.ws + WS_LIST);
    if (part == 0) {
        pg8::Gemm g{(const bf16*)(F.ws + WS_H2), (const bf16*)(F.ws + WS_WGU), D, D, D};
        MoeOrder S{G, 0, G.tpre[64], F.G, F.bid, LIST, D, true}; EpiGateUp E{(bf16*)(F.ws + WS_HID)};
        pg8::gemm_phase<EpiGateUp, MoeOrder>(F.lds, g, S, E);
    } else {
        const int kk = part - 1;
        pg8::Gemm g{(const bf16*)(F.ws + WS_HID), (const bf16*)(F.ws + WS_WD), EH, EH, EH};
        MoeOrder S{G, G.tpre[32 * kk], G.tpre[32 * kk + 32], F.G, F.bid, LIST, EH, false};
        EpiDown E{G, LIST, (const float*)(F.ws + WS_RT), (const float*)(F.ws + WS_MOD), kk == 0 ? (const float*)(F.ws + WS_XMID) : (const float*)F.out, F.out, kk};
        pg8::gemm_phase<EpiDown, MoeOrder>(F.lds, g, S, E);
    }
}

constexpr int NPHASE = 11;
__global__ void __launch_bounds__(NTHR, 2) mk_fwd(Args args) {
    extern __shared__ __attribute__((aligned(16))) unsigned char lds[];
    Frame F;
    F.lds = (LAS unsigned char*)lds; F.ws = args.ws; F.ctl = (gu32*)(args.ws + WS_CTL);
    F.tid = threadIdx.x; F.lane = F.tid & 63; F.wave = __builtin_amdgcn_readfirstlane(F.tid >> 6); F.G = gridDim.x; F.bid = blockIdx.x;
#pragma unroll
    for (int i = 0; i < 29; ++i) F.in[i] = args.in[i];
    F.out = args.out;
    volatile LAS unsigned* MISC = (volatile LAS unsigned*)(F.lds + LDS_BYTES - 64);
    if (F.tid < 16) MISC[F.tid] = 0u;
    __syncthreads();
    XcdBarrier bar; bar.bar = (unsigned*)(F.ctl + CW_BAR); bar.x = 0; bar.st = nullptr;
    if (MK_N_LAUNCHES == 1) bar = xcd_barrier_post((unsigned*)(F.ctl + CW_BAR), MISC);
    const int lo = args.ph_lo, hi = args.ph_hi;
#ifndef PH_MASK
#define PH_MASK 0x7ff
#endif
#define IN(k) (((PH_MASK >> (k)) & 1) && lo <= (k) && (k) < hi)
#ifndef PROBE_DUP
#define PROBE_DUP (-1)
#endif
#define REPS(k) for (int rep = (PROBE_DUP == (k)) ? 0 : 1; rep < 2; ++rep)
#define SEAM(k) do { if (IN(k) && IN((k) + 1)) xcd_barrier(bar); } while (0)
    if (IN(0)) REPS(0) { p0_adaln_rope(F); p0_weights(F); }
    SEAM(0);
    if (IN(1)) REPS(1) p1a_norm1(F);
    SEAM(1);
#ifdef NAIVE_INPROJ
    if (IN(2)) p1b_inproj(F);
#else
    if (IN(2)) REPS(2) p1b_inproj_mfma(F);
#endif
    SEAM(2);
#ifdef NAIVE_DATTN
    if (IN(3)) p2a_diffattn(F);
#else
#ifdef PROBE_ATT_VAR
    if (IN(3)) { p2a_diffattn_mfma<PROBE_ATT_VAR>(F, (bf16*)(F.ws + WS_XN)); asm volatile("s_waitcnt vmcnt(0)" ::: "memory"); __syncthreads(); }
#endif
    if (IN(3)) p2a_diffattn_mfma<0>(F, (bf16*)(F.ws + WS_QA));
#endif
    SEAM(3);
#ifdef NAIVE_NATTN
    if (IN(4)) p2b_natten(F);
#else
    if (IN(4)) REPS(4) p2b_natten_mfma(F, (bf16*)(F.ws + (rep ? WS_QB : WS_XN)));
#endif
    SEAM(4);
#ifdef NAIVE_MERGE
    if (IN(5)) p3a_merge(F);
#else
    if (IN(5)) REPS(5) p3_merge_out_mfma(F, 0);
#endif
    SEAM(5);
#ifdef NAIVE_MERGE
    if (IN(6)) p3b_out(F);
#else
    if (IN(6)) { if (PROBE_DUP == 6) { p3_merge_out_mfma(F, 1); asm volatile("s_waitcnt vmcnt(0)" ::: "memory"); __syncthreads(); } p3_merge_out_mfma(F, 1); }
#endif
    SEAM(6);
    if (IN(7)) REPS(7) p4a_norm2_route(F, rep == 0);
    SEAM(7);
#ifdef NAIVE_MOE
    if (IN(8)) p4b_gateup(F);
#else
    if (IN(8)) REPS(8) p4_moe_mfma(F, 0);
#endif
    SEAM(8);
#ifdef NAIVE_MOE
    if (IN(9)) p4c_down(F, 0);
#else
    if (IN(9)) { if (PROBE_DUP == 9) { p4_moe_mfma(F, 1); asm volatile("s_waitcnt vmcnt(0)" ::: "memory"); __syncthreads(); } p4_moe_mfma(F, 1); }
#endif
    SEAM(9);
#ifdef NAIVE_MOE
    if (IN(10)) p4c_down(F, 1);
#else
    if (IN(10)) p4_moe_mfma(F, 2);
#endif
#undef IN
#undef SEAM
}

extern "C" void kernel_launch(void* const* d_in, const int* in_sizes, int n_in, void* d_out, int out_size, void* d_ws, size_t ws_size, hipStream_t stream) {
    static int grid = 0;
    if (grid == 0) {
        if (n_in != 29 || out_size != T * D || ws_size < WS_END) { fprintf(stderr, "kernel_launch: unexpected shapes: n_in %d out %d ws %zu\n", n_in, out_size, ws_size); grid = -1; return; }
        int dev = 0, cus = 0, per_cu = 0;
        if (hipGetDevice(&dev) != hipSuccess || hipDeviceGetAttribute(&cus, hipDeviceAttributeMultiprocessorCount, dev) != hipSuccess) { grid = -1; return; }
        if (hipFuncSetAttribute((const void*)mk_fwd, hipFuncAttributeMaxDynamicSharedMemorySize, LDS_BYTES) != hipSuccess) { fprintf(stderr, "kernel_launch: hipFuncSetAttribute failed\n"); grid = -1; return; }
        if (hipOccupancyMaxActiveBlocksPerMultiprocessor(&per_cu, (const void*)mk_fwd, NTHR, LDS_BYTES) != hipSuccess || per_cu < 1) fprintf(stderr, "kernel_launch: occupancy query says %d\n", per_cu);
        (void)hipGetLastError();
        grid = cus;
    }
    if (grid < 0) return;
    if (hipMemsetAsync((char*)d_ws + WS_CTL, 0, CTL_ZERO_BYTES, stream) != hipSuccess) return;
    Args a{};
    for (int i = 0; i < 29; ++i) a.in[i] = (const float*)d_in[i];
    a.out = (float*)d_out; a.ws = (unsigned char*)d_ws;
    if (MK_N_LAUNCHES == 1) { a.ph_lo = 0; a.ph_hi = NPHASE; hipLaunchKernelGGL(mk_fwd, dim3(grid), dim3(NTHR), LDS_BYTES, stream, a); }
    else for (int p = 0; p < NPHASE; ++p) { a.ph_lo = p; a.ph_hi = p + 1; hipLaunchKernelGGL(mk_fwd, dim3(grid), dim3(NTHR), LDS_BYTES, stream, a); }
}
```

```cpp
#include <hip/hip_runtime.h>
#include <cstdio>
#include <cstdint>

#ifndef MK_N_LAUNCHES
#define MK_N_LAUNCHES 1
#endif

constexpr int NB = 4, SEQ = 8192, D = 1024, T = NB * SEQ, CTX = 256, TC = NB * CTX, MROWS = T + TC;
constexpr int KVL = CTX + SEQ;
constexpr int NIN = 6656, GRIDW = 64, NROWS = SEQ / GRIDW;
constexpr int NH = 8, HD = 64;
constexpr int NEXP = 32, EH = 512, NGRP = 4, EPG = 8;
constexpr int NLIST = 64;
constexpr float EPS = 1e-6f;
constexpr float LOG2E = 1.4426950408889634f;
constexpr float C2 = 0.125f * LOG2E;

constexpr size_t MiB = 1u << 20;
constexpr size_t WS_CTL = 0, CTL_ZERO_BYTES = 1 * MiB;
constexpr size_t WS_MOD = 1 * MiB;
constexpr size_t WS_ROPE = 1 * MiB + 256 * 1024;
constexpr size_t WS_LIST = 488 * MiB;
constexpr size_t WS_WIN = 12 * MiB;
constexpr size_t WS_WA = 25 * MiB, WS_WB = 27 * MiB, WS_WO = 28 * MiB;
constexpr size_t WS_WGU = 30 * MiB;
constexpr size_t WS_WD = 94 * MiB;
constexpr size_t WS_XN = 126 * MiB;
constexpr size_t WS_QA = 192 * MiB;
constexpr size_t WS_QB = 256 * MiB;
constexpr size_t WS_KA = 288 * MiB;
constexpr size_t WS_VA = 354 * MiB;
constexpr size_t WS_KB = 420 * MiB;
constexpr size_t WS_VB = 453 * MiB;
constexpr size_t WS_END = 504 * MiB;
constexpr size_t WS_Y = WS_XN, WS_H2 = WS_XN, WS_HID = WS_QA, WS_XMID = WS_KA;
constexpr int CW_TMO = 0, CW_BAR = 4096, CW_CNT = 16384;

constexpr int LDS_BYTES = 155648;
constexpr int NTHR = 512;

#define GAS __attribute__((address_space(1)))
#define LAS __attribute__((address_space(3)))
typedef unsigned short bf16;
typedef float f32x4 __attribute__((ext_vector_type(4)));
typedef float f32x2 __attribute__((ext_vector_type(2)));
typedef unsigned u32x4 __attribute__((ext_vector_type(4)));
typedef unsigned u32x2 __attribute__((ext_vector_type(2)));
typedef GAS unsigned gu32;

__device__ __forceinline__ unsigned f2bf(float f) { unsigned u = __builtin_bit_cast(unsigned, f); return (u + 0x7fffu + ((u >> 16) & 1u)) >> 16; }
__device__ __forceinline__ float bf2f(unsigned h) { return __builtin_bit_cast(float, h << 16); }
__device__ __forceinline__ float rbf(float f) { return bf2f(f2bf(f)); }
__device__ __forceinline__ unsigned pk2(float lo, float hi) { return f2bf(lo) | (f2bf(hi) << 16); }

#define XB_TMO      128
#define XB_XCNT(j)  (256  + 64 * (j))
#define XB_XSUB(j)  (1280 + 64 * (j))
#define XB_XGEN(j)  (2304 + 64 * (j))
#define XB_TOP      3328
#define XB_TOPGEN   3392
#define XCD_BAR_WORDS 3456
#define XB_SPIN_CAP (1u << 18)
__device__ __forceinline__ unsigned xb_ld(unsigned* p)              { return __hip_atomic_load(p, __ATOMIC_RELAXED, __HIP_MEMORY_SCOPE_AGENT); }
__device__ __forceinline__ unsigned xb_add(unsigned* p, unsigned v) { return __hip_atomic_fetch_add(p, v, __ATOMIC_RELAXED, __HIP_MEMORY_SCOPE_AGENT); }
__device__ __forceinline__ unsigned xb_xcc_id() { return (unsigned)__builtin_amdgcn_s_getreg((3 << 11) | 20) & 0xFu; }
#define XB_SPIN(cond, bar) do { unsigned _sp = 0; while (cond) { __builtin_amdgcn_s_sleep(1); \
    if ((++_sp & 255u) == 0u) { if (xb_ld(&(bar)[XB_TMO])) break; if (_sp > XB_SPIN_CAP) { atomicAdd(&(bar)[XB_TMO], 1u); break; } } } } while (0)
struct XcdBarrier { unsigned* bar; unsigned x; volatile LAS unsigned* st; };
__device__ __forceinline__ XcdBarrier xcd_barrier_post(unsigned* bar, volatile LAS unsigned* st) {
    XcdBarrier b; b.bar = bar; b.x = xb_xcc_id(); b.st = st;
    if (threadIdx.x == 0) (void)xb_add(&bar[XB_XCNT(b.x)], 1u);
    return b;
}
__device__ __forceinline__ void xcd_barrier_complete(unsigned* bar, unsigned x, unsigned& nloc, unsigned& nx) {
    const unsigned G = gridDim.x * gridDim.y * gridDim.z;
    unsigned sum, cnt, mine, sp = 0u;
    for (;;) {
        sum = 0u; cnt = 0u; mine = 0u;
#pragma unroll
        for (unsigned j = 0; j < 16; ++j) { const unsigned c = xb_ld(&bar[XB_XCNT(j)]); sum += c; cnt += (c > 0u) ? 1u : 0u; mine = (j == x) ? c : mine; }
        if (sum == G) break;
        __builtin_amdgcn_s_sleep(1);
        if ((++sp & 255u) == 0u) { if (xb_ld(&bar[XB_TMO])) break; if (sp > XB_SPIN_CAP) { atomicAdd(&bar[XB_TMO], 1u); break; } }
    }
    nloc = mine > 0u ? mine : 1u; nx = cnt > 0u ? cnt : 1u;
}
__device__ __forceinline__ void xcd_barrier(const XcdBarrier& b) {
    asm volatile("s_waitcnt vmcnt(0)" ::: "memory");
    __syncthreads();
    if (threadIdx.x == 0) {
        unsigned* bar = b.bar;
        __builtin_amdgcn_s_waitcnt(0);
        unsigned nloc = b.st[0], nx = b.st[1];
        if (nloc == 0u) { xcd_barrier_complete(bar, b.x, nloc, nx); b.st[0] = nloc; b.st[1] = nx; }
        const unsigned old = xb_add(&bar[XB_XSUB(b.x)], 1u);
        const unsigned gen = old / nloc;
        if (old + 1u == (gen + 1u) * nloc) {
            __builtin_amdgcn_fence(__ATOMIC_RELEASE, "agent");
            asm volatile("s_waitcnt vmcnt(0)" ::: "memory");
            const unsigned og = xb_add(&bar[XB_TOP], 1u);
            const unsigned tg = og / nx;
            if (og + 1u == (tg + 1u) * nx) xb_add(&bar[XB_TOPGEN], 1u);
            else XB_SPIN(xb_ld(&bar[XB_TOPGEN]) == tg, bar);
            __builtin_amdgcn_fence(__ATOMIC_ACQUIRE, "agent");
            xb_add(&bar[XB_XGEN(b.x)], 1u);
            asm volatile("s_waitcnt vmcnt(0)" ::: "memory");
        } else {
            XB_SPIN(xb_ld(&bar[XB_XGEN(b.x)]) == gen, bar);
            __builtin_amdgcn_fence(__ATOMIC_ACQUIRE, "agent");
            asm volatile("s_waitcnt vmcnt(0)" ::: "memory");
        }
    }
    __syncthreads();
}

namespace pg8 {
#define PG8_LAS __attribute__((address_space(3)))
typedef unsigned short bf16_t;
typedef short bf16x8 __attribute__((ext_vector_type(8)));
constexpr int BM = 256, BK = 64, HALF = 128, HTB = HALF * BK * 2, STAGE_BYTES = 8 * HTB, NXCD = 8, WGM = 8;
__host__ __device__ __forceinline__ int lds_byte(int r, int c) { const int st = (r >> 4) * 2 + (c >> 5), rr = r & 15, cc = c & 31, ob = rr * 64 + cc * 2; return st * 1024 + (ob ^ (((ob >> 9) & 1) << 5)); }
__host__ __device__ __forceinline__ void stage_rc(int b, int& R, int& C) { const int st = b / 1024, sb = b % 1024, swz = sb ^ (((sb >> 9) & 1) << 5); R = (st >> 1) * 16 + swz / 64; C = (st & 1) * 32 + (swz % 64) / 2; }
__host__ __device__ __forceinline__ int perm32(int rho) { const int n = rho >> 4, i = rho & 15; return 8 * (i >> 2) + 4 * n + (i & 3); }
struct Unit { int pm, pn, a0, a1; };
struct Gemm { const bf16_t* A; const bf16_t* Bt; int lda, ldb, K; };
__device__ __forceinline__ unsigned cvt_pk_bf16(float lo, float hi) { unsigned r; asm volatile("v_cvt_pk_bf16_f32 %0, %1, %2" : "=v"(r) : "v"(lo), "v"(hi)); return r; }

struct DenseOrder {
    int nM, nN, nwg, G, c, ldb;
    __device__ void init(int M, int N, int G_, int c_, int ldb_) { nM = M / BM; nN = N / BM; nwg = nM * nN; G = G_; c = c_; ldb = ldb_; }
    __device__ __forceinline__ bool map(long L, Unit& u) const {
        if (L >= nwg) return false;
        int wgid = (int)L; { const int q = nwg / NXCD, r = nwg % NXCD, xcd = wgid % NXCD, off = wgid / NXCD; wgid = (xcd < r ? xcd * (q + 1) : r * (q + 1) + (xcd - r) * q) + off; }
        const int nig = WGM * nN, gid = wgid / nig, fm = gid * WGM, gsz = (nM - fm) < WGM ? (nM - fm) : WGM;
        u.pm = fm + ((wgid % nig) % gsz); u.pn = (wgid % nig) / gsz; u.a0 = 0; u.a1 = 0; return true;
    }
    __device__ __forceinline__ bool next(int i, Unit& u) const { return map((long)i * G + c, u); }
    __device__ __forceinline__ int arow(const Unit& u, int r) const { return u.pm * BM + r; }
    __device__ __forceinline__ size_t boff(const Unit& u) const { return (size_t)u.pn * BM * ldb; }
};

template <class Epi, class Sched>
__device__ __forceinline__ void gemm_phase(PG8_LAS unsigned char* lds, const Gemm g, const Sched& S, const Epi& E) {
    const int tid = threadIdx.x, wid = __builtin_amdgcn_readfirstlane(tid >> 6), lane = tid & 63, wr = wid >> 2, wc = wid & 3, fr = lane & 15, fq = lane >> 4;
    const int nt = g.K / BK;
    int RA[2], CA[2]; unsigned voffB[2];
#pragma unroll
    for (int i = 0; i < 2; ++i) { int R, C; stage_rc(tid * 16 + i * 8192, R, C); const int Rb = Epi::PERM ? ((R & ~31) + perm32(R & 31)) : R;
        RA[i] = R; CA[i] = C * 2; voffB[i] = (unsigned)(Rb * g.ldb + C) * 2u; }
    const size_t kstep = (size_t)(BK * 2);
    const size_t hstepB = (size_t)HALF * g.ldb * 2;
    const unsigned ldsw = (unsigned)wid * 1024u;
    const int aoff = lds_byte(wr * 64 + fr, fq * 8), boff = lds_byte(wc * 32 + fr, fq * 8);
#define PG8_SA(b, h) (((b) * 2 + (h)) * HTB)
#define PG8_SB(b, h) ((4 + (b) * 2 + (h)) * HTB)
#define PG8_STAGE(bufoff, gbase, voff) do { _Pragma("unroll") for (int _i = 0; _i < 2; ++_i) \
        __builtin_amdgcn_global_load_lds((const unsigned*)((const char*)(gbase) + (voff)[_i]), (PG8_LAS unsigned*)(lds + (bufoff) + ldsw + _i * 8192), 16, 0, 0); } while (0)
#define PG8_LDA(dst, b, h) do { _Pragma("unroll") for (int m = 0; m < 4; ++m) _Pragma("unroll") for (int k = 0; k < 2; ++k) dst[m][k] = *(const PG8_LAS bf16x8*)(lds + PG8_SA(b, h) + aoff + m * 2048 + k * 1024); } while (0)
#define PG8_LDB(dst, b, h) do { _Pragma("unroll") for (int n = 0; n < 2; ++n) _Pragma("unroll") for (int k = 0; k < 2; ++k) dst[n][k] = *(const PG8_LAS bf16x8*)(lds + PG8_SB(b, h) + boff + n * 2048 + k * 1024); } while (0)
#define PG8_MMA(ai, bj, At, Bt) do { __builtin_amdgcn_s_setprio(1); _Pragma("unroll") for (int m = 0; m < 4; ++m) _Pragma("unroll") for (int n = 0; n < 2; ++n) _Pragma("unroll") for (int k = 0; k < 2; ++k) \
        acc[ai][bj][m][n] = __builtin_amdgcn_mfma_f32_16x16x32_bf16(Bt[n][k], At[m][k], acc[ai][bj][m][n], 0, 0, 0); __builtin_amdgcn_s_setprio(0); } while (0)
#define PG8_WAIT_V(n) asm volatile("s_waitcnt vmcnt(" #n ")" ::: "memory")
#define PG8_WAIT_L(n) asm volatile("s_waitcnt lgkmcnt(" #n ")" ::: "memory")
#define PG8_BAR __builtin_amdgcn_s_barrier()
#define PG8_SCHED __builtin_amdgcn_sched_barrier(0)
#define PG8_AOFFS(dst, u) do { _Pragma("unroll") for (int _h = 0; _h < 2; ++_h) _Pragma("unroll") for (int _i = 0; _i < 2; ++_i) \
        dst[_h][_i] = (unsigned)S.arow(u, _h * HALF + RA[_i]) * (unsigned)(g.lda * 2) + (unsigned)CA[_i]; } while (0)
    Unit cur, nxt; int ui = 0;
    if (!S.next(0, cur)) return;
    f32x4 acc[2][2][4][2];
#pragma unroll
    for (int a = 0; a < 2; ++a)
#pragma unroll
        for (int b = 0; b < 2; ++b)
#pragma unroll
            for (int m = 0; m < 4; ++m)
#pragma unroll
                for (int n = 0; n < 2; ++n) acc[a][b][m][n] = (f32x4){0.f, 0.f, 0.f, 0.f};
    bf16x8 At[4][2], B0[2][2], B1[2][2];
    unsigned oc[2][2], on[2][2];
    PG8_AOFFS(oc, cur);
    const char* gA = (const char*)g.A;
    const char* cB = (const char*)g.Bt + S.boff(cur) * 2;
    PG8_STAGE(PG8_SB(0, 0), cB, voffB); PG8_STAGE(PG8_SB(0, 1), cB + hstepB, voffB); PG8_STAGE(PG8_SA(0, 0), gA, oc[0]); PG8_STAGE(PG8_SA(0, 1), gA, oc[1]);
    if (wr == 1) PG8_BAR;
    PG8_WAIT_V(2); PG8_BAR;
    PG8_STAGE(PG8_SB(1, 0), cB + kstep, voffB); PG8_STAGE(PG8_SA(1, 0), gA + kstep, oc[0]); PG8_STAGE(PG8_SB(1, 1), cB + hstepB + kstep, voffB);
    PG8_WAIT_V(6); PG8_BAR;
    for (;;) {
        const bool has_next = S.next(ui + 1, nxt);
        if (has_next) { PG8_AOFFS(on, nxt); } else {
#pragma unroll
            for (int _h = 0; _h < 2; ++_h)
#pragma unroll
                for (int _i = 0; _i < 2; ++_i) on[_h][_i] = oc[_h][_i]; }
        const char* nB = has_next ? (const char*)g.Bt + S.boff(nxt) * 2 : cB;
        for (int t = 0; t < nt; t += 2) {
            const bool last = (t == nt - 2);
            const char* a1 = gA + (size_t)(t + 1) * kstep;
            const char* a2 = last ? gA : gA + (size_t)(t + 2) * kstep; const char* b2 = last ? nB : cB + (size_t)(t + 2) * kstep;
            const char* a3 = a2 + kstep; const char* b3 = b2 + kstep;
            unsigned os[2][2];
#pragma unroll
            for (int _h = 0; _h < 2; ++_h)
#pragma unroll
                for (int _i = 0; _i < 2; ++_i) os[_h][_i] = last ? on[_h][_i] : oc[_h][_i];
            PG8_LDB(B0, 0, 0); PG8_LDB(B1, 0, 1); PG8_SCHED; PG8_LDA(At, 0, 0); PG8_STAGE(PG8_SA(1, 1), a1, oc[1]);
            PG8_WAIT_V(8); PG8_WAIT_L(0); PG8_BAR; PG8_MMA(0, 0, At, B0); PG8_MMA(0, 1, At, B1); PG8_BAR; PG8_SCHED;
            PG8_LDA(At, 0, 1); PG8_STAGE(PG8_SB(0, 0), b2, voffB); PG8_STAGE(PG8_SB(0, 1), b2 + hstepB, voffB); PG8_STAGE(PG8_SA(0, 0), a2, os[0]);
            PG8_WAIT_V(8); PG8_WAIT_L(0); PG8_BAR; PG8_MMA(1, 0, At, B0); PG8_MMA(1, 1, At, B1); PG8_BAR; PG8_SCHED;
            PG8_LDB(B0, 1, 0); PG8_LDB(B1, 1, 1); PG8_SCHED; PG8_LDA(At, 1, 0); PG8_STAGE(PG8_SA(0, 1), a2, os[1]);
            PG8_WAIT_V(8); PG8_WAIT_L(0); PG8_BAR; PG8_MMA(0, 0, At, B0); PG8_MMA(0, 1, At, B1); PG8_BAR; PG8_SCHED;
            PG8_LDA(At, 1, 1); PG8_STAGE(PG8_SB(1, 0), b3, voffB); PG8_STAGE(PG8_SB(1, 1), b3 + hstepB, voffB); PG8_STAGE(PG8_SA(1, 0), a3, os[0]);
            PG8_WAIT_V(8); PG8_WAIT_L(0); PG8_BAR; PG8_MMA(1, 0, At, B0); PG8_MMA(1, 1, At, B1); PG8_BAR; PG8_SCHED;
        }
        if (wr == 0) PG8_BAR;
        E(acc, cur, wr, wc, fr, fq);
        if (!has_next) break;
#pragma unroll
        for (int a = 0; a < 2; ++a)
#pragma unroll
            for (int b = 0; b < 2; ++b)
#pragma unroll
                for (int m = 0; m < 4; ++m)
#pragma unroll
                    for (int n = 0; n < 2; ++n) acc[a][b][m][n] = (f32x4){0.f, 0.f, 0.f, 0.f};
        cur = nxt; cB = nB; ++ui;
#pragma unroll
        for (int _h = 0; _h < 2; ++_h)
#pragma unroll
            for (int _i = 0; _i < 2; ++_i) oc[_h][_i] = on[_h][_i];
        if (wr == 1) PG8_BAR;
    }
    PG8_WAIT_V(0);
    PG8_BAR;
#undef PG8_SA
#undef PG8_SB
#undef PG8_STAGE
#undef PG8_LDA
#undef PG8_LDB
#undef PG8_MMA
#undef PG8_WAIT_V
#undef PG8_WAIT_L
#undef PG8_BAR
#undef PG8_SCHED
#undef PG8_AOFFS
}
}

struct Args { const float* in[29]; float* out; unsigned char* ws; int ph_lo, ph_hi; };
struct Frame {
    LAS unsigned char* lds;
    unsigned char* ws; gu32* ctl;
    int tid, lane, wave, G, bid;
    const __attribute__((address_space(4))) unsigned char* ka;
    float* out;
    __device__ __forceinline__ const float* inp(int k) const { return *(const float* const __attribute__((address_space(4)))*)(ka + 8 * k); }
};
__device__ __forceinline__ float wave_sum(float v) {
#pragma unroll
    for (int o = 1; o < 64; o <<= 1) v += __shfl_xor(v, o);
    return v;
}
__device__ __forceinline__ float silu_f(float v) { return v / (1.f + __expf(-v)); }
__device__ __forceinline__ float sigmoid_f(float v) { return 1.f / (1.f + __expf(-v)); }

__constant__ float INV_FREQ[16] = {1.0f, 0.5623413324356079f, 0.3162277638912201f, 0.17782793939113617f, 0.10000000149011612f, 0.05623413249850273f, 0.03162277489900589f, 0.017782794311642647f,
    0.009999999776482582f, 0.005623413249850273f, 0.003162277629598975f, 0.0017782794311642647f, 0.0010000000474974513f, 0.000562341301701963f, 0.0003162277571391314f, 0.00017782794020604342f};
__device__ __forceinline__ double sin_poly(double r) { double r2 = r * r, t = r, s = r; for (int i = 1; i <= 12; ++i) { t *= -r2 / (double)((2 * i) * (2 * i + 1)); s += t; } return s; }
__device__ __forceinline__ double cos_poly(double r) { double r2 = r * r, t = 1.0, s = 1.0; for (int i = 1; i <= 12; ++i) { t *= -r2 / (double)((2 * i - 1) * (2 * i)); s += t; } return s; }
__device__ __forceinline__ void p0_adaln_rope(Frame& F) {
    const float* c = F.inp(1); const float* c_ctx = F.inp(3); const float* w_ada = F.inp(4); const float* b_ada = F.inp(5);
    float* MOD = (float*)(F.ws + WS_MOD);
    { float* RP = (float*)(F.ws + WS_ROPE);
      const int gi = F.bid * NTHR + F.tid;
      if (gi < 192 * 16) { const int pos = gi >> 4, f = gi & 15; const int p = pos < 128 ? pos : pos - 128;
          const float invf = INV_FREQ[f]; const float ang = (float)p * invf;
          const double a = (double)ang; const double k = rint(a * 0.15915494309189535); const double r = a - k * 6.283185307179586477;
          const float cs = (float)cos_poly(r), sn = (float)sin_poly(r);
          if (pos < 128) { RP[pos * 16 + f] = cs; RP[2048 + pos * 16 + f] = sn; } else { RP[4096 + p * 16 + f] = cs; RP[4096 + 1024 + p * 16 + f] = sn; } } }
    if (F.bid < 96) {
        LAS float* S = (LAS float*)F.lds;
        LAS float* R = S + 5 * 1024;
        for (int i = F.tid; i < 5 * 1024; i += NTHR) { const int r = i >> 10, k = i & 1023; const float v = r < 4 ? c[r * 1024 + k] : c_ctx[k]; S[i] = silu_f(v); }
        __syncthreads();
        for (int item = F.bid; item < 96; item += F.G) {
            const int c0 = item * 64; float acc[5] = {0.f, 0.f, 0.f, 0.f, 0.f};
            for (int kk = 0; kk < 128; ++kk) { const int k = F.wave * 128 + kk; const float w = w_ada[(size_t)k * 6144 + c0 + F.lane];
#pragma unroll
                for (int r = 0; r < 5; ++r) acc[r] += S[r * 1024 + k] * w; }
#pragma unroll
            for (int r = 0; r < 5; ++r) R[(F.wave * 5 + r) * 64 + F.lane] = acc[r];
            __syncthreads();
            if (F.tid < 320) { const int r = F.tid >> 6, l = F.tid & 63; float s = 0.f;
#pragma unroll
                for (int w = 0; w < 8; ++w) s += R[(w * 5 + r) * 64 + l];
                MOD[r * 6144 + c0 + l] = s + b_ada[c0 + l]; }
            __syncthreads();
        }
    }
}

__device__ __forceinline__ void norm_mod_row(const float* xrow, const float* nw, const float* scale, const float* shift, int lane, f32x4 (&v)[4]) {
    const GAS f32x4* xr = (const GAS f32x4*)xrow + lane; float ss = 0.f;
#pragma unroll
    for (int j = 0; j < 4; ++j) { v[j] = xr[64 * j]; ss += (v[j].x * v[j].x + v[j].y * v[j].y) + (v[j].z * v[j].z + v[j].w * v[j].w); }
    const float rstd = 1.0f / sqrtf(wave_sum(ss) * (1.f / D) + EPS);
#pragma unroll
    for (int j = 0; j < 4; ++j) { const int d0 = 4 * lane + 256 * j; const f32x4 w = *(const f32x4*)(nw + d0), sc = *(const f32x4*)(scale + d0), sh = *(const f32x4*)(shift + d0);
        v[j] = (v[j] * rstd * w) * (1.f + sc) + sh; }
}
__device__ __forceinline__ void store_row_bf16(bf16* orow, int lane, const f32x4 (&v)[4]) {
    GAS u32x2* o8 = (GAS u32x2*)orow + lane;
#pragma unroll
    for (int j = 0; j < 4; ++j) { u32x2 w; w.x = pk2(v[j].x, v[j].y); w.y = pk2(v[j].z, v[j].w); o8[64 * j] = w; }
}
__device__ __forceinline__ void p1a_norm1(Frame& F) {
    const float* x = F.inp(0); const float* ctx = F.inp(2); const float* nw = F.inp(6);
    const float* MOD = (const float*)(F.ws + WS_MOD); bf16* XN = (bf16*)(F.ws + WS_XN);
    const int gw = F.bid * 8 + F.wave, NGW = F.G * 8;
    for (int m = gw; m < MROWS; m += NGW) {
        const float* row; int mr;
        if (m < T) { row = x + (size_t)m * D; mr = m / SEQ; } else { row = ctx + (size_t)(m - T) * D; mr = 4; }
        f32x4 v[4]; norm_mod_row(row, nw, MOD + mr * 6144 + 1024, MOD + mr * 6144, F.lane, v);
        store_row_bf16(XN + (size_t)m * D, F.lane, v);
    }
}

__device__ __forceinline__ int kv_row(int m) { if (m < T) { const int b = m / SEQ, t = m - b * SEQ; return b * KVL + CTX + t; } const int cm = m - T, b = cm / CTX, c = cm - b * CTX; return b * KVL + c; }

__device__ __forceinline__ void p0_transpose_item(const float* W, int K, int N, bf16* WT, int kb, int n0, int dst_row0, LAS float* scr, int lane) {
    const int k0 = 64 * kb;
#pragma unroll 8
    for (int i = 0; i < 32; ++i) { const int kk = 2 * i + (lane >> 5); scr[kk * 33 + (lane & 31)] = W[(size_t)(k0 + kk) * N + n0 + (lane & 31)]; }
    asm volatile("s_waitcnt lgkmcnt(0)" ::: "memory");
    const int c = lane & 7;
#pragma unroll
    for (int j = 0; j < 4; ++j) { const int n = (lane >> 3) + 8 * j; const LAS float* sp = scr + (8 * c) * 33 + n;
        u32x4 o; o.x = pk2(sp[0 * 33], sp[1 * 33]); o.y = pk2(sp[2 * 33], sp[3 * 33]); o.z = pk2(sp[4 * 33], sp[5 * 33]); o.w = pk2(sp[6 * 33], sp[7 * 33]);
        *(GAS u32x4*)(WT + (size_t)(dst_row0 + n) * K + k0 + 8 * c) = o; }
    asm volatile("s_waitcnt lgkmcnt(0)" ::: "memory");
}
__device__ __forceinline__ int inproj_dst_row(int n0) { const int pn = n0 >> 8, w = n0 & 255, g = w >> 6, a = (w >> 5) & 1; return 256 * pn + 128 * a + 32 * g; }
__device__ __forceinline__ void p0_weights(Frame& F) {
    LAS float* scr = (LAS float*)(F.lds + 65536 + F.wave * 8704);
    const int gw = F.bid * 8 + F.wave, NGW = F.G * 8;
    constexpr int I_IN = 16 * 208, I_A = 16 * 32, I_B = 8 * 32, I_O = 16 * 32, I_G = 32 * 16 * 16, I_D = 32 * 8 * 32;
    constexpr int NITEMS = I_IN + I_A + I_B + I_O + 2 * I_G + I_D;
    for (int it = gw; it < NITEMS; it += NGW) {
        int r = it;
        if (r < I_IN) { const int kb = r / 208, n0 = (r % 208) * 32; p0_transpose_item(F.inp(8), 1024, NIN, (bf16*)(F.ws + WS_WIN), kb, n0, inproj_dst_row(n0), scr, F.lane); continue; } r -= I_IN;
        if (r < I_A) { const int kb = r / 32, n0 = (r % 32) * 32; p0_transpose_item(F.inp(19), 1024, 1024, (bf16*)(F.ws + WS_WA), kb, n0, n0, scr, F.lane); continue; } r -= I_A;
        if (r < I_B) { const int kb = r / 32, n0 = (r % 32) * 32; p0_transpose_item(F.inp(20), 512, 1024, (bf16*)(F.ws + WS_WB), kb, n0, n0, scr, F.lane); continue; } r -= I_B;
        if (r < I_O) { const int kb = r / 32, n0 = (r % 32) * 32; p0_transpose_item(F.inp(21), 1024, 1024, (bf16*)(F.ws + WS_WO), kb, n0, n0, scr, F.lane); continue; } r -= I_O;
        if (r < 2 * I_G) { const int up = r >= I_G; if (up) r -= I_G; const int e = r / 256, q = r % 256, kb = q / 16, n0 = (q % 16) * 32;
            const int drow = 256 * (n0 >> 7) + 128 * up + (n0 & 127);
            p0_transpose_item(F.inp(up ? 27 : 26) + (size_t)e * 1024 * EH, 1024, EH, (bf16*)(F.ws + WS_WGU) + (size_t)e * 1024 * 1024, kb, n0, drow, scr, F.lane); continue; } r -= 2 * I_G;
        { const int e = r / 256, q = r % 256, kb = q / 32, n0 = (q % 32) * 32;
            p0_transpose_item(F.inp(28) + (size_t)e * EH * 1024, EH, 1024, (bf16*)(F.ws + WS_WD) + (size_t)e * 1024 * EH, kb, n0, n0, scr, F.lane); }
    }
}

struct InProjOrder {
    pg8::DenseOrder d;
    __device__ __forceinline__ bool next(int i, pg8::Unit& u) const {
        long L = (long)i * d.G + d.c;
#if defined(PROBE_INPROJ2)
        if (L >= d.nwg + 48) L -= d.nwg + 48;
        if (i >= 27) return false;
#endif
        if (L < d.nwg) return d.map(L, u);
        const int j = (int)(L - d.nwg); if (j >= 48) return false;
        const int c = j % 12; u.pm = 128 + j / 12; u.pn = c < 8 ? 4 + c : 14 + (c - 8); u.a0 = 0; u.a1 = 0; return true;
    }
    __device__ __forceinline__ int arow(const pg8::Unit& u, int r) const { return u.pm * 256 + r; }
    __device__ __forceinline__ size_t boff(const pg8::Unit& u) const { return (size_t)u.pn * 256 * 1024; }
};
struct EpiInProj {
    static constexpr bool PERM = false;
    unsigned char* ws; bf16* GA; const float* gq_a; const float* gk_a; const float* gq_b; const float* gk_b;
    __device__ __forceinline__ void operator()(const f32x4 (&acc)[2][2][4][2], const pg8::Unit& u, int wr, int wc, int fr_, int fq_) const {
        int fr = fr_, fq = fq_; asm volatile("" : "+v"(fr), "+v"(fq));
        const int pn = u.pn, cg = 4 * pn + wc;
        int kind; const float* gain = nullptr; bool rope = false; float oscale = 1.f; bf16* dbase; int pitch, ccol; bool kvrow = false;
        if (cg < 16)      { kind = 0; gain = gq_a; rope = true; oscale = C2; dbase = (bf16*)(ws + WS_QA); pitch = D; ccol = cg * 64; }
        else if (cg < 32) { kind = 0; gain = gk_a; rope = true; dbase = (bf16*)(ws + WS_KA); pitch = D; ccol = (cg - 16) * 64; kvrow = true; }
        else if (cg < 48) { kind = 1; dbase = (bf16*)(ws + WS_VA); pitch = D; ccol = (cg - 32) * 64; kvrow = true; }
        else if (cg < 56) { kind = 0; gain = gq_b; oscale = C2; dbase = (bf16*)(ws + WS_QB); pitch = 512; ccol = (cg - 48) * 64; }
        else if (cg < 64) { kind = 0; gain = gk_b; dbase = (bf16*)(ws + WS_KB); pitch = 512; ccol = (cg - 56) * 64; kvrow = true; }
        else if (cg < 72) { kind = 1; dbase = (bf16*)(ws + WS_VB); pitch = 512; ccol = (cg - 64) * 64; kvrow = true; }
        else if (cg < 88) { kind = 2; dbase = GA; pitch = D; ccol = (cg - 72) * 64; }
        else              { kind = 2; dbase = GA + (size_t)T * D; pitch = D; ccol = (cg - 88) * 64; }
        const bool latent = u.pm < 128; if (!latent) rope = false;
        const float* RP = (const float*)(ws + WS_ROPE);
        f32x4 gn[2][2];
        if (kind == 0) {
#pragma unroll
            for (int bj = 0; bj < 2; ++bj)
#pragma unroll
                for (int n = 0; n < 2; ++n) gn[bj][n] = *(const f32x4*)(gain + 32 * bj + 16 * n + 4 * fq) * oscale;
        }
#pragma unroll
        for (int ai = 0; ai < 2; ++ai)
#pragma unroll
            for (int m = 0; m < 4; ++m) {
                const int row = u.pm * 256 + ai * 128 + wr * 64 + m * 16 + fr;
                f32x4 v[2][2];
#pragma unroll
                for (int bj = 0; bj < 2; ++bj)
#pragma unroll
                    for (int n = 0; n < 2; ++n) v[bj][n] = acc[ai][bj][m][n];
                if (kind == 0) {
                    float ss = 0.f;
#pragma unroll
                    for (int bj = 0; bj < 2; ++bj)
#pragma unroll
                        for (int n = 0; n < 2; ++n) ss += (v[bj][n].x * v[bj][n].x + v[bj][n].y * v[bj][n].y) + (v[bj][n].z * v[bj][n].z + v[bj][n].w * v[bj][n].w);
                    ss += __shfl_xor(ss, 16); ss += __shfl_xor(ss, 32);
                    const float rstd = 1.0f / sqrtf(ss * (1.f / 64.f) + EPS);
#pragma unroll
                    for (int bj = 0; bj < 2; ++bj)
#pragma unroll
                        for (int n = 0; n < 2; ++n) v[bj][n] = v[bj][n] * rstd * gn[bj][n];
                    if (rope) {
                        const int t = row & (SEQ - 1), pr = t >> 6, pc = t & 63;
                        const f32x4 cr = *(const f32x4*)(RP + pr * 16 + 4 * fq), sr = *(const f32x4*)(RP + 2048 + pr * 16 + 4 * fq);
                        const f32x4 cc = *(const f32x4*)(RP + 4096 + pc * 16 + 4 * fq), sc = *(const f32x4*)(RP + 5120 + pc * 16 + 4 * fq);
                        const f32x4 a0 = v[0][0] * cr - v[0][1] * sr, a1 = v[0][0] * sr + v[0][1] * cr;
                        const f32x4 b0 = v[1][0] * cc - v[1][1] * sc, b1 = v[1][0] * sc + v[1][1] * cc;
                        v[0][0] = a0; v[0][1] = a1; v[1][0] = b0; v[1][1] = b1;
                    }
                } else if (kind == 2) {
#pragma unroll
                    for (int bj = 0; bj < 2; ++bj)
#pragma unroll
                        for (int n = 0; n < 2; ++n) { v[bj][n].x = sigmoid_f(v[bj][n].x); v[bj][n].y = sigmoid_f(v[bj][n].y); v[bj][n].z = sigmoid_f(v[bj][n].z); v[bj][n].w = sigmoid_f(v[bj][n].w); }
                }
                const int drow = kvrow ? kv_row(row) : row;
                bf16* dp = dbase + (size_t)drow * pitch + ccol + 4 * fq;
#pragma unroll
                for (int bj = 0; bj < 2; ++bj)
#pragma unroll
                    for (int n = 0; n < 2; ++n) { u32x2 w; w.x = pg8::cvt_pk_bf16(v[bj][n].x, v[bj][n].y); w.y = pg8::cvt_pk_bf16(v[bj][n].z, v[bj][n].w); *(GAS u32x2*)(dp + 32 * bj + 16 * n) = w; }
            }
    }
};
__device__ __forceinline__ void p1b_inproj_mfma(Frame& F) {
    pg8::Gemm g{(const bf16*)(F.ws + WS_XN), (const bf16*)(F.ws + WS_WIN), D, D, D};
    InProjOrder S; S.d.init(T, NIN, F.G, F.bid, D);
    EpiInProj E{F.ws, (bf16*)F.out, F.inp(9), F.inp(10), F.inp(16), F.inp(17)};
    pg8::gemm_phase<EpiInProj, InProjOrder>(F.lds, g, S, E);
}

__device__ __forceinline__ float lam_value(const Frame& F) {
    float a = 0.f, b = 0.f; const float* q1 = F.inp(11); const float* k1 = F.inp(12); const float* q2 = F.inp(13); const float* k2 = F.inp(14);
    for (int i = 0; i < 64; ++i) { a += q1[i] * k1[i]; b += q2[i] * k2[i]; }
    return expf(a) - expf(b) + 0.2f;
}
__device__ __forceinline__ float qk_bound(const float* gq, const float* gk) {
    float mq = 0.f, mk = 0.f; for (int i = 0; i < 64; ++i) { mq = fmaxf(mq, fabsf(gq[i])); mk = fmaxf(mk, fabsf(gk[i])); }
    return 8.0f * mq * mk * LOG2E * 1.02f + 0.1f;
}

typedef int i32x2 __attribute__((ext_vector_type(2)));
__device__ __forceinline__ void p4a_norm2_route(Frame& F) {
    const float* XMID = (const float*)(F.ws + WS_XMID); const float* nw = F.inp(7); const float* MOD = (const float*)(F.ws + WS_MOD);
    const float* w_rg = F.inp(22); const float* b_rg = F.inp(23); const float* w_re = F.inp(24); const float* b_re = F.inp(25);
    bf16* H2 = (bf16*)(F.ws + WS_H2); i32x2* LIST = (i32x2*)(F.ws + WS_LIST);
    LAS float* WG = (LAS float*)F.lds;
    LAS float* WE = WG + 4096;
    for (int i = F.tid; i < 4096; i += NTHR) WG[i] = w_rg[i];
    for (int i = F.tid; i < 4 * 1024 * 8; i += NTHR) WE[i] = w_re[i];
    __syncthreads();
    const int gw = F.bid * 8 + F.wave, NGW = F.G * 8;
    f32x4 nx[4];
    if (gw < T) { const GAS f32x4* xr = (const GAS f32x4*)(XMID + (size_t)gw * D) + F.lane;
#pragma unroll
        for (int j = 0; j < 4; ++j) nx[j] = xr[64 * j]; }
    for (int m = gw; m < T; m += NGW) {
        const int b = m / SEQ; f32x4 v[4];
#pragma unroll
        for (int j = 0; j < 4; ++j) v[j] = nx[j];
        if (m + NGW < T) { const GAS f32x4* xr = (const GAS f32x4*)(XMID + (size_t)(m + NGW) * D) + F.lane;
#pragma unroll
            for (int j = 0; j < 4; ++j) nx[j] = xr[64 * j]; }
        { float ss = 0.f;
#pragma unroll
          for (int j = 0; j < 4; ++j) ss += (v[j].x * v[j].x + v[j].y * v[j].y) + (v[j].z * v[j].z + v[j].w * v[j].w);
          const float rstd = 1.0f / sqrtf(wave_sum(ss) * (1.f / D) + EPS);
          const float* scale = MOD + b * 6144 + 4096; const float* shift = MOD + b * 6144 + 3072;
#pragma unroll
          for (int j = 0; j < 4; ++j) { const int d0 = 4 * F.lane + 256 * j; const f32x4 w = *(const f32x4*)(nw + d0), sc = *(const f32x4*)(scale + d0), sh = *(const f32x4*)(shift + d0);
              v[j] = (v[j] * rstd * w) * (1.f + sc) + sh; } }
        store_row_bf16(H2 + (size_t)m * D, F.lane, v);
        float lg[4] = {0.f, 0.f, 0.f, 0.f};
#pragma unroll
        for (int j = 0; j < 4; ++j)
#pragma unroll
            for (int e = 0; e < 4; ++e) { const int k = 4 * F.lane + 256 * j + e; const float hv = v[j][e]; const f32x4 w4 = *(const LAS f32x4*)(WG + k * 4);
                lg[0] += hv * w4.x; lg[1] += hv * w4.y; lg[2] += hv * w4.z; lg[3] += hv * w4.w; }
#pragma unroll
        for (int c = 0; c < 4; ++c) lg[c] = wave_sum(lg[c]);
        int g = 0; float gl[4];
#pragma unroll
        for (int c = 0; c < 4; ++c) gl[c] = lg[c] + b_rg[c];
        float gm = gl[0];
#pragma unroll
        for (int c = 1; c < 4; ++c) if (gl[c] > gm) { gm = gl[c]; g = c; }
        float gs = 0.f;
#pragma unroll
        for (int c = 0; c < 4; ++c) gs += expf(gl[c] - gm);
        const float g_w = 1.f / gs;
        g = __builtin_amdgcn_readfirstlane(g);
        float el[8] = {0.f, 0.f, 0.f, 0.f, 0.f, 0.f, 0.f, 0.f};
        { const LAS float* we = WE + g * 8192;
#pragma unroll
          for (int j = 0; j < 4; ++j)
#pragma unroll
              for (int e = 0; e < 4; ++e) { const int k = 4 * F.lane + 256 * j + e; const float hv = v[j][e];
                  const f32x4 wa = *(const LAS f32x4*)(we + k * 8), wb = *(const LAS f32x4*)(we + k * 8 + 4);
                  el[0] += hv * wa.x; el[1] += hv * wa.y; el[2] += hv * wa.z; el[3] += hv * wa.w; el[4] += hv * wb.x; el[5] += hv * wb.y; el[6] += hv * wb.z; el[7] += hv * wb.w; } }
#pragma unroll
        for (int e = 0; e < 8; ++e) el[e] = wave_sum(el[e]) + b_re[g * 8 + e];
        int i0 = 0; float v0 = el[0];
#pragma unroll
        for (int e = 1; e < 8; ++e) if (el[e] > v0) { v0 = el[e]; i0 = e; }
        int i1 = -1; float v1 = -3.0e38f;
#pragma unroll
        for (int e = 0; e < 8; ++e) if (e != i0 && el[e] > v1) { v1 = el[e]; i1 = e; }
        const float e1 = expf(v1 - v0), den = 1.f / (1.f + e1);
        const float w0 = g_w * den, w1 = g_w * e1 * den;
        if (F.lane < 2) {
            const int ge = F.lane * 32 + g * 8 + (F.lane ? i1 : i0);
            const unsigned p = atomicAdd((unsigned*)(F.ctl + CW_CNT + 64 * ge), 1u);
            i32x2 rec; rec.x = m; rec.y = (int)__float_as_uint(F.lane ? w1 : w0);
            LIST[(size_t)ge * T + p] = rec;
        }
    }
}

namespace dattn {
typedef short bf16x8 __attribute__((ext_vector_type(8)));
typedef short s16x4 __attribute__((ext_vector_type(4)));
typedef float f32x16 __attribute__((ext_vector_type(16)));
typedef short v4i16_t __attribute__((ext_vector_type(4)));
constexpr int SLOT = 32768, NT = KVL / 64, LDS_WS = 3 * SLOT, XS = 136;
typedef __attribute__((address_space(3))) const char* lds_cptr;
__device__ __forceinline__ int crow(int r, int hi) { return (r & 3) + 8 * (r >> 2) + 4 * hi; }
__device__ __forceinline__ void glds16(const void* gsrc, unsigned lds_dst) { unsigned keep;
    asm volatile("s_mov_b32 %0, m0\n\ts_mov_b32 m0, %2\n\ts_nop 0\n\tglobal_load_lds_dwordx4 %1, off\n\ts_mov_b32 m0, %0" : "=&s"(keep) : "v"(gsrc), "s"(lds_dst) : "memory"); }
__device__ __forceinline__ unsigned cvtpk(float lo, float hi) { typedef float f2 __attribute__((ext_vector_type(2))); typedef __bf16 b2 __attribute__((ext_vector_type(2))); f2 v = {lo, hi}; b2 b = __builtin_convertvector(v, b2); return __builtin_bit_cast(unsigned, b); }
__device__ __forceinline__ s16x4 vtr(lds_cptr p) { return __builtin_bit_cast(s16x4, __builtin_amdgcn_ds_read_tr16_b64_v4i16((__attribute__((address_space(3))) v4i16_t*)p)); }
}

namespace dattn2 {
using dattn::bf16x8; using dattn::s16x4; using dattn::f32x16; using dattn::lds_cptr; using dattn::crow; using dattn::cvtpk; using dattn::vtr;
constexpr int NT = KVL / 64, KSL = 16384, VBASE = 3 * KSL, LDS_WS = 6 * KSL, XS = 136;
__device__ __forceinline__ void glds16s(unsigned voff, const void* sbase, unsigned lds_dst) { unsigned keep;
    asm volatile("s_mov_b32 %0, m0\n\ts_mov_b32 m0, %3\n\ts_nop 0\n\tglobal_load_lds_dwordx4 %1, %2\n\ts_mov_b32 m0, %0" : "=&s"(keep) : "v"(voff), "s"(sbase), "s"(lds_dst) : "memory"); }
#define D2_WAIT_BAR(N) asm volatile("s_waitcnt vmcnt(" #N ") lgkmcnt(0)\n\ts_barrier" ::: "memory")
#define D2_SBAR() __builtin_amdgcn_sched_barrier(0)
typedef __attribute__((address_space(3))) const bf16x8* lds_b8;

template <bool SHIFT> __device__ __forceinline__ void unit(int b, int h, int qt, const bf16* QA, bf16* OA, const bf16* KA, const bf16* VA, LAS unsigned char* lds, float lam, float shift, const float* subln) {
    const int tid = threadIdx.x, lane = tid & 63, r32 = lane & 31, hi = lane >> 5; const int wid = __builtin_amdgcn_readfirstlane(tid >> 6);
    const int br = wid >> 2, qi = wid & 3;
    const size_t qrow0 = (size_t)b * SEQ + qt * 128 + qi * 32;
    const bf16* Qw = QA + qrow0 * D + h * 128 + br * 64;
    const unsigned lds0 = (unsigned)(uintptr_t)lds;
    unsigned koff[2], voff[2];
#pragma unroll
    for (int j = 0; j < 2; ++j) { const int row = 8 * wid + 4 * j + (lane >> 4), s16 = lane & 15;
        koff[j] = (unsigned)((row * D + h * 128 + ((s16 ^ (row & 15)) * 8)) * 2);
        voff[j] = (unsigned)((row * D + h * 128 + (((s16 >> 2) ^ (row & 3)) * 32) + (s16 & 3) * 8) * 2); }
    const char* Kb = (const char*)(KA + (size_t)b * KVL * D); const char* Vb = (const char*)(VA + (size_t)b * KVL * D);
    const unsigned dst0 = lds0 + (unsigned)wid * 2048u;
#define D2_KDMA(t, slot) do { const char* _p = Kb + (size_t)(t) * (64 * D * 2); const unsigned _d = (unsigned)__builtin_amdgcn_readfirstlane(dst0 + (slot)); glds16s(koff[0], _p, _d); glds16s(koff[1], _p, _d + 1024u); } while (0)
#define D2_VDMA(t, slot) do { const char* _p = Vb + (size_t)(t) * (64 * D * 2); const unsigned _d = (unsigned)__builtin_amdgcn_readfirstlane(dst0 + VBASE + (slot)); glds16s(voff[0], _p, _d); glds16s(voff[1], _p, _d + 1024u); } while (0)
    D2_KDMA(0, 0); D2_VDMA(0, 0); D2_KDMA(1, KSL);
    bf16x8 qr[4];
#pragma unroll
    for (int d0 = 0; d0 < 4; ++d0) qr[d0] = *(const bf16x8*)(Qw + (size_t)r32 * D + d0 * 16 + hi * 8);
    f32x16 o[4];
#pragma unroll
    for (int i = 0; i < 4; ++i) o[i] = f32x16{};
    const f32x16 z16 = f32x16{};
    float l = 0.f;
    const unsigned kad = (unsigned)(r32 * 256 + ((((br * 8 + hi) ^ (r32 & 15))) << 4));
    unsigned vad[4];
    { const int q = (lane & 15) >> 2;
#pragma unroll
      for (int db = 0; db < 4; ++db) vad[db] = (unsigned)(VBASE + (4 * hi + q) * 256 + ((db ^ q) << 6) + ((lane >> 4) & 1) * 32 + (lane & 3) * 8); }
    const lds_cptr l3 = (lds_cptr)lds;
#define D2_KF(slot, f) (*(lds_b8)(l3 + (slot) + (kad ^ (unsigned)(((f) >> 1) << 5)) + ((f) & 1) * 8192))
#define D2_VF(dst, slot, m) do { const lds_cptr _a = l3 + (slot) + vad[(m) & 3] + ((m) >> 2) * 4096; const s16x4 _lo = vtr(_a), _hh = vtr(_a + 2048); \
        dst = (bf16x8){_lo[0], _lo[1], _lo[2], _lo[3], _hh[0], _hh[1], _hh[2], _hh[3]}; } while (0)
    D2_WAIT_BAR(0);
    D2_KDMA(2, 2 * KSL); D2_VDMA(1, KSL);
    f32x16 pA0, pA1, pB0, pB1;
#define D2_EX0(v) (SHIFT ? __builtin_amdgcn_exp2f((v) - shift) : __builtin_amdgcn_exp2f(v))
#pragma unroll
    for (int d0 = 0; d0 < 4; ++d0) {
        pA0 = __builtin_amdgcn_mfma_f32_32x32x16_bf16(D2_KF(0, 2 * d0), qr[d0], d0 == 0 ? z16 : pA0, 0, 0, 0);
        pA1 = __builtin_amdgcn_mfma_f32_32x32x16_bf16(D2_KF(0, 2 * d0 + 1), qr[d0], d0 == 0 ? z16 : pA1, 0, 0, 0); }
#pragma unroll
    for (int r = 0; r < 16; ++r) { pA0[r] = D2_EX0(pA0[r]); pA1[r] = D2_EX0(pA1[r]); }
    int r0 = KSL, r1 = 2 * KSL, r2 = 0;
    u32x4 pw0, pw1, pw2, pw3; bf16x8 kfa, kfb, kfc, vfa, vfb, vfc;
#define D2_PK(P, B) cvtpk(P[B], P[(B) + 1])
#define D2_PA(k) __builtin_bit_cast(bf16x8, pw##k)
#define D2_EX(v) (SHIFT ? __builtin_amdgcn_exp2f((v) - shift) : __builtin_amdgcn_exp2f(v))
#define D2_GA(C, CIN, KC, QD, KN, NF, A0, A1, A2, A3, W0, W1) do { C = __builtin_amdgcn_mfma_f32_32x32x16_bf16(KC, qr[QD], CIN, 0, 0, 0); if ((NF) < 8) KN = D2_KF(r0, NF); \
        sacc += A0; sacc += A1; sacc += A2; sacc += A3; W0; W1; D2_SBAR(); } while (0)
#define D2_GB(M, VC, VN, NM, X0, X1) do { o[(M) & 3] = __builtin_amdgcn_mfma_f32_32x32x16_bf16(((M) >> 2) == 0 ? D2_PA(0) : ((M) >> 2) == 1 ? D2_PA(1) : ((M) >> 2) == 2 ? D2_PA(2) : D2_PA(3), VC, o[(M) & 3], 0, 0, 0); \
        if ((NM) < 16) D2_VF(VN, r2, NM); X0 = D2_EX(X0); X1 = D2_EX(X1); D2_SBAR(); } while (0)
#define D2_STEP(C0, C1, P0, P1, t, GK, GV, WN) do { \
        D2_WAIT_BAR(WN); \
        if (GK) D2_KDMA((t) + 2, r2); if (GV) D2_VDMA((t) + 1, r1); \
        kfa = D2_KF(r0, 0); kfb = D2_KF(r0, 1); kfc = D2_KF(r0, 2); D2_SBAR(); \
        float sacc = P0[0] + P0[1]; \
        D2_GA(C0, z16, kfa, 0, kfa, 3, P0[2], P0[3], P0[4], P0[5],     pw0[0] = D2_PK(P0, 0),  pw0[1] = D2_PK(P0, 2)); \
        D2_GA(C1, z16, kfb, 0, kfb, 4, P0[6], P0[7], P0[8], P0[9],     pw0[2] = D2_PK(P0, 4),  pw0[3] = D2_PK(P0, 6)); \
        D2_GA(C0, C0,  kfc, 1, kfc, 5, P0[10], P0[11], P0[12], P0[13], pw1[0] = D2_PK(P0, 8),  pw1[1] = D2_PK(P0, 10)); \
        D2_GA(C1, C1,  kfa, 1, kfa, 6, P0[14], P0[15], P1[0], P1[1],   pw1[2] = D2_PK(P0, 12), pw1[3] = D2_PK(P0, 14)); \
        D2_GA(C0, C0,  kfb, 2, kfb, 7, P1[2], P1[3], P1[4], P1[5],     pw2[0] = D2_PK(P1, 0),  pw2[1] = D2_PK(P1, 2)); \
        D2_VF(vfa, r2, 0); \
        D2_GA(C1, C1,  kfc, 2, kfc, 8, P1[6], P1[7], P1[8], P1[9],     pw2[2] = D2_PK(P1, 4),  pw2[3] = D2_PK(P1, 6)); \
        D2_VF(vfb, r2, 1); \
        D2_GA(C0, C0,  kfa, 3, kfa, 8, P1[10], P1[11], P1[12], P1[13], pw3[0] = D2_PK(P1, 8),  pw3[1] = D2_PK(P1, 10)); \
        D2_VF(vfc, r2, 2); \
        D2_GA(C1, C1,  kfb, 3, kfb, 8, P1[14], P1[15], 0.f, 0.f,       pw3[2] = D2_PK(P1, 12), pw3[3] = D2_PK(P1, 14)); \
        l += sacc; \
        D2_GB(0,  vfa, vfa, 3,  C0[0],  C0[1]);  D2_GB(1,  vfb, vfb, 4,  C0[2],  C0[3]);  D2_GB(2,  vfc, vfc, 5,  C0[4],  C0[5]);  D2_GB(3,  vfa, vfa, 6,  C0[6],  C0[7]); \
        D2_GB(4,  vfb, vfb, 7,  C0[8],  C0[9]);  D2_GB(5,  vfc, vfc, 8,  C0[10], C0[11]); D2_GB(6,  vfa, vfa, 9,  C0[12], C0[13]); D2_GB(7,  vfb, vfb, 10, C0[14], C0[15]); \
        D2_GB(8,  vfc, vfc, 11, C1[0],  C1[1]);  D2_GB(9,  vfa, vfa, 12, C1[2],  C1[3]);  D2_GB(10, vfb, vfb, 13, C1[4],  C1[5]);  D2_GB(11, vfc, vfc, 14, C1[6],  C1[7]); \
        D2_GB(12, vfa, vfa, 15, C1[8],  C1[9]);  D2_GB(13, vfb, vfb, 16, C1[10], C1[11]); D2_GB(14, vfc, vfc, 16, C1[12], C1[13]); D2_GB(15, vfa, vfa, 16, C1[14], C1[15]); \
        { const int _t = r0; r0 = r1; r1 = r2; r2 = _t; } \
    } while (0)
    int t = 1;
    for (; t + 1 <= NT - 3; t += 2) {
        D2_STEP(pB0, pB1, pA0, pA1, t, true, true, 4);
        D2_STEP(pA0, pA1, pB0, pB1, t + 1, true, true, 4);
    }
    D2_STEP(pB0, pB1, pA0, pA1, NT - 3, true, true, 4);
    D2_STEP(pA0, pA1, pB0, pB1, NT - 2, false, true, 4);
    D2_STEP(pB0, pB1, pA0, pA1, NT - 1, false, false, 2);
    D2_WAIT_BAR(0);
    { float sacc = 0.f;
#pragma unroll
      for (int r = 0; r < 16; ++r) sacc += pB0[r] + pB1[r];
      l += sacc;
      pw0 = (u32x4){D2_PK(pB0, 0), D2_PK(pB0, 2), D2_PK(pB0, 4), D2_PK(pB0, 6)}; pw1 = (u32x4){D2_PK(pB0, 8), D2_PK(pB0, 10), D2_PK(pB0, 12), D2_PK(pB0, 14)};
      pw2 = (u32x4){D2_PK(pB1, 0), D2_PK(pB1, 2), D2_PK(pB1, 4), D2_PK(pB1, 6)}; pw3 = (u32x4){D2_PK(pB1, 8), D2_PK(pB1, 10), D2_PK(pB1, 12), D2_PK(pB1, 14)};
#pragma unroll
      for (int m = 0; m < 16; ++m) { bf16x8 vf; D2_VF(vf, r2, m);
          o[m & 3] = __builtin_amdgcn_mfma_f32_32x32x16_bf16((m >> 2) == 0 ? D2_PA(0) : (m >> 2) == 1 ? D2_PA(1) : (m >> 2) == 2 ? D2_PA(2) : D2_PA(3), vf, o[m & 3], 0, 0, 0); } }
    { auto rr = __builtin_amdgcn_permlane32_swap(__float_as_uint(l), __float_as_uint(l), false, false); l = __uint_as_float(rr[0]) + __uint_as_float(rr[1]); }
    LAS float* wsf = (LAS float*)(lds + LDS_WS) + wid * 64;
    if (hi == 0) wsf[r32] = 1.0f / l;
    asm volatile("s_waitcnt lgkmcnt(0)" ::: "memory");
    float rli[16];
    { const LAS float* wb = wsf + 4 * hi;
#pragma unroll
      for (int r = 0; r < 16; ++r) rli[r] = wb[(r & 3) + 8 * (r >> 2)]; }
    D2_WAIT_BAR(0);
    LAS float* X = (LAS float*)lds + (size_t)(qi * 32 + 4 * hi) * XS + r32;
    if (br == 1) {
#pragma unroll
        for (int db = 0; db < 4; ++db)
#pragma unroll
            for (int r = 0; r < 16; ++r) X[((r & 3) + 8 * (r >> 2)) * XS + db * 32] = o[db][r] * rli[r];
    }
    D2_WAIT_BAR(0);
    if (br == 0) {
#pragma unroll
        for (int db = 0; db < 4; ++db)
#pragma unroll
            for (int r = 0; r < 16; ++r) { const int xi = ((r & 3) + 8 * (r >> 2)) * XS + db * 32; X[xi] = o[db][r] * rli[r] - lam * X[xi]; }
        asm volatile("s_waitcnt lgkmcnt(0)" ::: "memory");
        int lane_e = lane; asm volatile("" : "+v"(lane_e) : "v"(rli[0]));
        const int row = lane_e >> 1, half = lane_e & 1;
        const LAS float* Xr = (const LAS float*)lds + (size_t)(qi * 32 + row) * XS + half * 8;
        f32x4 v[8][2]; float ss = 0.f;
#pragma unroll
        for (int i = 0; i < 8; ++i)
#pragma unroll
            for (int c = 0; c < 2; ++c) { v[i][c] = *(const LAS f32x4*)(Xr + i * 16 + c * 4); ss += (v[i][c].x * v[i][c].x + v[i][c].y * v[i][c].y) + (v[i][c].z * v[i][c].z + v[i][c].w * v[i][c].w); }
        ss += __shfl_xor(ss, 1);
        const float rstd = 0.8f / sqrtf(ss * (1.f / 128.f) + EPS);
        bf16* dst = OA + (qrow0 + row) * D + h * 128 + half * 8;
        const float* sg = subln + half * 8;
#pragma unroll
        for (int i = 0; i < 8; ++i) { const f32x4 g0 = *(const f32x4*)(sg + i * 16), g1 = *(const f32x4*)(sg + i * 16 + 4);
            u32x4 w; w.x = cvtpk(v[i][0].x * rstd * g0.x, v[i][0].y * rstd * g0.y); w.y = cvtpk(v[i][0].z * rstd * g0.z, v[i][0].w * rstd * g0.w);
            w.z = cvtpk(v[i][1].x * rstd * g1.x, v[i][1].y * rstd * g1.y); w.w = cvtpk(v[i][1].z * rstd * g1.z, v[i][1].w * rstd * g1.w);
            *(GAS u32x4*)(dst + i * 16) = w; }
    }
    D2_WAIT_BAR(0);
#undef D2_KDMA
#undef D2_VDMA
#undef D2_KF
#undef D2_VF
#undef D2_PK
#undef D2_PA
#undef D2_EX
#undef D2_GA
#undef D2_GB
#undef D2_STEP
#undef D2_EX0
}
}

__device__ __forceinline__ void p2a_diffattn_mfma(Frame& F, bf16* OA) {
    bf16* QA = (bf16*)(F.ws + WS_QA); const bf16* KA = (const bf16*)(F.ws + WS_KA); const bf16* VA = (const bf16*)(F.ws + WS_VA);
    const float lam = lam_value(F); const float mb = qk_bound(F.inp(9), F.inp(10));
    constexpr int NU = NB * NH * (SEQ / 128);
    for (int i = 0; ; ++i) {
        int bh, qt;
        if (F.G == 256) { if (i >= 8) break; const int x = F.bid & 7, j = F.bid >> 3; bh = x + 8 * (i >> 1); qt = (i & 1) * 32 + j; }
        else { const int u = F.bid + i * F.G; if (u >= NU) break; bh = u / (SEQ / 128); qt = u % (SEQ / 128); }
        if (mb < 100.f) dattn2::unit<false>(bh / NH, bh % NH, qt, QA, OA, KA, VA, F.lds, lam, 0.f, F.inp(15));
        else dattn2::unit<true>(bh / NH, bh % NH, qt, QA, OA, KA, VA, F.lds, lam, mb, F.inp(15));
    }
}


namespace nattn {
using dattn::bf16x8; using dattn::s16x4; using dattn::f32x16; using dattn::lds_cptr; using dattn::crow; using dattn::glds16; using dattn::cvtpk; using dattn::vtr;
__device__ __forceinline__ void unit(int b, int r, const bf16* QB, bf16* OB, const bf16* KB, const bf16* VB, LAS unsigned char* lds, float mb) {
    const int tid = threadIdx.x, lane = tid & 63, r32 = lane & 31, hi = lane >> 5; const int h = __builtin_amdgcn_readfirstlane(tid >> 6);
    const size_t qrow0 = (size_t)b * SEQ + r * GRIDW;
    const unsigned lds0 = (unsigned)(uintptr_t)lds;
    LAS unsigned char* vbuf = lds + h * 16384;
    const LAS float* BL = (const LAS float*)(lds + 131072 + h * 2048);
    LAS float* wsf = (LAS float*)(lds + 147456) + h * 128;
    int r0 = r - 4; r0 = r0 < 0 ? 0 : (r0 > NROWS - 8 ? NROWS - 8 : r0);
    bf16x8 qr[2][4];
#pragma unroll
    for (int qb = 0; qb < 2; ++qb)
#pragma unroll
        for (int d0 = 0; d0 < 4; ++d0) qr[qb][d0] = *(const bf16x8*)(QB + (qrow0 + qb * 32 + r32) * 512 + h * 64 + d0 * 16 + hi * 8);
    f32x16 o[2][2];
#pragma unroll
    for (int i = 0; i < 2; ++i)
#pragma unroll
        for (int j = 0; j < 2; ++j) o[i][j] = f32x16{};
    const f32x16 zero16 = f32x16{};
    float l[2] = {0.f, 0.f};
    const bf16* vsrc0 = VB + (size_t)(lane >> 2) * 512 + h * 64 + (lane & 3) * 8;
    const lds_cptr vp0 = (lds_cptr)vbuf + ((lane >> 4) & 1) * 32 + (lane & 3) * 8 + (4 * hi + ((lane & 15) >> 2)) * 64;
#define NA_KROW(t) ((size_t)b * KVL + ((t) < 8 ? CTX + (r0 + (t)) * GRIDW : ((t) - 8) * 64))
#define NA_DMA(t) do { const bf16* _s = vsrc0 + NA_KROW(t) * 512; const unsigned _d = lds0 + h * 16384 + ((t) & 1) * 8192; \
        _Pragma("unroll") for (int _db = 0; _db < 2; ++_db) _Pragma("unroll") for (int _rc = 0; _rc < 4; ++_rc) \
            glds16(_s + (size_t)_rc * 16 * 512 + _db * 32, (unsigned)__builtin_amdgcn_readfirstlane(_d + _db * 4096 + _rc * 1024)); } while (0)
    NA_DMA(0);
#pragma unroll 1
    for (int t = 0; t < 12; ++t) {
        const bf16* kbase = KB + (NA_KROW(t) + r32) * 512 + h * 64 + hi * 8;
        bf16x8 kf[2][4];
#pragma unroll
        for (int kh = 0; kh < 2; ++kh)
#pragma unroll
            for (int d0 = 0; d0 < 4; ++d0) kf[kh][d0] = *(const bf16x8*)(kbase + (size_t)kh * 32 * 512 + d0 * 16);
        if (t + 1 < 12) { NA_DMA(t + 1); asm volatile("s_waitcnt vmcnt(8)" ::: "memory"); } else asm volatile("s_waitcnt vmcnt(0)" ::: "memory");
        const lds_cptr vp = vp0 + (t & 1) * 8192;
#pragma unroll
        for (int qb = 0; qb < 2; ++qb) {
            f32x16 p0, p1;
#pragma unroll
            for (int d0 = 0; d0 < 4; ++d0) {
                p0 = __builtin_amdgcn_mfma_f32_32x32x16_bf16(kf[0][d0], qr[qb][d0], d0 == 0 ? zero16 : p0, 0, 0, 0);
                p1 = __builtin_amdgcn_mfma_f32_32x32x16_bf16(kf[1][d0], qr[qb][d0], d0 == 0 ? zero16 : p1, 0, 0, 0);
            }
            if (t < 8) {
                const int w = qb * 32 + r32; int c0 = w - 8; c0 = c0 < 0 ? 0 : (c0 > GRIDW - 16 ? GRIDW - 16 : c0);
                const LAS float* brow = BL + (r0 + t - r + 7) * 31 + (15 - w) + 4 * hi;
#pragma unroll
                for (int i = 0; i < 16; ++i) { const int kcc = (i & 3) + 8 * (i >> 2); const int kc = kcc + 4 * hi, kc1 = kc + 32;
                    const bool v0 = (kc >= c0) && (kc < c0 + 16), v1 = (kc1 >= c0) && (kc1 < c0 + 16);
                    const float b0 = brow[kcc], b1 = brow[kcc + 32];
                    p0[i] = v0 ? p0[i] + b0 : -1.0e30f; p1[i] = v1 ? p1[i] + b1 : -1.0e30f; }
            }
            float sacc = 0.f;
#pragma unroll
            for (int i = 0; i < 16; ++i) { p0[i] = __builtin_amdgcn_exp2f(p0[i] - mb); p1[i] = __builtin_amdgcn_exp2f(p1[i] - mb); sacc += p0[i] + p1[i]; }
            l[qb] += sacc;
            u32x4 pw[4];
#pragma unroll
            for (int s2 = 0; s2 < 2; ++s2) {
                pw[s2]     = (u32x4){cvtpk(p0[8 * s2], p0[8 * s2 + 1]), cvtpk(p0[8 * s2 + 2], p0[8 * s2 + 3]), cvtpk(p0[8 * s2 + 4], p0[8 * s2 + 5]), cvtpk(p0[8 * s2 + 6], p0[8 * s2 + 7])};
                pw[2 + s2] = (u32x4){cvtpk(p1[8 * s2], p1[8 * s2 + 1]), cvtpk(p1[8 * s2 + 2], p1[8 * s2 + 3]), cvtpk(p1[8 * s2 + 4], p1[8 * s2 + 5]), cvtpk(p1[8 * s2 + 6], p1[8 * s2 + 7])};
            }
#pragma unroll
            for (int ks = 0; ks < 4; ++ks)
#pragma unroll
                for (int db = 0; db < 2; ++db) {
                    const s16x4 lo = vtr(vp + db * 4096 + ks * 1024), hh = vtr(vp + db * 4096 + ks * 1024 + 512);
                    const bf16x8 vf = (bf16x8){lo[0], lo[1], lo[2], lo[3], hh[0], hh[1], hh[2], hh[3]};
                    o[qb][db] = __builtin_amdgcn_mfma_f32_32x32x16_bf16(__builtin_bit_cast(bf16x8, pw[ks]), vf, o[qb][db], 0, 0, 0);
                }
            asm volatile("" ::: "memory");
        }
    }
#pragma unroll
    for (int qb = 0; qb < 2; ++qb) { auto rr = __builtin_amdgcn_permlane32_swap(__float_as_uint(l[qb]), __float_as_uint(l[qb]), false, false); l[qb] = __uint_as_float(rr[0]) + __uint_as_float(rr[1]);
        if (hi == 0) wsf[qb * 32 + r32] = 1.0f / l[qb]; }
    asm volatile("s_waitcnt lgkmcnt(0)" ::: "memory");
    LAS bf16* stg = (LAS bf16*)vbuf;
    { LAS bf16* sb = stg + (4 * hi) * 64 + r32; const LAS float* wb = wsf + 4 * hi;
#pragma unroll
      for (int qb = 0; qb < 2; ++qb)
#pragma unroll
          for (int i = 0; i < 16; ++i) { const int qc = qb * 32 + (i & 3) + 8 * (i >> 2); const float rl = wb[qc];
#pragma unroll
              for (int db = 0; db < 2; ++db) sb[qc * 64 + db * 32] = (bf16)f2bf(o[qb][db][i] * rl); } }
    asm volatile("s_waitcnt lgkmcnt(0)" ::: "memory");
#pragma unroll
    for (int i = 0; i < 8; ++i) { const int row = i * 8 + (lane >> 3), ch = lane & 7; const u32x4 v = *(const LAS u32x4*)(stg + row * 64 + ch * 8);
        *(GAS u32x4*)(OB + (qrow0 + row) * 512 + h * 64 + ch * 8) = v; }
    asm volatile("s_waitcnt vmcnt(0) lgkmcnt(0)" ::: "memory");
#undef NA_DMA
#undef NA_KROW
}
}
__device__ __forceinline__ void p2b_natten_mfma(Frame& F, bf16* OB) {
    bf16* QB = (bf16*)(F.ws + WS_QB); const bf16* KB = (const bf16*)(F.ws + WS_KB); const bf16* VB = (const bf16*)(F.ws + WS_VB);
    const float* bias = F.inp(18);
    float bm = 0.f; for (int i = F.lane; i < NH * 15 * 31; i += 64) bm = fmaxf(bm, fabsf(bias[i]));
#pragma unroll
    for (int o = 1; o < 64; o <<= 1) bm = fmaxf(bm, __shfl_xor(bm, o));
    const float mb = qk_bound(F.inp(16), F.inp(17)) + bm * LOG2E;
    LAS float* BL = (LAS float*)(F.lds + 131072);
    for (int i = F.tid; i < NH * 512; i += NTHR) { const int h = i >> 9, e = i & 511; BL[i] = e < 465 ? bias[h * 465 + e] * LOG2E : 0.f; }
    __syncthreads();
#if defined(PROBE_NA2)
    for (int u = F.bid; u < 2 * NB * NROWS; u += F.G) { const int uu = u % (NB * NROWS); nattn::unit(uu / NROWS, uu % NROWS, QB, u < NB * NROWS ? (bf16*)(F.ws + WS_XN) : OB, KB, VB, F.lds, mb); }
#else
    for (int u = F.bid; u < NB * NROWS; u += F.G) nattn::unit(u / NROWS, u % NROWS, QB, OB, KB, VB, F.lds, mb);
#endif
    __syncthreads();
}

struct EpiMergeA {
    static constexpr bool PERM = true; const bf16* GA; bf16* Y;
    __device__ __forceinline__ void operator()(const f32x4 (&acc)[2][2][4][2], const pg8::Unit& u, int wr, int wc, int fr_, int fq_) const {
        int fr = fr_, fq = fq_; asm volatile("" : "+v"(fr), "+v"(fq));
#pragma unroll
        for (int ai = 0; ai < 2; ++ai)
#pragma unroll
            for (int m = 0; m < 4; ++m) { const size_t ro = (size_t)(u.pm * 256 + ai * 128 + wr * 64 + m * 16 + fr) * D + u.pn * 256 + wc * 32 + 8 * fq;
#pragma unroll
                for (int bj = 0; bj < 2; ++bj) { const u32x4 gv = *(const GAS u32x4*)(GA + ro + bj * 128); const f32x4 a = acc[ai][bj][m][0], b = acc[ai][bj][m][1];
                    u32x4 w; w.x = pg8::cvt_pk_bf16(bf2f(gv.x & 0xffffu) * a.x, bf2f(gv.x >> 16) * a.y); w.y = pg8::cvt_pk_bf16(bf2f(gv.y & 0xffffu) * a.z, bf2f(gv.y >> 16) * a.w);
                    w.z = pg8::cvt_pk_bf16(bf2f(gv.z & 0xffffu) * b.x, bf2f(gv.z >> 16) * b.y); w.w = pg8::cvt_pk_bf16(bf2f(gv.w & 0xffffu) * b.z, bf2f(gv.w >> 16) * b.w);
                    *(GAS u32x4*)(Y + ro + bj * 128) = w; } }
    }
};
struct EpiMergeB {
    static constexpr bool PERM = true; const bf16* GB; bf16* Y;
    __device__ __forceinline__ void operator()(const f32x4 (&acc)[2][2][4][2], const pg8::Unit& u, int wr, int wc, int fr_, int fq_) const {
        int fr = fr_, fq = fq_; asm volatile("" : "+v"(fr), "+v"(fq));
#pragma unroll
        for (int ai = 0; ai < 2; ++ai)
#pragma unroll
            for (int m = 0; m < 4; ++m) { const size_t ro = (size_t)(u.pm * 256 + ai * 128 + wr * 64 + m * 16 + fr) * D + u.pn * 256 + wc * 32 + 8 * fq;
#pragma unroll
                for (int bj = 0; bj < 2; ++bj) { const u32x4 gv = *(const GAS u32x4*)(GB + ro + bj * 128); const u32x4 yv = *(const GAS u32x4*)(Y + ro + bj * 128); const f32x4 a = acc[ai][bj][m][0], b = acc[ai][bj][m][1];
                    u32x4 w; w.x = pg8::cvt_pk_bf16(bf2f(yv.x & 0xffffu) + bf2f(gv.x & 0xffffu) * a.x, bf2f(yv.x >> 16) + bf2f(gv.x >> 16) * a.y);
                    w.y = pg8::cvt_pk_bf16(bf2f(yv.y & 0xffffu) + bf2f(gv.y & 0xffffu) * a.z, bf2f(yv.y >> 16) + bf2f(gv.y >> 16) * a.w);
                    w.z = pg8::cvt_pk_bf16(bf2f(yv.z & 0xffffu) + bf2f(gv.z & 0xffffu) * b.x, bf2f(yv.z >> 16) + bf2f(gv.z >> 16) * b.y);
                    w.w = pg8::cvt_pk_bf16(bf2f(yv.w & 0xffffu) + bf2f(gv.w & 0xffffu) * b.z, bf2f(yv.w >> 16) + bf2f(gv.w >> 16) * b.w);
                    *(GAS u32x4*)(Y + ro + bj * 128) = w; } }
    }
};
struct EpiOut {
    static constexpr bool PERM = false; const float* x; const float* MOD; float* XMID;
    __device__ __forceinline__ void operator()(const f32x4 (&acc)[2][2][4][2], const pg8::Unit& u, int wr, int wc, int fr_, int fq_) const {
        int fr = fr_, fq = fq_; asm volatile("" : "+v"(fr), "+v"(fq));
        const int b = (u.pm * 256) / SEQ; const int col0 = u.pn * 256 + wc * 32 + 4 * fq;
        f32x4 g[2][2];
#pragma unroll
        for (int bj = 0; bj < 2; ++bj)
#pragma unroll
            for (int n = 0; n < 2; ++n) g[bj][n] = *(const f32x4*)(MOD + b * 6144 + 2048 + col0 + bj * 128 + n * 16);
#pragma unroll
        for (int ai = 0; ai < 2; ++ai)
#pragma unroll
            for (int m = 0; m < 4; ++m) { const size_t ro = (size_t)(u.pm * 256 + ai * 128 + wr * 64 + m * 16 + fr) * D + col0;
#pragma unroll
                for (int bj = 0; bj < 2; ++bj)
#pragma unroll
                    for (int n = 0; n < 2; ++n) { const f32x4 xv = *(const f32x4*)(x + ro + bj * 128 + n * 16); *(f32x4*)(XMID + ro + bj * 128 + n * 16) = xv + g[bj][n] * acc[ai][bj][m][n]; } }
    }
};
__device__ __forceinline__ void p3_merge_out_mfma(Frame& F, int part) {
    bf16* Y = (bf16*)(F.ws + WS_Y); const bf16* GA = (const bf16*)F.out;
    if (part == 0) {
        { pg8::Gemm g{(const bf16*)(F.ws + WS_QA), (const bf16*)(F.ws + WS_WA), D, D, D}; pg8::DenseOrder S; S.init(T, D, F.G, F.bid, D); EpiMergeA E{GA, Y}; pg8::gemm_phase<EpiMergeA, pg8::DenseOrder>(F.lds, g, S, E); }
        asm volatile("s_waitcnt vmcnt(0)" ::: "memory"); __syncthreads();
        { pg8::Gemm g{(const bf16*)(F.ws + WS_QB), (const bf16*)(F.ws + WS_WB), 512, 512, 512}; pg8::DenseOrder S; S.init(T, D, F.G, F.bid, 512); EpiMergeB E{GA + (size_t)T * D, Y}; pg8::gemm_phase<EpiMergeB, pg8::DenseOrder>(F.lds, g, S, E); }
    } else {
        pg8::Gemm g{Y, (const bf16*)(F.ws + WS_WO), D, D, D}; pg8::DenseOrder S; S.init(T, D, F.G, F.bid, D);
        EpiOut E{F.inp(0), (const float*)(F.ws + WS_MOD), (float*)(F.ws + WS_XMID)}; pg8::gemm_phase<EpiOut, pg8::DenseOrder>(F.lds, g, S, E);
    }
}

constexpr int MOE_TAB_OFF = 132096;
struct MoeTab { LAS int* cnt; LAS int* tpre; LAS int* sbase; };
__device__ __forceinline__ MoeTab moe_tables(Frame& F) {
    MoeTab G; G.cnt = (LAS int*)(F.lds + MOE_TAB_OFF); G.tpre = G.cnt + 64; G.sbase = G.tpre + 65;
    __syncthreads();
    if (F.tid < 64) G.cnt[F.tid] = (int)__hip_atomic_load(F.ctl + CW_CNT + 64 * F.tid, __ATOMIC_RELAXED, __HIP_MEMORY_SCOPE_AGENT);
    __syncthreads();
    if (F.tid == 0) { int tp = 0; for (int g = 0; g < 64; ++g) { G.tpre[g] = tp; G.sbase[g] = tp * 256; tp += (G.cnt[g] + 255) / 256; } G.tpre[64] = tp; }
    __syncthreads();
    return G;
}
struct MoeOrder {
    MoeTab G; int t_lo, t_hi, Gn, c; const i32x2* LIST; int ldb; bool gather;
    __device__ __forceinline__ bool next(int i, pg8::Unit& u) const {
        const long L = (long)i * Gn + c; const int tile = t_lo + (int)(L >> 2); if (tile >= t_hi) return false;
        int g = 0;
        for (int k = 0; k < 64; ++k) g += (G.tpre[k + 1] <= tile) ? 1 : 0;
        u.pm = tile - G.tpre[g]; u.pn = (int)(L & 3); u.a0 = g; u.a1 = tile * 256; return true;
    }
    __device__ __forceinline__ int arow(const pg8::Unit& u, int r) const {
        if (!gather) return u.a1 + r;
        const int idx = u.pm * 256 + r; const int cnt = G.cnt[u.a0]; return LIST[(size_t)u.a0 * T + (idx < cnt ? idx : 0)].x;
    }
    __device__ __forceinline__ size_t boff(const pg8::Unit& u) const { return ((size_t)(u.a0 & 31) * 1024 + (size_t)u.pn * 256) * ldb; }
};
struct EpiGateUp {
    static constexpr bool PERM = true; bf16* HID;
    __device__ __forceinline__ void operator()(const f32x4 (&acc)[2][2][4][2], const pg8::Unit& u, int wr, int wc, int fr_, int fq_) const {
        int fr = fr_, fq = fq_; asm volatile("" : "+v"(fr), "+v"(fq));
#pragma unroll
        for (int ai = 0; ai < 2; ++ai)
#pragma unroll
            for (int m = 0; m < 4; ++m) { const size_t ro = (size_t)(u.a1 + ai * 128 + wr * 64 + m * 16 + fr) * EH + u.pn * 128 + wc * 32 + 8 * fq;
                const f32x4 ga = acc[ai][0][m][0], gb = acc[ai][0][m][1], ua = acc[ai][1][m][0], ub = acc[ai][1][m][1];
                u32x4 w; w.x = pg8::cvt_pk_bf16(silu_f(ga.x) * ua.x, silu_f(ga.y) * ua.y); w.y = pg8::cvt_pk_bf16(silu_f(ga.z) * ua.z, silu_f(ga.w) * ua.w);
                w.z = pg8::cvt_pk_bf16(silu_f(gb.x) * ub.x, silu_f(gb.y) * ub.y); w.w = pg8::cvt_pk_bf16(silu_f(gb.z) * ub.z, silu_f(gb.w) * ub.w);
                *(GAS u32x4*)(HID + ro) = w; }
    }
};
struct EpiDown {
    static constexpr bool PERM = false; MoeTab G; const i32x2* LIST; const LAS float* GA2; const float* base; float* out;
    __device__ __forceinline__ void operator()(const f32x4 (&acc)[2][2][4][2], const pg8::Unit& u, int wr, int wc, int fr_, int fq_) const {
        int fr = fr_, fq = fq_; asm volatile("" : "+v"(fr), "+v"(fq));
        const int cnt = G.cnt[u.a0]; const int col0 = u.pn * 256 + wc * 32 + 4 * fq;
        const i32x2* lst = LIST + (size_t)u.a0 * T;
        const int idx0 = u.pm * 256 + wr * 64 + fr;
        i32x2 tw[2][4];
#pragma unroll
        for (int ai = 0; ai < 2; ++ai)
#pragma unroll
            for (int m = 0; m < 4; ++m) { const int idx = idx0 + ai * 128 + m * 16; tw[ai][m] = lst[idx < cnt ? idx : 0]; }
#pragma unroll
        for (int ai = 0; ai < 2; ++ai) {
            f32x4 bv[4][2][2];
#pragma unroll
            for (int m = 0; m < 4; ++m) { const size_t ro = (size_t)tw[ai][m].x * D + col0;
#pragma unroll
                for (int bj = 0; bj < 2; ++bj)
#pragma unroll
                    for (int n = 0; n < 2; ++n) bv[m][bj][n] = *(const f32x4*)(base + ro + bj * 128 + n * 16); }
#pragma unroll
            for (int m = 0; m < 4; ++m) { const int idx = idx0 + ai * 128 + m * 16; const int tok = tw[ai][m].x; const float w = __uint_as_float((unsigned)tw[ai][m].y);
                const LAS float* g2 = GA2 + (tok / SEQ) * 1024 + col0; const size_t ro = (size_t)tok * D + col0;
                if (idx < cnt) {
#pragma unroll
                    for (int bj = 0; bj < 2; ++bj)
#pragma unroll
                        for (int n = 0; n < 2; ++n) { const f32x4 gv = *(const LAS f32x4*)(g2 + bj * 128 + n * 16); *(f32x4*)(out + ro + bj * 128 + n * 16) = bv[m][bj][n] + gv * w * acc[ai][bj][m][n]; } } }
        }
    }
};
__device__ __forceinline__ void p4_moe_mfma(Frame& F, int part) {
    const MoeTab G = moe_tables(F); const i32x2* LIST = (const i32x2*)(F.ws + WS_LIST);
    if (part == 0) {
        pg8::Gemm g{(const bf16*)(F.ws + WS_H2), (const bf16*)(F.ws + WS_WGU), D, D, D};
        MoeOrder S{G, 0, G.tpre[64], F.G, F.bid, LIST, D, true}; EpiGateUp E{(bf16*)(F.ws + WS_HID)};
        pg8::gemm_phase<EpiGateUp, MoeOrder>(F.lds, g, S, E);
    } else {
        const int kk = part - 1;
        pg8::Gemm g{(const bf16*)(F.ws + WS_HID), (const bf16*)(F.ws + WS_WD), EH, EH, EH};
        MoeOrder S{G, G.tpre[32 * kk], G.tpre[32 * kk + 32], F.G, F.bid, LIST, EH, false};
        LAS float* GA2 = (LAS float*)(F.lds + MOE_TAB_OFF + 1024);
        { const float* MOD = (const float*)(F.ws + WS_MOD); for (int i = F.tid; i < 4096; i += NTHR) GA2[i] = MOD[(i >> 10) * 6144 + 5120 + (i & 1023)]; }
        __syncthreads();
        EpiDown E{G, LIST, GA2, kk == 0 ? (const float*)(F.ws + WS_XMID) : (const float*)F.out, F.out};
        pg8::gemm_phase<EpiDown, MoeOrder>(F.lds, g, S, E);
    }
}

constexpr int NPHASE = 10;
__global__ void __launch_bounds__(NTHR, 2) mk_fwd(Args args) {
    extern __shared__ __attribute__((aligned(16))) unsigned char lds[];
    Frame F;
    F.lds = (LAS unsigned char*)lds; F.ws = args.ws; F.ctl = (gu32*)(args.ws + WS_CTL);
    F.tid = threadIdx.x; F.lane = F.tid & 63; F.wave = __builtin_amdgcn_readfirstlane(F.tid >> 6); F.G = gridDim.x; F.bid = blockIdx.x;
    F.ka = (const __attribute__((address_space(4))) unsigned char*)__builtin_amdgcn_kernarg_segment_ptr();
    F.out = args.out;
    volatile LAS unsigned* MISC = (volatile LAS unsigned*)(F.lds + LDS_BYTES - 64);
    if (F.tid < 16) MISC[F.tid] = 0u;
    __syncthreads();
    XcdBarrier bar; bar.bar = (unsigned*)(F.ctl + CW_BAR); bar.x = 0; bar.st = nullptr;
    if (MK_N_LAUNCHES == 1) bar = xcd_barrier_post((unsigned*)(F.ctl + CW_BAR), MISC);
    const int lo = args.ph_lo, hi = args.ph_hi;
#ifndef PH_MASK
#define PH_MASK 0x3ff
#endif
#define IN(k) (((PH_MASK >> (k)) & 1) && lo <= (k) && (k) < hi)
#define SEAM(k) do { if (IN(k) && IN((k) + 1)) xcd_barrier(bar); { int t_ = threadIdx.x; asm volatile("" : "+v"(t_)); F.tid = t_; F.lane = t_ & 63; } } while (0)
    if (IN(0)) { p0_adaln_rope(F); p0_weights(F); }
    SEAM(0);
    if (IN(1)) p1a_norm1(F);
    SEAM(1);
    if (IN(2)) p1b_inproj_mfma(F);
    SEAM(2);
    if (IN(3)) { p2a_diffattn_mfma(F, (bf16*)(F.ws + WS_QA)); p2b_natten_mfma(F, (bf16*)(F.ws + WS_QB)); }
    SEAM(3);
    if (IN(4)) p3_merge_out_mfma(F, 0);
    SEAM(4);
    if (IN(5)) p3_merge_out_mfma(F, 1);
    SEAM(5);
    if (IN(6)) p4a_norm2_route(F);
    SEAM(6);
    if (IN(7)) p4_moe_mfma(F, 0);
    SEAM(7);
    if (IN(8)) p4_moe_mfma(F, 1);
    SEAM(8);
    if (IN(9)) p4_moe_mfma(F, 2);
#undef IN
#undef SEAM
}

extern "C" void kernel_launch(void* const* d_in, const int* in_sizes, int n_in, void* d_out, int out_size, void* d_ws, size_t ws_size, hipStream_t stream) {
    static int grid = 0;
    if (grid == 0) {
        if (n_in != 29 || out_size != T * D || ws_size < WS_END) { fprintf(stderr, "kernel_launch: unexpected shapes: n_in %d out %d ws %zu\n", n_in, out_size, ws_size); grid = -1; return; }
        int dev = 0, cus = 0, per_cu = 0;
        if (hipGetDevice(&dev) != hipSuccess || hipDeviceGetAttribute(&cus, hipDeviceAttributeMultiprocessorCount, dev) != hipSuccess) { grid = -1; return; }
        if (hipFuncSetAttribute((const void*)mk_fwd, hipFuncAttributeMaxDynamicSharedMemorySize, LDS_BYTES) != hipSuccess) { fprintf(stderr, "kernel_launch: hipFuncSetAttribute failed\n"); grid = -1; return; }
        if (hipOccupancyMaxActiveBlocksPerMultiprocessor(&per_cu, (const void*)mk_fwd, NTHR, LDS_BYTES) != hipSuccess || per_cu < 1) fprintf(stderr, "kernel_launch: occupancy query says %d\n", per_cu);
        (void)hipGetLastError();
        grid = cus;
    }
    if (grid < 0) return;
    if (hipMemsetAsync((char*)d_ws + WS_CTL, 0, CTL_ZERO_BYTES, stream) != hipSuccess) return;
    Args a{};
    for (int i = 0; i < 29; ++i) a.in[i] = (const float*)d_in[i];
    a.out = (float*)d_out; a.ws = (unsigned char*)d_ws;
    if (MK_N_LAUNCHES == 1) { a.ph_lo = 0; a.ph_hi = NPHASE; hipLaunchKernelGGL(mk_fwd, dim3(grid), dim3(NTHR), LDS_BYTES, stream, a); }
    else for (int p = 0; p < NPHASE; ++p) { a.ph_lo = p; a.ph_hi = p + 1; hipLaunchKernelGGL(mk_fwd, dim3(grid), dim3(NTHR), LDS_BYTES, stream, a); }
}
```

```cpp
#include <hip/hip_runtime.h>
#include <cstdio>
#include <cstdint>

#ifndef MK_N_LAUNCHES
#define MK_N_LAUNCHES 1
#endif

constexpr int NB = 4, SEQ = 8192, D = 1024, T = NB * SEQ, CTX = 256, TC = NB * CTX, MROWS = T + TC;
constexpr int KVL = CTX + SEQ;
constexpr int NIN = 6656, GRIDW = 64, NROWS = SEQ / GRIDW;
constexpr int NH = 8, HD = 64;
constexpr int NEXP = 32, EH = 512, NGRP = 4, EPG = 8;
constexpr int NLIST = 64;
constexpr float EPS = 1e-6f;
constexpr float LOG2E = 1.4426950408889634f;
constexpr float C2 = 0.125f * LOG2E;

constexpr size_t MiB = 1u << 20;
constexpr size_t WS_CTL = 0, CTL_ZERO_BYTES = 1 * MiB;
constexpr size_t WS_MOD = 1 * MiB;
constexpr size_t WS_ROPE = 1 * MiB + 256 * 1024;
constexpr size_t WS_LIST = 488 * MiB;
constexpr size_t WS_WIN = 12 * MiB;
constexpr size_t WS_WA = 25 * MiB, WS_WB = 27 * MiB, WS_WO = 28 * MiB;
constexpr size_t WS_WGU = 30 * MiB;
constexpr size_t WS_WD = 94 * MiB;
constexpr size_t WS_XN = 126 * MiB;
constexpr size_t WS_QA = 192 * MiB;
constexpr size_t WS_QB = 256 * MiB;
constexpr size_t WS_KA = 288 * MiB;
constexpr size_t WS_VA = 354 * MiB;
constexpr size_t WS_KB = 420 * MiB;
constexpr size_t WS_VB = 453 * MiB;
constexpr size_t WS_END = 504 * MiB;
constexpr size_t WS_Y = WS_XN, WS_H2 = WS_XN, WS_HID = WS_QA, WS_XMID = WS_KA;
constexpr int CW_TMO = 0, CW_BAR = 4096, CW_CNT = 16384;

constexpr int LDS_BYTES = 155648;
constexpr int NTHR = 512;

#define GAS __attribute__((address_space(1)))
#define LAS __attribute__((address_space(3)))
typedef unsigned short bf16;
typedef float f32x4 __attribute__((ext_vector_type(4)));
typedef float f32x2 __attribute__((ext_vector_type(2)));
typedef unsigned u32x4 __attribute__((ext_vector_type(4)));
typedef unsigned u32x2 __attribute__((ext_vector_type(2)));
typedef GAS unsigned gu32;

__device__ __forceinline__ unsigned f2bf(float f) { unsigned u = __builtin_bit_cast(unsigned, f); return (u + 0x7fffu + ((u >> 16) & 1u)) >> 16; }
__device__ __forceinline__ float bf2f(unsigned h) { return __builtin_bit_cast(float, h << 16); }
__device__ __forceinline__ float rbf(float f) { return bf2f(f2bf(f)); }
__device__ __forceinline__ unsigned pk2(float lo, float hi) { return f2bf(lo) | (f2bf(hi) << 16); }

#define XB_TMO      128
#define XB_XCNT(j)  (256  + 64 * (j))
#define XB_XSUB(j)  (1280 + 64 * (j))
#define XB_XGEN(j)  (2304 + 64 * (j))
#define XB_TOP      3328
#define XB_TOPGEN   3392
#define XCD_BAR_WORDS 3456
#define XB_SPIN_CAP (1u << 18)
__device__ __forceinline__ unsigned xb_ld(unsigned* p)              { return __hip_atomic_load(p, __ATOMIC_RELAXED, __HIP_MEMORY_SCOPE_AGENT); }
__device__ __forceinline__ unsigned xb_add(unsigned* p, unsigned v) { return __hip_atomic_fetch_add(p, v, __ATOMIC_RELAXED, __HIP_MEMORY_SCOPE_AGENT); }
__device__ __forceinline__ unsigned xb_xcc_id() { return (unsigned)__builtin_amdgcn_s_getreg((3 << 11) | 20) & 0xFu; }
#define XB_SPIN(cond, bar) do { unsigned _sp = 0; while (cond) { __builtin_amdgcn_s_sleep(1); \
    if ((++_sp & 255u) == 0u) { if (xb_ld(&(bar)[XB_TMO])) break; if (_sp > XB_SPIN_CAP) { atomicAdd(&(bar)[XB_TMO], 1u); break; } } } } while (0)
struct XcdBarrier { unsigned* bar; unsigned x; volatile LAS unsigned* st; };
__device__ __forceinline__ XcdBarrier xcd_barrier_post(unsigned* bar, volatile LAS unsigned* st) {
    XcdBarrier b; b.bar = bar; b.x = xb_xcc_id(); b.st = st;
    if (threadIdx.x == 0) (void)xb_add(&bar[XB_XCNT(b.x)], 1u);
    return b;
}
__device__ __forceinline__ void xcd_barrier_complete(unsigned* bar, unsigned x, unsigned& nloc, unsigned& nx) {
    const unsigned G = gridDim.x * gridDim.y * gridDim.z;
    unsigned sum, cnt, mine, sp = 0u;
    for (;;) {
        sum = 0u; cnt = 0u; mine = 0u;
#pragma unroll
        for (unsigned j = 0; j < 16; ++j) { const unsigned c = xb_ld(&bar[XB_XCNT(j)]); sum += c; cnt += (c > 0u) ? 1u : 0u; mine = (j == x) ? c : mine; }
        if (sum == G) break;
        __builtin_amdgcn_s_sleep(1);
        if ((++sp & 255u) == 0u) { if (xb_ld(&bar[XB_TMO])) break; if (sp > XB_SPIN_CAP) { atomicAdd(&bar[XB_TMO], 1u); break; } }
    }
    nloc = mine > 0u ? mine : 1u; nx = cnt > 0u ? cnt : 1u;
}
__device__ __forceinline__ void xcd_barrier(const XcdBarrier& b) {
    asm volatile("s_waitcnt vmcnt(0)" ::: "memory");
    __syncthreads();
    if (threadIdx.x == 0) {
        unsigned* bar = b.bar;
        __builtin_amdgcn_s_waitcnt(0);
        unsigned nloc = b.st[0], nx = b.st[1];
        if (nloc == 0u) { xcd_barrier_complete(bar, b.x, nloc, nx); b.st[0] = nloc; b.st[1] = nx; }
        const unsigned old = xb_add(&bar[XB_XSUB(b.x)], 1u);
        const unsigned gen = old / nloc;
        if (old + 1u == (gen + 1u) * nloc) {
            __builtin_amdgcn_fence(__ATOMIC_RELEASE, "agent");
            asm volatile("s_waitcnt vmcnt(0)" ::: "memory");
            const unsigned og = xb_add(&bar[XB_TOP], 1u);
            const unsigned tg = og / nx;
            if (og + 1u == (tg + 1u) * nx) xb_add(&bar[XB_TOPGEN], 1u);
            else XB_SPIN(xb_ld(&bar[XB_TOPGEN]) == tg, bar);
            __builtin_amdgcn_fence(__ATOMIC_ACQUIRE, "agent");
            xb_add(&bar[XB_XGEN(b.x)], 1u);
            asm volatile("s_waitcnt vmcnt(0)" ::: "memory");
        } else {
            XB_SPIN(xb_ld(&bar[XB_XGEN(b.x)]) == gen, bar);
            __builtin_amdgcn_fence(__ATOMIC_ACQUIRE, "agent");
            asm volatile("s_waitcnt vmcnt(0)" ::: "memory");
        }
    }
    __syncthreads();
}

namespace pg8 {
#define PG8_LAS __attribute__((address_space(3)))
typedef unsigned short bf16_t;
typedef short bf16x8 __attribute__((ext_vector_type(8)));
constexpr int BM = 256, BK = 64, HALF = 128, HTB = HALF * BK * 2, STAGE_BYTES = 8 * HTB, NXCD = 8, WGM = 8;
__host__ __device__ __forceinline__ int lds_byte(int r, int c) { const int st = (r >> 4) * 2 + (c >> 5), rr = r & 15, cc = c & 31, ob = rr * 64 + cc * 2; return st * 1024 + (ob ^ (((ob >> 9) & 1) << 5)); }
__host__ __device__ __forceinline__ void stage_rc(int b, int& R, int& C) { const int st = b / 1024, sb = b % 1024, swz = sb ^ (((sb >> 9) & 1) << 5); R = (st >> 1) * 16 + swz / 64; C = (st & 1) * 32 + (swz % 64) / 2; }
__host__ __device__ __forceinline__ int perm32(int rho) { const int n = rho >> 4, i = rho & 15; return 8 * (i >> 2) + 4 * n + (i & 3); }
struct Unit { int pm, pn, a0, a1; };
struct Gemm { const bf16_t* A; const bf16_t* Bt; int lda, ldb, K; };
__device__ __forceinline__ unsigned cvt_pk_bf16(float lo, float hi) { unsigned r; asm volatile("v_cvt_pk_bf16_f32 %0, %1, %2" : "=v"(r) : "v"(lo), "v"(hi)); return r; }

struct DenseOrder {
    int nM, nN, nwg, G, c, ldb;
    __device__ void init(int M, int N, int G_, int c_, int ldb_) { nM = M / BM; nN = N / BM; nwg = nM * nN; G = G_; c = c_; ldb = ldb_; }
    __device__ __forceinline__ bool map(long L, Unit& u) const {
        if (L >= nwg) return false;
        int wgid = (int)L; { const int q = nwg / NXCD, r = nwg % NXCD, xcd = wgid % NXCD, off = wgid / NXCD; wgid = (xcd < r ? xcd * (q + 1) : r * (q + 1) + (xcd - r) * q) + off; }
        const int nig = WGM * nN, gid = wgid / nig, fm = gid * WGM, gsz = (nM - fm) < WGM ? (nM - fm) : WGM;
        u.pm = fm + ((wgid % nig) % gsz); u.pn = (wgid % nig) / gsz; u.a0 = 0; u.a1 = 0; return true;
    }
    __device__ __forceinline__ bool next(int i, Unit& u) const { return map((long)i * G + c, u); }
    __device__ __forceinline__ int arow(const Unit& u, int r) const { return u.pm * BM + r; }
    __device__ __forceinline__ size_t boff(const Unit& u) const { return (size_t)u.pn * BM * ldb; }
};

template <class Epi, class Sched>
__device__ __forceinline__ void gemm_phase(PG8_LAS unsigned char* lds, const Gemm g, const Sched& S, const Epi& E) {
    const int tid = threadIdx.x, wid = __builtin_amdgcn_readfirstlane(tid >> 6), lane = tid & 63, wr = wid >> 2, wc = wid & 3, fr = lane & 15, fq = lane >> 4;
    const int nt = g.K / BK;
    int RA[2], CA[2]; unsigned voffB[2];
#pragma unroll
    for (int i = 0; i < 2; ++i) { int R, C; stage_rc(tid * 16 + i * 8192, R, C); const int Rb = Epi::PERM ? ((R & ~31) + perm32(R & 31)) : R;
        RA[i] = R; CA[i] = C * 2; voffB[i] = (unsigned)(Rb * g.ldb + C) * 2u; }
    const size_t kstep = (size_t)(BK * 2);
    const size_t hstepB = (size_t)HALF * g.ldb * 2;
    const unsigned ldsw = (unsigned)wid * 1024u;
    const int aoff = lds_byte(wr * 64 + fr, fq * 8), boff = lds_byte(wc * 32 + fr, fq * 8);
#define PG8_SA(b, h) (((b) * 2 + (h)) * HTB)
#define PG8_SB(b, h) ((4 + (b) * 2 + (h)) * HTB)
#define PG8_STAGE(bufoff, gbase, voff) do { _Pragma("unroll") for (int _i = 0; _i < 2; ++_i) \
        __builtin_amdgcn_global_load_lds((const unsigned*)((const char*)(gbase) + (voff)[_i]), (PG8_LAS unsigned*)(lds + (bufoff) + ldsw + _i * 8192), 16, 0, 0); } while (0)
#define PG8_LDA(dst, b, h) do { _Pragma("unroll") for (int m = 0; m < 4; ++m) _Pragma("unroll") for (int k = 0; k < 2; ++k) dst[m][k] = *(const PG8_LAS bf16x8*)(lds + PG8_SA(b, h) + aoff + m * 2048 + k * 1024); } while (0)
#define PG8_LDB(dst, b, h) do { _Pragma("unroll") for (int n = 0; n < 2; ++n) _Pragma("unroll") for (int k = 0; k < 2; ++k) dst[n][k] = *(const PG8_LAS bf16x8*)(lds + PG8_SB(b, h) + boff + n * 2048 + k * 1024); } while (0)
#define PG8_MMA(ai, bj, At, Bt) do { __builtin_amdgcn_s_setprio(1); _Pragma("unroll") for (int m = 0; m < 4; ++m) _Pragma("unroll") for (int n = 0; n < 2; ++n) _Pragma("unroll") for (int k = 0; k < 2; ++k) \
        acc[ai][bj][m][n] = __builtin_amdgcn_mfma_f32_16x16x32_bf16(Bt[n][k], At[m][k], acc[ai][bj][m][n], 0, 0, 0); __builtin_amdgcn_s_setprio(0); } while (0)
#define PG8_WAIT_V(n) asm volatile("s_waitcnt vmcnt(" #n ")" ::: "memory")
#define PG8_WAIT_L(n) asm volatile("s_waitcnt lgkmcnt(" #n ")" ::: "memory")
#define PG8_BAR __builtin_amdgcn_s_barrier()
#define PG8_SCHED __builtin_amdgcn_sched_barrier(0)
#define PG8_AOFFS(dst, u) do { _Pragma("unroll") for (int _h = 0; _h < 2; ++_h) _Pragma("unroll") for (int _i = 0; _i < 2; ++_i) \
        dst[_h][_i] = (unsigned)S.arow(u, _h * HALF + RA[_i]) * (unsigned)(g.lda * 2) + (unsigned)CA[_i]; } while (0)
    Unit cur, nxt; int ui = 0;
    if (!S.next(0, cur)) return;
    f32x4 acc[2][2][4][2];
#pragma unroll
    for (int a = 0; a < 2; ++a)
#pragma unroll
        for (int b = 0; b < 2; ++b)
#pragma unroll
            for (int m = 0; m < 4; ++m)
#pragma unroll
                for (int n = 0; n < 2; ++n) acc[a][b][m][n] = (f32x4){0.f, 0.f, 0.f, 0.f};
    bf16x8 At[4][2], B0[2][2], B1[2][2];
    unsigned oc[2][2], on[2][2];
    PG8_AOFFS(oc, cur);
    const char* gA = (const char*)g.A;
    const char* cB = (const char*)g.Bt + S.boff(cur) * 2;
    PG8_STAGE(PG8_SB(0, 0), cB, voffB); PG8_STAGE(PG8_SB(0, 1), cB + hstepB, voffB); PG8_STAGE(PG8_SA(0, 0), gA, oc[0]); PG8_STAGE(PG8_SA(0, 1), gA, oc[1]);
    if (wr == 1) PG8_BAR;
    PG8_WAIT_V(2); PG8_BAR;
    PG8_STAGE(PG8_SB(1, 0), cB + kstep, voffB); PG8_STAGE(PG8_SA(1, 0), gA + kstep, oc[0]); PG8_STAGE(PG8_SB(1, 1), cB + hstepB + kstep, voffB);
    PG8_WAIT_V(6); PG8_BAR;
    for (;;) {
        const bool has_next = S.next(ui + 1, nxt);
        if (has_next) { PG8_AOFFS(on, nxt); } else {
#pragma unroll
            for (int _h = 0; _h < 2; ++_h)
#pragma unroll
                for (int _i = 0; _i < 2; ++_i) on[_h][_i] = oc[_h][_i]; }
        const char* nB = has_next ? (const char*)g.Bt + S.boff(nxt) * 2 : cB;
        for (int t = 0; t < nt; t += 2) {
            const bool last = (t == nt - 2);
            const char* a1 = gA + (size_t)(t + 1) * kstep;
            const char* a2 = last ? gA : gA + (size_t)(t + 2) * kstep; const char* b2 = last ? nB : cB + (size_t)(t + 2) * kstep;
            const char* a3 = a2 + kstep; const char* b3 = b2 + kstep;
            unsigned os[2][2];
#pragma unroll
            for (int _h = 0; _h < 2; ++_h)
#pragma unroll
                for (int _i = 0; _i < 2; ++_i) os[_h][_i] = last ? on[_h][_i] : oc[_h][_i];
            PG8_LDB(B0, 0, 0); PG8_LDB(B1, 0, 1); PG8_SCHED; PG8_LDA(At, 0, 0); PG8_STAGE(PG8_SA(1, 1), a1, oc[1]);
            PG8_WAIT_V(8); PG8_WAIT_L(0); PG8_BAR; PG8_MMA(0, 0, At, B0); PG8_MMA(0, 1, At, B1); PG8_BAR; PG8_SCHED;
            PG8_LDA(At, 0, 1); PG8_STAGE(PG8_SB(0, 0), b2, voffB); PG8_STAGE(PG8_SB(0, 1), b2 + hstepB, voffB); PG8_STAGE(PG8_SA(0, 0), a2, os[0]);
            PG8_WAIT_V(8); PG8_WAIT_L(0); PG8_BAR; PG8_MMA(1, 0, At, B0); PG8_MMA(1, 1, At, B1); PG8_BAR; PG8_SCHED;
            PG8_LDB(B0, 1, 0); PG8_LDB(B1, 1, 1); PG8_SCHED; PG8_LDA(At, 1, 0); PG8_STAGE(PG8_SA(0, 1), a2, os[1]);
            PG8_WAIT_V(8); PG8_WAIT_L(0); PG8_BAR; PG8_MMA(0, 0, At, B0); PG8_MMA(0, 1, At, B1); PG8_BAR; PG8_SCHED;
            PG8_LDA(At, 1, 1); PG8_STAGE(PG8_SB(1, 0), b3, voffB); PG8_STAGE(PG8_SB(1, 1), b3 + hstepB, voffB); PG8_STAGE(PG8_SA(1, 0), a3, os[0]);
            PG8_WAIT_V(8); PG8_WAIT_L(0); PG8_BAR; PG8_MMA(1, 0, At, B0); PG8_MMA(1, 1, At, B1); PG8_BAR; PG8_SCHED;
        }
        if (wr == 0) PG8_BAR;
        E(acc, cur, wr, wc, fr, fq);
        if (!has_next) break;
#pragma unroll
        for (int a = 0; a < 2; ++a)
#pragma unroll
            for (int b = 0; b < 2; ++b)
#pragma unroll
                for (int m = 0; m < 4; ++m)
#pragma unroll
                    for (int n = 0; n < 2; ++n) acc[a][b][m][n] = (f32x4){0.f, 0.f, 0.f, 0.f};
        cur = nxt; cB = nB; ++ui;
#pragma unroll
        for (int _h = 0; _h < 2; ++_h)
#pragma unroll
            for (int _i = 0; _i < 2; ++_i) oc[_h][_i] = on[_h][_i];
        if (wr == 1) PG8_BAR;
    }
    PG8_WAIT_V(0);
    PG8_BAR;
#undef PG8_SA
#undef PG8_SB
#undef PG8_STAGE
#undef PG8_LDA
#undef PG8_LDB
#undef PG8_MMA
#undef PG8_WAIT_V
#undef PG8_WAIT_L
#undef PG8_BAR
#undef PG8_SCHED
#undef PG8_AOFFS
}
}

struct Args { const float* in[29]; float* out; unsigned char* ws; int ph_lo, ph_hi; };
struct Frame {
    LAS unsigned char* lds;
    unsigned char* ws; gu32* ctl;
    int tid, lane, wave, G, bid;
    const __attribute__((address_space(4))) unsigned char* ka;
    float* out;
    __device__ __forceinline__ const float* inp(int k) const { return *(const float* const __attribute__((address_space(4)))*)(ka + 8 * k); }
};
__device__ __forceinline__ float wave_sum(float v) {
#pragma unroll
    for (int o = 1; o < 64; o <<= 1) v += __shfl_xor(v, o);
    return v;
}
__device__ __forceinline__ float sigmoid_f(float v) { return __builtin_amdgcn_rcpf(1.f + __builtin_amdgcn_exp2f(-LOG2E * v)); }
__device__ __forceinline__ float silu_f(float v) { return v * sigmoid_f(v); }

__constant__ float INV_FREQ[16] = {1.0f, 0.5623413324356079f, 0.3162277638912201f, 0.17782793939113617f, 0.10000000149011612f, 0.05623413249850273f, 0.03162277489900589f, 0.017782794311642647f,
    0.009999999776482582f, 0.005623413249850273f, 0.003162277629598975f, 0.0017782794311642647f, 0.0010000000474974513f, 0.000562341301701963f, 0.0003162277571391314f, 0.00017782794020604342f};
__device__ __forceinline__ double sin_poly(double r) { double r2 = r * r, t = r, s = r; for (int i = 1; i <= 12; ++i) { t *= -r2 / (double)((2 * i) * (2 * i + 1)); s += t; } return s; }
__device__ __forceinline__ double cos_poly(double r) { double r2 = r * r, t = 1.0, s = 1.0; for (int i = 1; i <= 12; ++i) { t *= -r2 / (double)((2 * i - 1) * (2 * i)); s += t; } return s; }
__device__ __forceinline__ void p0_adaln_rope(Frame& F) {
    const float* c = F.inp(1); const float* c_ctx = F.inp(3); const float* w_ada = F.inp(4); const float* b_ada = F.inp(5);
    float* MOD = (float*)(F.ws + WS_MOD);
    { float* RP = (float*)(F.ws + WS_ROPE);
      const int gi = F.bid * NTHR + F.tid;
      if (gi < 192 * 16) { const int pos = gi >> 4, f = gi & 15; const int p = pos < 128 ? pos : pos - 128;
          const float invf = INV_FREQ[f]; const float ang = (float)p * invf;
          const double a = (double)ang; const double k = rint(a * 0.15915494309189535); const double r = a - k * 6.283185307179586477;
          const float cs = (float)cos_poly(r), sn = (float)sin_poly(r);
          if (pos < 128) { RP[pos * 16 + f] = cs; RP[2048 + pos * 16 + f] = sn; } else { RP[4096 + p * 16 + f] = cs; RP[4096 + 1024 + p * 16 + f] = sn; } } }
    if (F.bid < 96) {
        LAS float* S = (LAS float*)F.lds;
        LAS float* R = S + 5 * 1024;
        for (int i = F.tid; i < 5 * 1024; i += NTHR) { const int r = i >> 10, k = i & 1023; const float v = r < 4 ? c[r * 1024 + k] : c_ctx[k]; S[i] = silu_f(v); }
        __syncthreads();
        for (int item = F.bid; item < 96; item += F.G) {
            const int c0 = item * 64; float acc[5] = {0.f, 0.f, 0.f, 0.f, 0.f};
            for (int kk = 0; kk < 128; ++kk) { const int k = F.wave * 128 + kk; const float w = w_ada[(size_t)k * 6144 + c0 + F.lane];
#pragma unroll
                for (int r = 0; r < 5; ++r) acc[r] += S[r * 1024 + k] * w; }
#pragma unroll
            for (int r = 0; r < 5; ++r) R[(F.wave * 5 + r) * 64 + F.lane] = acc[r];
            __syncthreads();
            if (F.tid < 320) { const int r = F.tid >> 6, l = F.tid & 63; float s = 0.f;
#pragma unroll
                for (int w = 0; w < 8; ++w) s += R[(w * 5 + r) * 64 + l];
                MOD[r * 6144 + c0 + l] = s + b_ada[c0 + l]; }
            __syncthreads();
        }
    }
}

__device__ __forceinline__ void norm_mod_row(const float* xrow, const float* nw, const float* scale, const float* shift, int lane, f32x4 (&v)[4]) {
    const GAS f32x4* xr = (const GAS f32x4*)xrow + lane; float ss = 0.f;
#pragma unroll
    for (int j = 0; j < 4; ++j) { v[j] = xr[64 * j]; ss += (v[j].x * v[j].x + v[j].y * v[j].y) + (v[j].z * v[j].z + v[j].w * v[j].w); }
    const float rstd = 1.0f / sqrtf(wave_sum(ss) * (1.f / D) + EPS);
#pragma unroll
    for (int j = 0; j < 4; ++j) { const int d0 = 4 * lane + 256 * j; const f32x4 w = *(const f32x4*)(nw + d0), sc = *(const f32x4*)(scale + d0), sh = *(const f32x4*)(shift + d0);
        v[j] = (v[j] * rstd * w) * (1.f + sc) + sh; }
}
__device__ __forceinline__ void store_row_bf16(bf16* orow, int lane, const f32x4 (&v)[4]) {
    GAS u32x2* o8 = (GAS u32x2*)orow + lane;
#pragma unroll
    for (int j = 0; j < 4; ++j) { u32x2 w; w.x = pk2(v[j].x, v[j].y); w.y = pk2(v[j].z, v[j].w); o8[64 * j] = w; }
}
__device__ __forceinline__ void p1a_norm1(Frame& F) {
    const float* x = F.inp(0); const float* ctx = F.inp(2); const float* nw = F.inp(6);
    const float* MOD = (const float*)(F.ws + WS_MOD); bf16* XN = (bf16*)(F.ws + WS_XN);
    const int gw = F.bid * 8 + F.wave, NGW = F.G * 8;
    for (int m = gw; m < MROWS; m += NGW) {
        const float* row; int mr;
        if (m < T) { row = x + (size_t)m * D; mr = m / SEQ; } else { row = ctx + (size_t)(m - T) * D; mr = 4; }
        f32x4 v[4]; norm_mod_row(row, nw, MOD + mr * 6144 + 1024, MOD + mr * 6144, F.lane, v);
        store_row_bf16(XN + (size_t)m * D, F.lane, v);
    }
}

__device__ __forceinline__ int kv_row(int m) { if (m < T) { const int b = m / SEQ, t = m - b * SEQ; return b * KVL + CTX + t; } const int cm = m - T, b = cm / CTX, c = cm - b * CTX; return b * KVL + c; }

__device__ __forceinline__ void p0_transpose_item(const float* W, int K, int N, bf16* WT, int kb, int n0, int dst_row0, LAS float* scr, int lane) {
    const int k0 = 64 * kb;
#pragma unroll 8
    for (int i = 0; i < 32; ++i) { const int kk = 2 * i + (lane >> 5); scr[kk * 33 + (lane & 31)] = W[(size_t)(k0 + kk) * N + n0 + (lane & 31)]; }
    asm volatile("s_waitcnt lgkmcnt(0)" ::: "memory");
    const int c = lane & 7;
#pragma unroll
    for (int j = 0; j < 4; ++j) { const int n = (lane >> 3) + 8 * j; const LAS float* sp = scr + (8 * c) * 33 + n;
        u32x4 o; o.x = pk2(sp[0 * 33], sp[1 * 33]); o.y = pk2(sp[2 * 33], sp[3 * 33]); o.z = pk2(sp[4 * 33], sp[5 * 33]); o.w = pk2(sp[6 * 33], sp[7 * 33]);
        *(GAS u32x4*)(WT + (size_t)(dst_row0 + n) * K + k0 + 8 * c) = o; }
    asm volatile("s_waitcnt lgkmcnt(0)" ::: "memory");
}
__device__ __forceinline__ int inproj_dst_row(int n0) { const int pn = n0 >> 8, w = n0 & 255, g = w >> 6, a = (w >> 5) & 1; return 256 * pn + 128 * a + 32 * g; }
__device__ __forceinline__ void p0_weights(Frame& F) {
    LAS float* scr = (LAS float*)(F.lds + 65536 + F.wave * 8704);
    const int gw = F.bid * 8 + F.wave, NGW = F.G * 8;
    constexpr int I_IN = 16 * 208, I_A = 16 * 32, I_B = 8 * 32, I_O = 16 * 32, I_G = 32 * 16 * 16, I_D = 32 * 8 * 32;
    constexpr int NITEMS = I_IN + I_A + I_B + I_O + 2 * I_G + I_D;
    for (int it = gw; it < NITEMS; it += NGW) {
        int r = it;
        if (r < I_IN) { const int kb = r / 208, n0 = (r % 208) * 32; p0_transpose_item(F.inp(8), 1024, NIN, (bf16*)(F.ws + WS_WIN), kb, n0, inproj_dst_row(n0), scr, F.lane); continue; } r -= I_IN;
        if (r < I_A) { const int kb = r / 32, n0 = (r % 32) * 32; p0_transpose_item(F.inp(19), 1024, 1024, (bf16*)(F.ws + WS_WA), kb, n0, n0, scr, F.lane); continue; } r -= I_A;
        if (r < I_B) { const int kb = r / 32, n0 = (r % 32) * 32; p0_transpose_item(F.inp(20), 512, 1024, (bf16*)(F.ws + WS_WB), kb, n0, n0, scr, F.lane); continue; } r -= I_B;
        if (r < I_O) { const int kb = r / 32, n0 = (r % 32) * 32; p0_transpose_item(F.inp(21), 1024, 1024, (bf16*)(F.ws + WS_WO), kb, n0, n0, scr, F.lane); continue; } r -= I_O;
        if (r < 2 * I_G) { const int up = r >= I_G; if (up) r -= I_G; const int e = r / 256, q = r % 256, kb = q / 16, n0 = (q % 16) * 32;
            const int drow = 256 * (n0 >> 7) + 128 * up + (n0 & 127);
            p0_transpose_item(F.inp(up ? 27 : 26) + (size_t)e * 1024 * EH, 1024, EH, (bf16*)(F.ws + WS_WGU) + (size_t)e * 1024 * 1024, kb, n0, drow, scr, F.lane); continue; } r -= 2 * I_G;
        { const int e = r / 256, q = r % 256, kb = q / 32, n0 = (q % 32) * 32;
            p0_transpose_item(F.inp(28) + (size_t)e * EH * 1024, EH, 1024, (bf16*)(F.ws + WS_WD) + (size_t)e * 1024 * EH, kb, n0, n0, scr, F.lane); }
    }
}

struct InProjOrder {
    pg8::DenseOrder d;
    __device__ __forceinline__ bool next(int i, pg8::Unit& u) const {
        long L = (long)i * d.G + d.c;
#if defined(PROBE_INPROJ2)
        if (L >= d.nwg + 48) L -= d.nwg + 48;
        if (i >= 27) return false;
#endif
        if (L < d.nwg) return d.map(L, u);
        const int j = (int)(L - d.nwg); if (j >= 48) return false;
        const int c = j % 12; u.pm = 128 + j / 12; u.pn = c < 8 ? 4 + c : 14 + (c - 8); u.a0 = 0; u.a1 = 0; return true;
    }
    __device__ __forceinline__ int arow(const pg8::Unit& u, int r) const { return u.pm * 256 + r; }
    __device__ __forceinline__ size_t boff(const pg8::Unit& u) const { return (size_t)u.pn * 256 * 1024; }
};
struct EpiInProj {
    static constexpr bool PERM = true;
    unsigned char* ws; bf16* GA; const float* gq_a; const float* gk_a; const float* gq_b; const float* gk_b;
    __device__ __forceinline__ void operator()(const f32x4 (&acc)[2][2][4][2], const pg8::Unit& u, int wr, int wc, int fr_, int fq_) const {
        int fr = fr_, fq = fq_; asm volatile("" : "+v"(fr), "+v"(fq));
        const int pn = u.pn, cg = 4 * pn + wc;
        int kind; const float* gain = nullptr; bool rope = false; float oscale = 1.f; bf16* dbase; int pitch, ccol; bool kvrow = false;
        if (cg < 16)      { kind = 0; gain = gq_a; rope = true; oscale = C2; dbase = (bf16*)(ws + WS_QA); pitch = D; ccol = cg * 64; }
        else if (cg < 32) { kind = 0; gain = gk_a; rope = true; dbase = (bf16*)(ws + WS_KA); pitch = D; ccol = (cg - 16) * 64; kvrow = true; }
        else if (cg < 48) { kind = 1; dbase = (bf16*)(ws + WS_VA); pitch = D; ccol = (cg - 32) * 64; kvrow = true; }
        else if (cg < 56) { kind = 0; gain = gq_b; oscale = C2; dbase = (bf16*)(ws + WS_QB); pitch = 512; ccol = (cg - 48) * 64; }
        else if (cg < 64) { kind = 0; gain = gk_b; dbase = (bf16*)(ws + WS_KB); pitch = 512; ccol = (cg - 56) * 64; kvrow = true; }
        else if (cg < 72) { kind = 1; dbase = (bf16*)(ws + WS_VB); pitch = 512; ccol = (cg - 64) * 64; kvrow = true; }
        else if (cg < 88) { kind = 2; dbase = GA; pitch = D; ccol = (cg - 72) * 64; }
        else              { kind = 2; dbase = GA + (size_t)T * D; pitch = D; ccol = (cg - 88) * 64; }
        const bool latent = u.pm < 128; if (!latent) rope = false;
        const float* RP = (const float*)(ws + WS_ROPE);
        const int role = fq >> 1, fl = fq & 1;
        const float sgn = role ? 1.f : -1.f;
        f32x4 gn[2][2];
        if (kind == 0) {
#pragma unroll
            for (int bj = 0; bj < 2; ++bj)
#pragma unroll
                for (int n = 0; n < 2; ++n) gn[bj][n] = *(const f32x4*)(gain + 32 * bj + 8 * fq + 4 * n) * oscale;
        }
#pragma unroll
        for (int ai = 0; ai < 2; ++ai)
#pragma unroll
            for (int m = 0; m < 4; ++m) {
                const int row = u.pm * 256 + ai * 128 + wr * 64 + m * 16 + fr;
                f32x4 v[2][2];
#pragma unroll
                for (int bj = 0; bj < 2; ++bj)
#pragma unroll
                    for (int n = 0; n < 2; ++n) v[bj][n] = acc[ai][bj][m][n];
                if (kind == 0) {
                    float ss = 0.f;
#pragma unroll
                    for (int bj = 0; bj < 2; ++bj)
#pragma unroll
                        for (int n = 0; n < 2; ++n) ss += (v[bj][n].x * v[bj][n].x + v[bj][n].y * v[bj][n].y) + (v[bj][n].z * v[bj][n].z + v[bj][n].w * v[bj][n].w);
                    ss += __shfl_xor(ss, 16); ss += __shfl_xor(ss, 32);
                    const float rstd = 1.0f / sqrtf(ss * (1.f / 64.f) + EPS);
#pragma unroll
                    for (int bj = 0; bj < 2; ++bj)
#pragma unroll
                        for (int n = 0; n < 2; ++n) v[bj][n] = v[bj][n] * rstd * gn[bj][n];
                    if (rope) {
                        const int t = row & (SEQ - 1), pr = t >> 6, pc = t & 63;
#pragma unroll
                        for (int bj = 0; bj < 2; ++bj) { const float* tb = RP + (bj ? 4096 + pc * 16 : pr * 16) + 8 * fl; const int so = bj ? 1024 : 2048;
#pragma unroll
                            for (int n = 0; n < 2; ++n) { const f32x4 cs = *(const f32x4*)(tb + 4 * n), sn = *(const f32x4*)(tb + so + 4 * n); f32x4 p;
#pragma unroll
                                for (int i = 0; i < 4; ++i) { const unsigned x = __float_as_uint(v[bj][n][i]); auto rr = __builtin_amdgcn_permlane32_swap(x, x, false, false); p[i] = __uint_as_float(role ? rr[0] : rr[1]); }
                                v[bj][n] = v[bj][n] * cs + (p * sgn) * sn; } }
                    }
                } else if (kind == 2) {
#pragma unroll
                    for (int bj = 0; bj < 2; ++bj)
#pragma unroll
                        for (int n = 0; n < 2; ++n) { v[bj][n].x = sigmoid_f(v[bj][n].x); v[bj][n].y = sigmoid_f(v[bj][n].y); v[bj][n].z = sigmoid_f(v[bj][n].z); v[bj][n].w = sigmoid_f(v[bj][n].w); }
                }
                const int drow = kvrow ? kv_row(row) : row;
                bf16* dp = dbase + (size_t)drow * pitch + ccol + 8 * fq;
#pragma unroll
                for (int bj = 0; bj < 2; ++bj) { u32x4 w; w.x = pg8::cvt_pk_bf16(v[bj][0].x, v[bj][0].y); w.y = pg8::cvt_pk_bf16(v[bj][0].z, v[bj][0].w);
                    w.z = pg8::cvt_pk_bf16(v[bj][1].x, v[bj][1].y); w.w = pg8::cvt_pk_bf16(v[bj][1].z, v[bj][1].w); *(GAS u32x4*)(dp + 32 * bj) = w; }
            }
    }
};
__device__ __forceinline__ void p1b_inproj_mfma(Frame& F) {
    pg8::Gemm g{(const bf16*)(F.ws + WS_XN), (const bf16*)(F.ws + WS_WIN), D, D, D};
    InProjOrder S; S.d.init(T, NIN, F.G, F.bid, D);
    EpiInProj E{F.ws, (bf16*)F.out, F.inp(9), F.inp(10), F.inp(16), F.inp(17)};
    pg8::gemm_phase<EpiInProj, InProjOrder>(F.lds, g, S, E);
}

__device__ __forceinline__ float lam_value(const Frame& F) {
    float a = 0.f, b = 0.f; const float* q1 = F.inp(11); const float* k1 = F.inp(12); const float* q2 = F.inp(13); const float* k2 = F.inp(14);
    for (int i = 0; i < 64; ++i) { a += q1[i] * k1[i]; b += q2[i] * k2[i]; }
    return expf(a) - expf(b) + 0.2f;
}
__device__ __forceinline__ float qk_bound(const float* gq, const float* gk) {
    float mq = 0.f, mk = 0.f; for (int i = 0; i < 64; ++i) { mq = fmaxf(mq, fabsf(gq[i])); mk = fmaxf(mk, fabsf(gk[i])); }
    return 8.0f * mq * mk * LOG2E * 1.02f + 0.1f;
}

typedef int i32x2 __attribute__((ext_vector_type(2)));
__device__ __forceinline__ void p4a_norm2_route(Frame& F) {
    const float* XMID = (const float*)(F.ws + WS_XMID); const float* nw = F.inp(7); const float* MOD = (const float*)(F.ws + WS_MOD);
    const float* w_rg = F.inp(22); const float* b_rg = F.inp(23); const float* w_re = F.inp(24); const float* b_re = F.inp(25);
    bf16* H2 = (bf16*)(F.ws + WS_H2); i32x2* LIST = (i32x2*)(F.ws + WS_LIST);
    LAS float* WG = (LAS float*)F.lds;
    LAS float* WE = WG + 4096;
    for (int i = F.tid; i < 4096; i += NTHR) WG[i] = w_rg[i];
    for (int i = F.tid; i < 4 * 1024 * 8; i += NTHR) WE[i] = w_re[i];
    __syncthreads();
    const int gw = F.bid * 8 + F.wave, NGW = F.G * 8;
    f32x4 nx[4];
    if (gw < T) { const GAS f32x4* xr = (const GAS f32x4*)(XMID + (size_t)gw * D) + F.lane;
#pragma unroll
        for (int j = 0; j < 4; ++j) nx[j] = xr[64 * j]; }
    for (int m = gw; m < T; m += NGW) {
        const int b = m / SEQ; f32x4 v[4];
#pragma unroll
        for (int j = 0; j < 4; ++j) v[j] = nx[j];
        if (m + NGW < T) { const GAS f32x4* xr = (const GAS f32x4*)(XMID + (size_t)(m + NGW) * D) + F.lane;
#pragma unroll
            for (int j = 0; j < 4; ++j) nx[j] = xr[64 * j]; }
        { float ss = 0.f;
#pragma unroll
          for (int j = 0; j < 4; ++j) ss += (v[j].x * v[j].x + v[j].y * v[j].y) + (v[j].z * v[j].z + v[j].w * v[j].w);
          const float rstd = 1.0f / sqrtf(wave_sum(ss) * (1.f / D) + EPS);
          const float* scale = MOD + b * 6144 + 4096; const float* shift = MOD + b * 6144 + 3072;
#pragma unroll
          for (int j = 0; j < 4; ++j) { const int d0 = 4 * F.lane + 256 * j; const f32x4 w = *(const f32x4*)(nw + d0), sc = *(const f32x4*)(scale + d0), sh = *(const f32x4*)(shift + d0);
              v[j] = (v[j] * rstd * w) * (1.f + sc) + sh; } }
        store_row_bf16(H2 + (size_t)m * D, F.lane, v);
        float lg[4] = {0.f, 0.f, 0.f, 0.f};
#pragma unroll
        for (int j = 0; j < 4; ++j)
#pragma unroll
            for (int e = 0; e < 4; ++e) { const int k = 4 * F.lane + 256 * j + e; const float hv = v[j][e]; const f32x4 w4 = *(const LAS f32x4*)(WG + k * 4);
                lg[0] += hv * w4.x; lg[1] += hv * w4.y; lg[2] += hv * w4.z; lg[3] += hv * w4.w; }
#pragma unroll
        for (int c = 0; c < 4; ++c) lg[c] = wave_sum(lg[c]);
        int g = 0; float gl[4];
#pragma unroll
        for (int c = 0; c < 4; ++c) gl[c] = lg[c] + b_rg[c];
        float gm = gl[0];
#pragma unroll
        for (int c = 1; c < 4; ++c) if (gl[c] > gm) { gm = gl[c]; g = c; }
        float gs = 0.f;
#pragma unroll
        for (int c = 0; c < 4; ++c) gs += expf(gl[c] - gm);
        const float g_w = 1.f / gs;
        g = __builtin_amdgcn_readfirstlane(g);
        float el[8] = {0.f, 0.f, 0.f, 0.f, 0.f, 0.f, 0.f, 0.f};
        { const LAS float* we = WE + g * 8192;
#pragma unroll
          for (int j = 0; j < 4; ++j)
#pragma unroll
              for (int e = 0; e < 4; ++e) { const int k = 4 * F.lane + 256 * j + e; const float hv = v[j][e];
                  const f32x4 wa = *(const LAS f32x4*)(we + k * 8), wb = *(const LAS f32x4*)(we + k * 8 + 4);
                  el[0] += hv * wa.x; el[1] += hv * wa.y; el[2] += hv * wa.z; el[3] += hv * wa.w; el[4] += hv * wb.x; el[5] += hv * wb.y; el[6] += hv * wb.z; el[7] += hv * wb.w; } }
#pragma unroll
        for (int e = 0; e < 8; ++e) el[e] = wave_sum(el[e]) + b_re[g * 8 + e];
        int i0 = 0; float v0 = el[0];
#pragma unroll
        for (int e = 1; e < 8; ++e) if (el[e] > v0) { v0 = el[e]; i0 = e; }
        int i1 = -1; float v1 = -3.0e38f;
#pragma unroll
        for (int e = 0; e < 8; ++e) if (e != i0 && el[e] > v1) { v1 = el[e]; i1 = e; }
        const float e1 = expf(v1 - v0), den = 1.f / (1.f + e1);
        const float w0 = g_w * den, w1 = g_w * e1 * den;
        if (F.lane < 2) {
            const int ge = F.lane * 32 + g * 8 + (F.lane ? i1 : i0);
            const unsigned p = atomicAdd((unsigned*)(F.ctl + CW_CNT + 64 * ge), 1u);
            i32x2 rec; rec.x = m; rec.y = (int)__float_as_uint(F.lane ? w1 : w0);
            LIST[(size_t)ge * T + p] = rec;
        }
    }
}

namespace dattn {
typedef short bf16x8 __attribute__((ext_vector_type(8)));
typedef short s16x4 __attribute__((ext_vector_type(4)));
typedef float f32x16 __attribute__((ext_vector_type(16)));
typedef short v4i16_t __attribute__((ext_vector_type(4)));
constexpr int SLOT = 32768, NT = KVL / 64, LDS_WS = 3 * SLOT, XS = 136;
typedef __attribute__((address_space(3))) const char* lds_cptr;
__device__ __forceinline__ int crow(int r, int hi) { return (r & 3) + 8 * (r >> 2) + 4 * hi; }
__device__ __forceinline__ void glds16(const void* gsrc, unsigned lds_dst) { unsigned keep;
    asm volatile("s_mov_b32 %0, m0\n\ts_mov_b32 m0, %2\n\ts_nop 0\n\tglobal_load_lds_dwordx4 %1, off\n\ts_mov_b32 m0, %0" : "=&s"(keep) : "v"(gsrc), "s"(lds_dst) : "memory"); }
__device__ __forceinline__ unsigned cvtpk(float lo, float hi) { typedef float f2 __attribute__((ext_vector_type(2))); typedef __bf16 b2 __attribute__((ext_vector_type(2))); f2 v = {lo, hi}; b2 b = __builtin_convertvector(v, b2); return __builtin_bit_cast(unsigned, b); }
__device__ __forceinline__ s16x4 vtr(lds_cptr p) { return __builtin_bit_cast(s16x4, __builtin_amdgcn_ds_read_tr16_b64_v4i16((__attribute__((address_space(3))) v4i16_t*)p)); }
}

namespace dattn2 {
using dattn::bf16x8; using dattn::s16x4; using dattn::f32x16; using dattn::lds_cptr; using dattn::crow; using dattn::cvtpk; using dattn::vtr;
constexpr int NT = KVL / 64, KSL = 16384, VBASE = 3 * KSL, LDS_WS = 6 * KSL, XS = 136;
__device__ __forceinline__ void glds16s(unsigned voff, const void* sbase, unsigned lds_dst) { unsigned keep;
    asm volatile("s_mov_b32 %0, m0\n\ts_mov_b32 m0, %3\n\ts_nop 0\n\tglobal_load_lds_dwordx4 %1, %2\n\ts_mov_b32 m0, %0" : "=&s"(keep) : "v"(voff), "s"(sbase), "s"(lds_dst) : "memory"); }
#define D2_WAIT_BAR(N) asm volatile("s_waitcnt vmcnt(" #N ") lgkmcnt(0)\n\ts_barrier" ::: "memory")
#define D2_SBAR() __builtin_amdgcn_sched_barrier(0)
typedef __attribute__((address_space(3))) const bf16x8* lds_b8;

template <bool SHIFT> __device__ __forceinline__ void unit(int b, int h, int qt, const bf16* QA, bf16* OA, const bf16* KA, const bf16* VA, LAS unsigned char* lds, float lam, float shift, const float* subln) {
    const int tid = threadIdx.x, lane = tid & 63, r32 = lane & 31, hi = lane >> 5; const int wid = __builtin_amdgcn_readfirstlane(tid >> 6);
    const int br = wid >> 2, qi = wid & 3;
    const size_t qrow0 = (size_t)b * SEQ + qt * 128 + qi * 32;
    const bf16* Qw = QA + qrow0 * D + h * 128 + br * 64;
    const unsigned lds0 = (unsigned)(uintptr_t)lds;
    unsigned koff[2], voff[2];
#pragma unroll
    for (int j = 0; j < 2; ++j) { const int row = 8 * wid + 4 * j + (lane >> 4), s16 = lane & 15;
        koff[j] = (unsigned)((row * D + h * 128 + ((s16 ^ (row & 15)) * 8)) * 2);
        voff[j] = (unsigned)((row * D + h * 128 + (((s16 >> 2) ^ (row & 3)) * 32) + (s16 & 3) * 8) * 2); }
    const char* Kb = (const char*)(KA + (size_t)b * KVL * D); const char* Vb = (const char*)(VA + (size_t)b * KVL * D);
    const unsigned dst0 = lds0 + (unsigned)wid * 2048u;
#define D2_KDMA(t, slot) do { const char* _p = Kb + (size_t)(t) * (64 * D * 2); const unsigned _d = (unsigned)__builtin_amdgcn_readfirstlane(dst0 + (slot)); glds16s(koff[0], _p, _d); glds16s(koff[1], _p, _d + 1024u); } while (0)
#define D2_VDMA(t, slot) do { const char* _p = Vb + (size_t)(t) * (64 * D * 2); const unsigned _d = (unsigned)__builtin_amdgcn_readfirstlane(dst0 + VBASE + (slot)); glds16s(voff[0], _p, _d); glds16s(voff[1], _p, _d + 1024u); } while (0)
    D2_KDMA(0, 0); D2_VDMA(0, 0); D2_KDMA(1, KSL);
    bf16x8 qr[4];
#pragma unroll
    for (int d0 = 0; d0 < 4; ++d0) qr[d0] = *(const bf16x8*)(Qw + (size_t)r32 * D + d0 * 16 + hi * 8);
    f32x16 o[4];
#pragma unroll
    for (int i = 0; i < 4; ++i) o[i] = f32x16{};
    const f32x16 z16 = f32x16{};
    float l = 0.f;
    const unsigned kad = (unsigned)(r32 * 256 + ((((br * 8 + hi) ^ (r32 & 15))) << 4));
    unsigned vad[4];
    { const int q = (lane & 15) >> 2;
#pragma unroll
      for (int db = 0; db < 4; ++db) vad[db] = (unsigned)(VBASE + (4 * hi + q) * 256 + ((db ^ q) << 6) + ((lane >> 4) & 1) * 32 + (lane & 3) * 8); }
    const lds_cptr l3 = (lds_cptr)lds;
#define D2_KF(slot, f) (*(lds_b8)(l3 + (slot) + (kad ^ (unsigned)(((f) >> 1) << 5)) + ((f) & 1) * 8192))
#define D2_VF(dst, slot, m) do { const lds_cptr _a = l3 + (slot) + vad[(m) & 3] + ((m) >> 2) * 4096; const s16x4 _lo = vtr(_a), _hh = vtr(_a + 2048); \
        dst = (bf16x8){_lo[0], _lo[1], _lo[2], _lo[3], _hh[0], _hh[1], _hh[2], _hh[3]}; } while (0)
    D2_WAIT_BAR(0);
    D2_KDMA(2, 2 * KSL); D2_VDMA(1, KSL);
    f32x16 pA0, pA1, pB0, pB1;
#define D2_EX0(v) (SHIFT ? __builtin_amdgcn_exp2f((v) - shift) : __builtin_amdgcn_exp2f(v))
#pragma unroll
    for (int d0 = 0; d0 < 4; ++d0) {
        pA0 = __builtin_amdgcn_mfma_f32_32x32x16_bf16(D2_KF(0, 2 * d0), qr[d0], d0 == 0 ? z16 : pA0, 0, 0, 0);
        pA1 = __builtin_amdgcn_mfma_f32_32x32x16_bf16(D2_KF(0, 2 * d0 + 1), qr[d0], d0 == 0 ? z16 : pA1, 0, 0, 0); }
#pragma unroll
    for (int r = 0; r < 16; ++r) { pA0[r] = D2_EX0(pA0[r]); pA1[r] = D2_EX0(pA1[r]); }
    int r0 = KSL, r1 = 2 * KSL, r2 = 0;
    u32x4 pw0, pw1, pw2, pw3; bf16x8 kfa, kfb, kfc, vfa, vfb, vfc;
#define D2_PK(P, B) cvtpk(P[B], P[(B) + 1])
#define D2_PA(k) __builtin_bit_cast(bf16x8, pw##k)
#define D2_EX(v) (SHIFT ? __builtin_amdgcn_exp2f((v) - shift) : __builtin_amdgcn_exp2f(v))
#define D2_GA(C, CIN, KC, QD, KN, NF, A0, A1, W0) do { C = __builtin_amdgcn_mfma_f32_32x32x16_bf16(KC, qr[QD], CIN, 0, 0, 0); if ((NF) < 8) KN = D2_KF(r0, NF); \
        sacc += A0; sacc += A1; W0; D2_SBAR(); } while (0)
#define D2_GB(M, VC, VN, NM, X0, X1, EXTRA) do { o[(M) & 3] = __builtin_amdgcn_mfma_f32_32x32x16_bf16(((M) >> 2) == 0 ? D2_PA(0) : ((M) >> 2) == 1 ? D2_PA(1) : ((M) >> 2) == 2 ? D2_PA(2) : D2_PA(3), VC, o[(M) & 3], 0, 0, 0); \
        if ((NM) < 16) D2_VF(VN, r2, NM); X0 = D2_EX(X0); X1 = D2_EX(X1); EXTRA; D2_SBAR(); } while (0)
#define D2_STEP(C0, C1, P0, P1, t, GK, GV, WN) do { \
        D2_WAIT_BAR(WN); \
        if (GK) D2_KDMA((t) + 2, r2); if (GV) D2_VDMA((t) + 1, r1); \
        kfa = D2_KF(r0, 0); kfb = D2_KF(r0, 1); kfc = D2_KF(r0, 2); D2_SBAR(); \
        float sacc = P0[0] + P0[1]; \
        D2_GA(C0, z16, kfa, 0, kfa, 3, P0[2],  P0[3],  pw0[0] = D2_PK(P0, 0)); \
        D2_GA(C1, z16, kfb, 0, kfb, 4, P0[4],  P0[5],  pw0[1] = D2_PK(P0, 2)); \
        D2_GA(C0, C0,  kfc, 1, kfc, 5, P0[6],  P0[7],  pw0[2] = D2_PK(P0, 4)); \
        D2_GA(C1, C1,  kfa, 1, kfa, 6, P0[8],  P0[9],  pw0[3] = D2_PK(P0, 6)); \
        D2_GA(C0, C0,  kfb, 2, kfb, 7, P0[10], P0[11], pw1[0] = D2_PK(P0, 8)); \
        D2_VF(vfa, r2, 0); \
        D2_GA(C1, C1,  kfc, 2, kfc, 8, P0[12], P0[13], pw1[1] = D2_PK(P0, 10)); \
        D2_VF(vfb, r2, 1); \
        D2_GA(C0, C0,  kfa, 3, kfa, 8, P0[14], P0[15], pw1[2] = D2_PK(P0, 12)); \
        D2_VF(vfc, r2, 2); \
        D2_GA(C1, C1,  kfb, 3, kfb, 8, P1[0],  P1[1],  pw1[3] = D2_PK(P0, 14)); \
        D2_GB(0,  vfa, vfa, 3,  C0[0],  C0[1],  (sacc += P1[2],  sacc += P1[3],  pw2[0] = D2_PK(P1, 0))); \
        D2_GB(1,  vfb, vfb, 4,  C0[2],  C0[3],  (sacc += P1[4],  sacc += P1[5],  pw2[1] = D2_PK(P1, 2))); \
        D2_GB(2,  vfc, vfc, 5,  C0[4],  C0[5],  (sacc += P1[6],  sacc += P1[7],  pw2[2] = D2_PK(P1, 4))); \
        D2_GB(3,  vfa, vfa, 6,  C0[6],  C0[7],  (sacc += P1[8],  sacc += P1[9],  pw2[3] = D2_PK(P1, 6))); \
        D2_GB(4,  vfb, vfb, 7,  C0[8],  C0[9],  (sacc += P1[10], sacc += P1[11], pw3[0] = D2_PK(P1, 8))); \
        D2_GB(5,  vfc, vfc, 8,  C0[10], C0[11], (sacc += P1[12], sacc += P1[13], pw3[1] = D2_PK(P1, 10))); \
        D2_GB(6,  vfa, vfa, 9,  C0[12], C0[13], (sacc += P1[14], sacc += P1[15], pw3[2] = D2_PK(P1, 12))); \
        D2_GB(7,  vfb, vfb, 10, C0[14], C0[15], (pw3[3] = D2_PK(P1, 14), l += sacc)); \
        D2_GB(8,  vfc, vfc, 11, C1[0],  C1[1],  (void)0);  D2_GB(9,  vfa, vfa, 12, C1[2],  C1[3],  (void)0);  D2_GB(10, vfb, vfb, 13, C1[4],  C1[5],  (void)0);  D2_GB(11, vfc, vfc, 14, C1[6],  C1[7],  (void)0); \
        D2_GB(12, vfa, vfa, 15, C1[8],  C1[9],  (void)0);  D2_GB(13, vfb, vfb, 16, C1[10], C1[11], (void)0); D2_GB(14, vfc, vfc, 16, C1[12], C1[13], (void)0); D2_GB(15, vfa, vfa, 16, C1[14], C1[15], (void)0); \
        { const int _t = r0; r0 = r1; r1 = r2; r2 = _t; } \
    } while (0)
    if (wid >= 4) __builtin_amdgcn_s_setprio(1);
    int t = 1;
    for (; t + 1 <= NT - 3; t += 2) {
        D2_STEP(pB0, pB1, pA0, pA1, t, true, true, 4);
        D2_STEP(pA0, pA1, pB0, pB1, t + 1, true, true, 4);
    }
    D2_STEP(pB0, pB1, pA0, pA1, NT - 3, true, true, 4);
    D2_STEP(pA0, pA1, pB0, pB1, NT - 2, false, true, 4);
    D2_STEP(pB0, pB1, pA0, pA1, NT - 1, false, false, 2);
    __builtin_amdgcn_s_setprio(0);
    D2_WAIT_BAR(0);
    { float sacc = 0.f;
#pragma unroll
      for (int r = 0; r < 16; ++r) sacc += pB0[r] + pB1[r];
      l += sacc;
      pw0 = (u32x4){D2_PK(pB0, 0), D2_PK(pB0, 2), D2_PK(pB0, 4), D2_PK(pB0, 6)}; pw1 = (u32x4){D2_PK(pB0, 8), D2_PK(pB0, 10), D2_PK(pB0, 12), D2_PK(pB0, 14)};
      pw2 = (u32x4){D2_PK(pB1, 0), D2_PK(pB1, 2), D2_PK(pB1, 4), D2_PK(pB1, 6)}; pw3 = (u32x4){D2_PK(pB1, 8), D2_PK(pB1, 10), D2_PK(pB1, 12), D2_PK(pB1, 14)};
#pragma unroll
      for (int m = 0; m < 16; ++m) { bf16x8 vf; D2_VF(vf, r2, m);
          o[m & 3] = __builtin_amdgcn_mfma_f32_32x32x16_bf16((m >> 2) == 0 ? D2_PA(0) : (m >> 2) == 1 ? D2_PA(1) : (m >> 2) == 2 ? D2_PA(2) : D2_PA(3), vf, o[m & 3], 0, 0, 0); } }
    { auto rr = __builtin_amdgcn_permlane32_swap(__float_as_uint(l), __float_as_uint(l), false, false); l = __uint_as_float(rr[0]) + __uint_as_float(rr[1]); }
    LAS float* wsf = (LAS float*)(lds + LDS_WS) + wid * 64;
    if (hi == 0) wsf[r32] = 1.0f / l;
    asm volatile("s_waitcnt lgkmcnt(0)" ::: "memory");
    float rli[16];
    { const LAS float* wb = wsf + 4 * hi;
#pragma unroll
      for (int r = 0; r < 16; ++r) rli[r] = wb[(r & 3) + 8 * (r >> 2)]; }
    D2_WAIT_BAR(0);
    LAS float* X = (LAS float*)lds + (size_t)(qi * 32 + 4 * hi) * XS + r32;
    if (br == 1) {
#pragma unroll
        for (int db = 0; db < 4; ++db)
#pragma unroll
            for (int r = 0; r < 16; ++r) X[((r & 3) + 8 * (r >> 2)) * XS + db * 32] = o[db][r] * rli[r];
    }
    D2_WAIT_BAR(0);
    if (br == 0) {
#pragma unroll
        for (int db = 0; db < 4; ++db)
#pragma unroll
            for (int r = 0; r < 16; ++r) { const int xi = ((r & 3) + 8 * (r >> 2)) * XS + db * 32; X[xi] = o[db][r] * rli[r] - lam * X[xi]; }
        asm volatile("s_waitcnt lgkmcnt(0)" ::: "memory");
        int lane_e = lane; asm volatile("" : "+v"(lane_e) : "v"(rli[0]));
        const int row = lane_e >> 1, half = lane_e & 1;
        const LAS float* Xr = (const LAS float*)lds + (size_t)(qi * 32 + row) * XS + half * 8;
        f32x4 v[8][2]; float ss = 0.f;
#pragma unroll
        for (int i = 0; i < 8; ++i)
#pragma unroll
            for (int c = 0; c < 2; ++c) { v[i][c] = *(const LAS f32x4*)(Xr + i * 16 + c * 4); ss += (v[i][c].x * v[i][c].x + v[i][c].y * v[i][c].y) + (v[i][c].z * v[i][c].z + v[i][c].w * v[i][c].w); }
        ss += __shfl_xor(ss, 1);
        const float rstd = 0.8f / sqrtf(ss * (1.f / 128.f) + EPS);
        bf16* dst = OA + (qrow0 + row) * D + h * 128 + half * 8;
        const float* sg = subln + half * 8;
#pragma unroll
        for (int i = 0; i < 8; ++i) { const f32x4 g0 = *(const f32x4*)(sg + i * 16), g1 = *(const f32x4*)(sg + i * 16 + 4);
            u32x4 w; w.x = cvtpk(v[i][0].x * rstd * g0.x, v[i][0].y * rstd * g0.y); w.y = cvtpk(v[i][0].z * rstd * g0.z, v[i][0].w * rstd * g0.w);
            w.z = cvtpk(v[i][1].x * rstd * g1.x, v[i][1].y * rstd * g1.y); w.w = cvtpk(v[i][1].z * rstd * g1.z, v[i][1].w * rstd * g1.w);
            *(GAS u32x4*)(dst + i * 16) = w; }
    }
    D2_WAIT_BAR(0);
#undef D2_KDMA
#undef D2_VDMA
#undef D2_KF
#undef D2_VF
#undef D2_PK
#undef D2_PA
#undef D2_EX
#undef D2_GA
#undef D2_GB
#undef D2_STEP
#undef D2_EX0
}
}

__device__ __forceinline__ void p2a_diffattn_mfma(Frame& F, bf16* OA) {
    bf16* QA = (bf16*)(F.ws + WS_QA); const bf16* KA = (const bf16*)(F.ws + WS_KA); const bf16* VA = (const bf16*)(F.ws + WS_VA);
    const float lam = lam_value(F); const float mb = qk_bound(F.inp(9), F.inp(10));
    constexpr int NU = NB * NH * (SEQ / 128);
    for (int i = 0; ; ++i) {
        int bh, qt;
        if (F.G == 256) { if (i >= 8) break; const int x = F.bid & 7, j = F.bid >> 3; bh = x + 8 * (i >> 1); qt = (i & 1) * 32 + j; }
        else { const int u = F.bid + i * F.G; if (u >= NU) break; bh = u / (SEQ / 128); qt = u % (SEQ / 128); }
        if (mb < 100.f) dattn2::unit<false>(bh / NH, bh % NH, qt, QA, OA, KA, VA, F.lds, lam, 0.f, F.inp(15));
        else dattn2::unit<true>(bh / NH, bh % NH, qt, QA, OA, KA, VA, F.lds, lam, mb, F.inp(15));
    }
}


namespace nattn {
using dattn::bf16x8; using dattn::s16x4; using dattn::f32x16; using dattn::lds_cptr; using dattn::crow; using dattn::glds16; using dattn::cvtpk; using dattn::vtr;
__device__ __forceinline__ void unit(int b, int r, const bf16* QB, bf16* OB, const bf16* KB, const bf16* VB, LAS unsigned char* lds, float mb) {
    const int tid = threadIdx.x, lane = tid & 63, r32 = lane & 31, hi = lane >> 5; const int h = __builtin_amdgcn_readfirstlane(tid >> 6);
    const size_t qrow0 = (size_t)b * SEQ + r * GRIDW;
    const unsigned lds0 = (unsigned)(uintptr_t)lds;
    LAS unsigned char* vbuf = lds + h * 16384;
    const LAS float* BL = (const LAS float*)(lds + 131072 + h * 2048);
    LAS float* wsf = (LAS float*)(lds + 147456) + h * 128;
    int r0 = r - 4; r0 = r0 < 0 ? 0 : (r0 > NROWS - 8 ? NROWS - 8 : r0);
    bf16x8 qr[2][4];
#pragma unroll
    for (int qb = 0; qb < 2; ++qb)
#pragma unroll
        for (int d0 = 0; d0 < 4; ++d0) qr[qb][d0] = *(const bf16x8*)(QB + (qrow0 + qb * 32 + r32) * 512 + h * 64 + d0 * 16 + hi * 8);
    f32x16 o[2][2];
#pragma unroll
    for (int i = 0; i < 2; ++i)
#pragma unroll
        for (int j = 0; j < 2; ++j) o[i][j] = f32x16{};
    const f32x16 zero16 = f32x16{};
    float l[2] = {0.f, 0.f};
    const bf16* vsrc0 = VB + (size_t)(lane >> 2) * 512 + h * 64 + (lane & 3) * 8;
    const lds_cptr vp0 = (lds_cptr)vbuf + ((lane >> 4) & 1) * 32 + (lane & 3) * 8 + (4 * hi + ((lane & 15) >> 2)) * 64;
#define NA_KROW(t) ((size_t)b * KVL + ((t) < 8 ? CTX + (r0 + (t)) * GRIDW : ((t) - 8) * 64))
#define NA_DMA(t) do { const bf16* _s = vsrc0 + NA_KROW(t) * 512; const unsigned _d = lds0 + h * 16384 + ((t) & 1) * 8192; \
        _Pragma("unroll") for (int _db = 0; _db < 2; ++_db) _Pragma("unroll") for (int _rc = 0; _rc < 4; ++_rc) \
            glds16(_s + (size_t)_rc * 16 * 512 + _db * 32, (unsigned)__builtin_amdgcn_readfirstlane(_d + _db * 4096 + _rc * 1024)); } while (0)
    NA_DMA(0);
#pragma unroll 1
    for (int t = 0; t < 12; ++t) {
        const bf16* kbase = KB + (NA_KROW(t) + r32) * 512 + h * 64 + hi * 8;
        bf16x8 kf[2][4];
#pragma unroll
        for (int kh = 0; kh < 2; ++kh)
#pragma unroll
            for (int d0 = 0; d0 < 4; ++d0) kf[kh][d0] = *(const bf16x8*)(kbase + (size_t)kh * 32 * 512 + d0 * 16);
        if (t + 1 < 12) { NA_DMA(t + 1); asm volatile("s_waitcnt vmcnt(8)" ::: "memory"); } else asm volatile("s_waitcnt vmcnt(0)" ::: "memory");
        const lds_cptr vp = vp0 + (t & 1) * 8192;
#pragma unroll
        for (int qb = 0; qb < 2; ++qb) {
            f32x16 p0, p1;
#pragma unroll
            for (int d0 = 0; d0 < 4; ++d0) {
                p0 = __builtin_amdgcn_mfma_f32_32x32x16_bf16(kf[0][d0], qr[qb][d0], d0 == 0 ? zero16 : p0, 0, 0, 0);
                p1 = __builtin_amdgcn_mfma_f32_32x32x16_bf16(kf[1][d0], qr[qb][d0], d0 == 0 ? zero16 : p1, 0, 0, 0);
            }
            if (t < 8) {
                const int w = qb * 32 + r32; int c0 = w - 8; c0 = c0 < 0 ? 0 : (c0 > GRIDW - 16 ? GRIDW - 16 : c0);
                const LAS float* brow = BL + (r0 + t - r + 7) * 31 + (15 - w) + 4 * hi;
#pragma unroll
                for (int i = 0; i < 16; ++i) { const int kcc = (i & 3) + 8 * (i >> 2); const int kc = kcc + 4 * hi, kc1 = kc + 32;
                    const bool v0 = (kc >= c0) && (kc < c0 + 16), v1 = (kc1 >= c0) && (kc1 < c0 + 16);
                    const float b0 = brow[kcc], b1 = brow[kcc + 32];
                    p0[i] = v0 ? p0[i] + b0 : -1.0e30f; p1[i] = v1 ? p1[i] + b1 : -1.0e30f; }
            }
            float sacc = 0.f;
#pragma unroll
            for (int i = 0; i < 16; ++i) { p0[i] = __builtin_amdgcn_exp2f(p0[i] - mb); p1[i] = __builtin_amdgcn_exp2f(p1[i] - mb); sacc += p0[i] + p1[i]; }
            l[qb] += sacc;
            u32x4 pw[4];
#pragma unroll
            for (int s2 = 0; s2 < 2; ++s2) {
                pw[s2]     = (u32x4){cvtpk(p0[8 * s2], p0[8 * s2 + 1]), cvtpk(p0[8 * s2 + 2], p0[8 * s2 + 3]), cvtpk(p0[8 * s2 + 4], p0[8 * s2 + 5]), cvtpk(p0[8 * s2 + 6], p0[8 * s2 + 7])};
                pw[2 + s2] = (u32x4){cvtpk(p1[8 * s2], p1[8 * s2 + 1]), cvtpk(p1[8 * s2 + 2], p1[8 * s2 + 3]), cvtpk(p1[8 * s2 + 4], p1[8 * s2 + 5]), cvtpk(p1[8 * s2 + 6], p1[8 * s2 + 7])};
            }
#pragma unroll
            for (int ks = 0; ks < 4; ++ks)
#pragma unroll
                for (int db = 0; db < 2; ++db) {
                    const s16x4 lo = vtr(vp + db * 4096 + ks * 1024), hh = vtr(vp + db * 4096 + ks * 1024 + 512);
                    const bf16x8 vf = (bf16x8){lo[0], lo[1], lo[2], lo[3], hh[0], hh[1], hh[2], hh[3]};
                    o[qb][db] = __builtin_amdgcn_mfma_f32_32x32x16_bf16(__builtin_bit_cast(bf16x8, pw[ks]), vf, o[qb][db], 0, 0, 0);
                }
            asm volatile("" ::: "memory");
        }
    }
#pragma unroll
    for (int qb = 0; qb < 2; ++qb) { auto rr = __builtin_amdgcn_permlane32_swap(__float_as_uint(l[qb]), __float_as_uint(l[qb]), false, false); l[qb] = __uint_as_float(rr[0]) + __uint_as_float(rr[1]);
        if (hi == 0) wsf[qb * 32 + r32] = 1.0f / l[qb]; }
    asm volatile("s_waitcnt lgkmcnt(0)" ::: "memory");
    LAS bf16* stg = (LAS bf16*)vbuf;
    { LAS bf16* sb = stg + (4 * hi) * 64 + r32; const LAS float* wb = wsf + 4 * hi;
#pragma unroll
      for (int qb = 0; qb < 2; ++qb)
#pragma unroll
          for (int i = 0; i < 16; ++i) { const int qc = qb * 32 + (i & 3) + 8 * (i >> 2); const float rl = wb[qc];
#pragma unroll
              for (int db = 0; db < 2; ++db) sb[qc * 64 + db * 32] = (bf16)f2bf(o[qb][db][i] * rl); } }
    asm volatile("s_waitcnt lgkmcnt(0)" ::: "memory");
#pragma unroll
    for (int i = 0; i < 8; ++i) { const int row = i * 8 + (lane >> 3), ch = lane & 7; const u32x4 v = *(const LAS u32x4*)(stg + row * 64 + ch * 8);
        *(GAS u32x4*)(OB + (qrow0 + row) * 512 + h * 64 + ch * 8) = v; }
    asm volatile("s_waitcnt vmcnt(0) lgkmcnt(0)" ::: "memory");
#undef NA_DMA
#undef NA_KROW
}
}
__device__ __forceinline__ void p2b_natten_mfma(Frame& F, bf16* OB) {
    bf16* QB = (bf16*)(F.ws + WS_QB); const bf16* KB = (const bf16*)(F.ws + WS_KB); const bf16* VB = (const bf16*)(F.ws + WS_VB);
    const float* bias = F.inp(18);
    float bm = 0.f; for (int i = F.lane; i < NH * 15 * 31; i += 64) bm = fmaxf(bm, fabsf(bias[i]));
#pragma unroll
    for (int o = 1; o < 64; o <<= 1) bm = fmaxf(bm, __shfl_xor(bm, o));
    const float mb = qk_bound(F.inp(16), F.inp(17)) + bm * LOG2E;
    LAS float* BL = (LAS float*)(F.lds + 131072);
    for (int i = F.tid; i < NH * 512; i += NTHR) { const int h = i >> 9, e = i & 511; BL[i] = e < 465 ? bias[h * 465 + e] * LOG2E : 0.f; }
    __syncthreads();
#if defined(PROBE_NA2)
    for (int u = F.bid; u < 2 * NB * NROWS; u += F.G) { const int uu = u % (NB * NROWS); nattn::unit(uu / NROWS, uu % NROWS, QB, u < NB * NROWS ? (bf16*)(F.ws + WS_XN) : OB, KB, VB, F.lds, mb); }
#else
    for (int u = F.bid; u < NB * NROWS; u += F.G) nattn::unit(u / NROWS, u % NROWS, QB, OB, KB, VB, F.lds, mb);
#endif
    __syncthreads();
}

struct EpiMergeA {
    static constexpr bool PERM = true; const bf16* GA; bf16* Y;
    __device__ __forceinline__ void operator()(const f32x4 (&acc)[2][2][4][2], const pg8::Unit& u, int wr, int wc, int fr_, int fq_) const {
        int fr = fr_, fq = fq_; asm volatile("" : "+v"(fr), "+v"(fq));
#pragma unroll
        for (int ai = 0; ai < 2; ++ai)
#pragma unroll
            for (int m = 0; m < 4; ++m) { const size_t ro = (size_t)(u.pm * 256 + ai * 128 + wr * 64 + m * 16 + fr) * D + u.pn * 256 + wc * 32 + 8 * fq;
#pragma unroll
                for (int bj = 0; bj < 2; ++bj) { const u32x4 gv = *(const GAS u32x4*)(GA + ro + bj * 128); const f32x4 a = acc[ai][bj][m][0], b = acc[ai][bj][m][1];
                    u32x4 w; w.x = pg8::cvt_pk_bf16(bf2f(gv.x & 0xffffu) * a.x, bf2f(gv.x >> 16) * a.y); w.y = pg8::cvt_pk_bf16(bf2f(gv.y & 0xffffu) * a.z, bf2f(gv.y >> 16) * a.w);
                    w.z = pg8::cvt_pk_bf16(bf2f(gv.z & 0xffffu) * b.x, bf2f(gv.z >> 16) * b.y); w.w = pg8::cvt_pk_bf16(bf2f(gv.w & 0xffffu) * b.z, bf2f(gv.w >> 16) * b.w);
                    *(GAS u32x4*)(Y + ro + bj * 128) = w; } }
    }
};
struct EpiMergeB {
    static constexpr bool PERM = true; const bf16* GB; bf16* Y;
    __device__ __forceinline__ void operator()(const f32x4 (&acc)[2][2][4][2], const pg8::Unit& u, int wr, int wc, int fr_, int fq_) const {
        int fr = fr_, fq = fq_; asm volatile("" : "+v"(fr), "+v"(fq));
#pragma unroll
        for (int ai = 0; ai < 2; ++ai)
#pragma unroll
            for (int m = 0; m < 4; ++m) { const size_t ro = (size_t)(u.pm * 256 + ai * 128 + wr * 64 + m * 16 + fr) * D + u.pn * 256 + wc * 32 + 8 * fq;
#pragma unroll
                for (int bj = 0; bj < 2; ++bj) { const u32x4 gv = *(const GAS u32x4*)(GB + ro + bj * 128); const u32x4 yv = *(const GAS u32x4*)(Y + ro + bj * 128); const f32x4 a = acc[ai][bj][m][0], b = acc[ai][bj][m][1];
                    u32x4 w; w.x = pg8::cvt_pk_bf16(bf2f(yv.x & 0xffffu) + bf2f(gv.x & 0xffffu) * a.x, bf2f(yv.x >> 16) + bf2f(gv.x >> 16) * a.y);
                    w.y = pg8::cvt_pk_bf16(bf2f(yv.y & 0xffffu) + bf2f(gv.y & 0xffffu) * a.z, bf2f(yv.y >> 16) + bf2f(gv.y >> 16) * a.w);
                    w.z = pg8::cvt_pk_bf16(bf2f(yv.z & 0xffffu) + bf2f(gv.z & 0xffffu) * b.x, bf2f(yv.z >> 16) + bf2f(gv.z >> 16) * b.y);
                    w.w = pg8::cvt_pk_bf16(bf2f(yv.w & 0xffffu) + bf2f(gv.w & 0xffffu) * b.z, bf2f(yv.w >> 16) + bf2f(gv.w >> 16) * b.w);
                    *(GAS u32x4*)(Y + ro + bj * 128) = w; } }
    }
};
struct EpiOut {
    static constexpr bool PERM = false; const float* x; const float* MOD; float* XMID;
    __device__ __forceinline__ void operator()(const f32x4 (&acc)[2][2][4][2], const pg8::Unit& u, int wr, int wc, int fr_, int fq_) const {
        int fr = fr_, fq = fq_; asm volatile("" : "+v"(fr), "+v"(fq));
        const int b = (u.pm * 256) / SEQ; const int col0 = u.pn * 256 + wc * 32 + 4 * fq;
        f32x4 g[2][2];
#pragma unroll
        for (int bj = 0; bj < 2; ++bj)
#pragma unroll
            for (int n = 0; n < 2; ++n) g[bj][n] = *(const f32x4*)(MOD + b * 6144 + 2048 + col0 + bj * 128 + n * 16);
#pragma unroll
        for (int ai = 0; ai < 2; ++ai)
#pragma unroll
            for (int m = 0; m < 4; ++m) { const size_t ro = (size_t)(u.pm * 256 + ai * 128 + wr * 64 + m * 16 + fr) * D + col0;
#pragma unroll
                for (int bj = 0; bj < 2; ++bj)
#pragma unroll
                    for (int n = 0; n < 2; ++n) { const f32x4 xv = *(const f32x4*)(x + ro + bj * 128 + n * 16); *(f32x4*)(XMID + ro + bj * 128 + n * 16) = xv + g[bj][n] * acc[ai][bj][m][n]; } }
    }
};
__device__ __forceinline__ void p3_merge_out_mfma(Frame& F, int part) {
    bf16* Y = (bf16*)(F.ws + WS_Y); const bf16* GA = (const bf16*)F.out;
    if (part == 0) {
        { pg8::Gemm g{(const bf16*)(F.ws + WS_QA), (const bf16*)(F.ws + WS_WA), D, D, D}; pg8::DenseOrder S; S.init(T, D, F.G, F.bid, D); EpiMergeA E{GA, Y}; pg8::gemm_phase<EpiMergeA, pg8::DenseOrder>(F.lds, g, S, E); }
        asm volatile("s_waitcnt vmcnt(0)" ::: "memory"); __syncthreads();
        { pg8::Gemm g{(const bf16*)(F.ws + WS_QB), (const bf16*)(F.ws + WS_WB), 512, 512, 512}; pg8::DenseOrder S; S.init(T, D, F.G, F.bid, 512); EpiMergeB E{GA + (size_t)T * D, Y}; pg8::gemm_phase<EpiMergeB, pg8::DenseOrder>(F.lds, g, S, E); }
    } else {
        pg8::Gemm g{Y, (const bf16*)(F.ws + WS_WO), D, D, D}; pg8::DenseOrder S; S.init(T, D, F.G, F.bid, D);
        EpiOut E{F.inp(0), (const float*)(F.ws + WS_MOD), (float*)(F.ws + WS_XMID)}; pg8::gemm_phase<EpiOut, pg8::DenseOrder>(F.lds, g, S, E);
    }
}

constexpr int MOE_TAB_OFF = 132096;
struct MoeTab { LAS int* cnt; LAS int* tpre; LAS int* tgrp; };
__device__ __forceinline__ MoeTab moe_tables(Frame& F) {
    MoeTab G; G.cnt = (LAS int*)(F.lds + MOE_TAB_OFF); G.tpre = G.cnt + 64; G.tgrp = G.tpre + 65;
    __syncthreads();
    if (F.tid < 64) {
        const int c = (int)__hip_atomic_load(F.ctl + CW_CNT + 64 * F.tid, __ATOMIC_RELAXED, __HIP_MEMORY_SCOPE_AGENT);
        const int nt = (c + 255) >> 8; int inc = nt;
#pragma unroll
        for (int o = 1; o < 64; o <<= 1) { const int v = __shfl_up(inc, o); if (F.lane >= o) inc += v; }
        G.cnt[F.tid] = c; G.tpre[F.tid] = inc - nt; if (F.tid == 63) G.tpre[64] = inc;
        for (int i = 0; i < nt; ++i) G.tgrp[inc - nt + i] = F.tid;
    }
    __syncthreads();
    return G;
}
struct MoeOrder {
    MoeTab G; int t_lo, t_hi, Gn, c; const i32x2* LIST; int ldb; bool gather;
    __device__ __forceinline__ bool next(int i, pg8::Unit& u) const {
        const long L = (long)i * Gn + c; const int tile = t_lo + (int)(L >> 2); if (tile >= t_hi) return false;
        const int g = G.tgrp[tile];
        u.pm = tile - G.tpre[g]; u.pn = (int)(L & 3); u.a0 = g; u.a1 = tile * 256; return true;
    }
    __device__ __forceinline__ int arow(const pg8::Unit& u, int r) const {
        if (!gather) return u.a1 + r;
        const int idx = u.pm * 256 + r; const int cnt = G.cnt[u.a0]; return LIST[(size_t)u.a0 * T + (idx < cnt ? idx : 0)].x;
    }
    __device__ __forceinline__ size_t boff(const pg8::Unit& u) const { return ((size_t)(u.a0 & 31) * 1024 + (size_t)u.pn * 256) * ldb; }
};
struct EpiGateUp {
    static constexpr bool PERM = true; bf16* HID;
    __device__ __forceinline__ void operator()(const f32x4 (&acc)[2][2][4][2], const pg8::Unit& u, int wr, int wc, int fr_, int fq_) const {
        int fr = fr_, fq = fq_; asm volatile("" : "+v"(fr), "+v"(fq));
#pragma unroll
        for (int ai = 0; ai < 2; ++ai)
#pragma unroll
            for (int m = 0; m < 4; ++m) { const size_t ro = (size_t)(u.a1 + ai * 128 + wr * 64 + m * 16 + fr) * EH + u.pn * 128 + wc * 32 + 8 * fq;
                const f32x4 ga = acc[ai][0][m][0], gb = acc[ai][0][m][1], ua = acc[ai][1][m][0], ub = acc[ai][1][m][1];
                u32x4 w; w.x = pg8::cvt_pk_bf16(silu_f(ga.x) * ua.x, silu_f(ga.y) * ua.y); w.y = pg8::cvt_pk_bf16(silu_f(ga.z) * ua.z, silu_f(ga.w) * ua.w);
                w.z = pg8::cvt_pk_bf16(silu_f(gb.x) * ub.x, silu_f(gb.y) * ub.y); w.w = pg8::cvt_pk_bf16(silu_f(gb.z) * ub.z, silu_f(gb.w) * ub.w);
                *(GAS u32x4*)(HID + ro) = w; }
    }
};
struct EpiDown {
    static constexpr bool PERM = false; MoeTab G; const i32x2* LIST; const LAS float* GA2; const float* base; float* out;
    __device__ __forceinline__ void operator()(const f32x4 (&acc)[2][2][4][2], const pg8::Unit& u, int wr, int wc, int fr_, int fq_) const {
        int fr = fr_, fq = fq_; asm volatile("" : "+v"(fr), "+v"(fq));
        const int cnt = G.cnt[u.a0]; const int col0 = u.pn * 256 + wc * 32 + 4 * fq;
        const i32x2* lst = LIST + (size_t)u.a0 * T;
        const int idx0 = u.pm * 256 + wr * 64 + fr;
        i32x2 tw[2][4];
#pragma unroll
        for (int ai = 0; ai < 2; ++ai)
#pragma unroll
            for (int m = 0; m < 4; ++m) { const int idx = idx0 + ai * 128 + m * 16; tw[ai][m] = lst[idx < cnt ? idx : 0]; }
#pragma unroll
        for (int ai = 0; ai < 2; ++ai) {
            f32x4 bv[4][2][2];
#pragma unroll
            for (int m = 0; m < 4; ++m) { const size_t ro = (size_t)tw[ai][m].x * D + col0;
#pragma unroll
                for (int bj = 0; bj < 2; ++bj)
#pragma unroll
                    for (int n = 0; n < 2; ++n) bv[m][bj][n] = *(const f32x4*)(base + ro + bj * 128 + n * 16); }
#pragma unroll
            for (int m = 0; m < 4; ++m) { const int idx = idx0 + ai * 128 + m * 16; const int tok = tw[ai][m].x; const float w = __uint_as_float((unsigned)tw[ai][m].y);
                const LAS float* g2 = GA2 + (tok / SEQ) * 1024 + col0; const size_t ro = (size_t)tok * D + col0;
                if (idx < cnt) {
#pragma unroll
                    for (int bj = 0; bj < 2; ++bj)
#pragma unroll
                        for (int n = 0; n < 2; ++n) { const f32x4 gv = *(const LAS f32x4*)(g2 + bj * 128 + n * 16); *(f32x4*)(out + ro + bj * 128 + n * 16) = bv[m][bj][n] + gv * w * acc[ai][bj][m][n]; } } }
        }
    }
};
__device__ __forceinline__ void p4_moe_mfma(Frame& F, int part) {
    const MoeTab G = moe_tables(F); const i32x2* LIST = (const i32x2*)(F.ws + WS_LIST);
    if (part == 0) {
        pg8::Gemm g{(const bf16*)(F.ws + WS_H2), (const bf16*)(F.ws + WS_WGU), D, D, D};
        MoeOrder S{G, 0, G.tpre[64], F.G, F.bid, LIST, D, true}; EpiGateUp E{(bf16*)(F.ws + WS_HID)};
        pg8::gemm_phase<EpiGateUp, MoeOrder>(F.lds, g, S, E);
    } else {
        const int kk = part - 1;
        pg8::Gemm g{(const bf16*)(F.ws + WS_HID), (const bf16*)(F.ws + WS_WD), EH, EH, EH};
        MoeOrder S{G, G.tpre[32 * kk], G.tpre[32 * kk + 32], F.G, F.bid, LIST, EH, false};
        LAS float* GA2 = (LAS float*)(F.lds + MOE_TAB_OFF + 2048);
        { const float* MOD = (const float*)(F.ws + WS_MOD); for (int i = F.tid; i < 4096; i += NTHR) GA2[i] = MOD[(i >> 10) * 6144 + 5120 + (i & 1023)]; }
        __syncthreads();
        EpiDown E{G, LIST, GA2, kk == 0 ? (const float*)(F.ws + WS_XMID) : (const float*)F.out, F.out};
        pg8::gemm_phase<EpiDown, MoeOrder>(F.lds, g, S, E);
    }
}

constexpr int NPHASE = 10;
__global__ void __launch_bounds__(NTHR, 2) mk_fwd(Args args) {
    extern __shared__ __attribute__((aligned(16))) unsigned char lds[];
    Frame F;
    F.lds = (LAS unsigned char*)lds; F.ws = args.ws; F.ctl = (gu32*)(args.ws + WS_CTL);
    F.tid = threadIdx.x; F.lane = F.tid & 63; F.wave = __builtin_amdgcn_readfirstlane(F.tid >> 6); F.G = gridDim.x; F.bid = blockIdx.x;
    F.ka = (const __attribute__((address_space(4))) unsigned char*)__builtin_amdgcn_kernarg_segment_ptr();
    F.out = args.out;
    volatile LAS unsigned* MISC = (volatile LAS unsigned*)(F.lds + LDS_BYTES - 64);
    if (F.tid < 16) MISC[F.tid] = 0u;
    __syncthreads();
    XcdBarrier bar; bar.bar = (unsigned*)(F.ctl + CW_BAR); bar.x = 0; bar.st = nullptr;
    if (MK_N_LAUNCHES == 1) bar = xcd_barrier_post((unsigned*)(F.ctl + CW_BAR), MISC);
    const int lo = args.ph_lo, hi = args.ph_hi;
#ifndef PH_MASK
#define PH_MASK 0x3ff
#endif
#define IN(k) (((PH_MASK >> (k)) & 1) && lo <= (k) && (k) < hi)
#define SEAM(k) do { if (IN(k) && IN((k) + 1)) xcd_barrier(bar); { int t_ = threadIdx.x; asm volatile("" : "+v"(t_)); F.tid = t_; F.lane = t_ & 63; } } while (0)
    if (IN(0)) { p0_adaln_rope(F); p0_weights(F); }
    SEAM(0);
    if (IN(1)) p1a_norm1(F);
    SEAM(1);
    if (IN(2)) p1b_inproj_mfma(F);
    SEAM(2);
    if (IN(3)) { p2a_diffattn_mfma(F, (bf16*)(F.ws + WS_QA)); p2b_natten_mfma(F, (bf16*)(F.ws + WS_QB)); }
    SEAM(3);
    if (IN(4)) p3_merge_out_mfma(F, 0);
    SEAM(4);
    if (IN(5)) p3_merge_out_mfma(F, 1);
    SEAM(5);
    if (IN(6)) p4a_norm2_route(F);
    SEAM(6);
    if (IN(7)) p4_moe_mfma(F, 0);
    SEAM(7);
    if (IN(8)) p4_moe_mfma(F, 1);
    SEAM(8);
    if (IN(9)) p4_moe_mfma(F, 2);
#undef IN
#undef SEAM
}

extern "C" void kernel_launch(void* const* d_in, const int* in_sizes, int n_in, void* d_out, int out_size, void* d_ws, size_t ws_size, hipStream_t stream) {
    static int grid = 0;
    if (grid == 0) {
        if (n_in != 29 || out_size != T * D || ws_size < WS_END) { fprintf(stderr, "kernel_launch: unexpected shapes: n_in %d out %d ws %zu\n", n_in, out_size, ws_size); grid = -1; return; }
        int dev = 0, cus = 0, per_cu = 0;
        if (hipGetDevice(&dev) != hipSuccess || hipDeviceGetAttribute(&cus, hipDeviceAttributeMultiprocessorCount, dev) != hipSuccess) { grid = -1; return; }
        if (hipFuncSetAttribute((const void*)mk_fwd, hipFuncAttributeMaxDynamicSharedMemorySize, LDS_BYTES) != hipSuccess) { fprintf(stderr, "kernel_launch: hipFuncSetAttribute failed\n"); grid = -1; return; }
        if (hipOccupancyMaxActiveBlocksPerMultiprocessor(&per_cu, (const void*)mk_fwd, NTHR, LDS_BYTES) != hipSuccess || per_cu < 1) fprintf(stderr, "kernel_launch: occupancy query says %d\n", per_cu);
        (void)hipGetLastError();
        grid = cus;
    }
    if (grid < 0) return;
    if (hipMemsetAsync((char*)d_ws + WS_CTL, 0, CTL_ZERO_BYTES, stream) != hipSuccess) return;
    Args a{};
    for (int i = 0; i < 29; ++i) a.in[i] = (const float*)d_in[i];
    a.out = (float*)d_out; a.ws = (unsigned char*)d_ws;
    if (MK_N_LAUNCHES == 1) { a.ph_lo = 0; a.ph_hi = NPHASE; hipLaunchKernelGGL(mk_fwd, dim3(grid), dim3(NTHR), LDS_BYTES, stream, a); }
    else for (int p = 0; p < NPHASE; ++p) { a.ph_lo = p; a.ph_hi = p + 1; hipLaunchKernelGGL(mk_fwd, dim3(grid), dim3(NTHR), LDS_BYTES, stream, a); }
}
```

```cpp
#include <hip/hip_runtime.h>
#include <cstdio>
#include <cstdint>

#ifndef MK_N_LAUNCHES
#define MK_N_LAUNCHES 1
#endif

constexpr int NB = 4, SEQ = 8192, D = 1024, T = NB * SEQ, CTX = 256, TC = NB * CTX, MROWS = T + TC;
constexpr int KVL = CTX + SEQ;
constexpr int NIN = 6656, GRIDW = 64, NROWS = SEQ / GRIDW;
constexpr int NH = 8, HD = 64;
constexpr int NEXP = 32, EH = 512, NGRP = 4, EPG = 8;
constexpr int NLIST = 64;
constexpr float EPS = 1e-6f;
constexpr float LOG2E = 1.4426950408889634f;
constexpr float C2 = 0.125f * LOG2E;

constexpr size_t MiB = 1u << 20;
constexpr size_t WS_CTL = 0, CTL_ZERO_BYTES = 1 * MiB;
constexpr size_t WS_MOD = 1 * MiB;
constexpr size_t WS_ROPE = 1 * MiB + 256 * 1024;
constexpr size_t WS_LIST = 488 * MiB;
constexpr size_t WS_WIN = 12 * MiB;
constexpr size_t WS_WA = 25 * MiB, WS_WB = 27 * MiB, WS_WO = 28 * MiB;
constexpr size_t WS_WGU = 30 * MiB;
constexpr size_t WS_WD = 94 * MiB;
constexpr size_t WS_XN = 126 * MiB;
constexpr size_t WS_QA = 192 * MiB;
constexpr size_t WS_QB = 256 * MiB;
constexpr size_t WS_KA = 288 * MiB;
constexpr size_t WS_VA = 354 * MiB;
constexpr size_t WS_KB = 420 * MiB;
constexpr size_t WS_VB = 453 * MiB;
constexpr size_t WS_END = 504 * MiB;
constexpr size_t WS_Y = WS_XN, WS_H2 = WS_XN, WS_HID = WS_QA, WS_XMID = WS_KA;
constexpr int CW_TMO = 0, CW_BAR = 4096, CW_CNT = 16384;

constexpr int LDS_BYTES = 155648;
constexpr int NTHR = 512;

#define GAS __attribute__((address_space(1)))
#define LAS __attribute__((address_space(3)))
typedef unsigned short bf16;
typedef float f32x4 __attribute__((ext_vector_type(4)));
typedef float f32x2 __attribute__((ext_vector_type(2)));
typedef unsigned u32x4 __attribute__((ext_vector_type(4)));
typedef unsigned u32x2 __attribute__((ext_vector_type(2)));
typedef GAS unsigned gu32;

__device__ __forceinline__ unsigned f2bf(float f) { unsigned u = __builtin_bit_cast(unsigned, f); return (u + 0x7fffu + ((u >> 16) & 1u)) >> 16; }
__device__ __forceinline__ float bf2f(unsigned h) { return __builtin_bit_cast(float, h << 16); }
__device__ __forceinline__ float rbf(float f) { return bf2f(f2bf(f)); }
__device__ __forceinline__ unsigned pk2(float lo, float hi) { return f2bf(lo) | (f2bf(hi) << 16); }

#define XB_TMO      128
#define XB_XCNT(j)  (256  + 64 * (j))
#define XB_XSUB(j)  (1280 + 64 * (j))
#define XB_XGEN(j)  (2304 + 64 * (j))
#define XB_TOP      3328
#define XB_TOPGEN   3392
#define XCD_BAR_WORDS 3456
#define XB_SPIN_CAP (1u << 18)
__device__ __forceinline__ unsigned xb_ld(unsigned* p)              { return __hip_atomic_load(p, __ATOMIC_RELAXED, __HIP_MEMORY_SCOPE_AGENT); }
__device__ __forceinline__ unsigned xb_add(unsigned* p, unsigned v) { return __hip_atomic_fetch_add(p, v, __ATOMIC_RELAXED, __HIP_MEMORY_SCOPE_AGENT); }
__device__ __forceinline__ unsigned xb_xcc_id() { return (unsigned)__builtin_amdgcn_s_getreg((3 << 11) | 20) & 0xFu; }
#define XB_SPIN(cond, bar) do { unsigned _sp = 0; while (cond) { __builtin_amdgcn_s_sleep(1); \
    if ((++_sp & 255u) == 0u) { if (xb_ld(&(bar)[XB_TMO])) break; if (_sp > XB_SPIN_CAP) { atomicAdd(&(bar)[XB_TMO], 1u); break; } } } } while (0)
struct XcdBarrier { unsigned* bar; unsigned x; volatile LAS unsigned* st; };
__device__ __forceinline__ XcdBarrier xcd_barrier_post(unsigned* bar, volatile LAS unsigned* st) {
    XcdBarrier b; b.bar = bar; b.x = xb_xcc_id(); b.st = st;
    if (threadIdx.x == 0) (void)xb_add(&bar[XB_XCNT(b.x)], 1u);
    return b;
}
__device__ __forceinline__ void xcd_barrier_complete(unsigned* bar, unsigned x, unsigned& nloc, unsigned& nx) {
    const unsigned G = gridDim.x * gridDim.y * gridDim.z;
    unsigned sum, cnt, mine, sp = 0u;
    for (;;) {
        sum = 0u; cnt = 0u; mine = 0u;
#pragma unroll
        for (unsigned j = 0; j < 16; ++j) { const unsigned c = xb_ld(&bar[XB_XCNT(j)]); sum += c; cnt += (c > 0u) ? 1u : 0u; mine = (j == x) ? c : mine; }
        if (sum == G) break;
        __builtin_amdgcn_s_sleep(1);
        if ((++sp & 255u) == 0u) { if (xb_ld(&bar[XB_TMO])) break; if (sp > XB_SPIN_CAP) { atomicAdd(&bar[XB_TMO], 1u); break; } }
    }
    nloc = mine > 0u ? mine : 1u; nx = cnt > 0u ? cnt : 1u;
}
__device__ __forceinline__ void xcd_barrier(const XcdBarrier& b) {
    asm volatile("s_waitcnt vmcnt(0)" ::: "memory");
    __syncthreads();
    if (threadIdx.x == 0) {
        unsigned* bar = b.bar;
        __builtin_amdgcn_s_waitcnt(0);
        unsigned nloc = b.st[0], nx = b.st[1];
        if (nloc == 0u) { xcd_barrier_complete(bar, b.x, nloc, nx); b.st[0] = nloc; b.st[1] = nx; }
        const unsigned old = xb_add(&bar[XB_XSUB(b.x)], 1u);
        const unsigned gen = old / nloc;
        if (old + 1u == (gen + 1u) * nloc) {
            __builtin_amdgcn_fence(__ATOMIC_RELEASE, "agent");
            asm volatile("s_waitcnt vmcnt(0)" ::: "memory");
            const unsigned og = xb_add(&bar[XB_TOP], 1u);
            const unsigned tg = og / nx;
            if (og + 1u == (tg + 1u) * nx) xb_add(&bar[XB_TOPGEN], 1u);
            else XB_SPIN(xb_ld(&bar[XB_TOPGEN]) == tg, bar);
            __builtin_amdgcn_fence(__ATOMIC_ACQUIRE, "agent");
            xb_add(&bar[XB_XGEN(b.x)], 1u);
            asm volatile("s_waitcnt vmcnt(0)" ::: "memory");
        } else {
            XB_SPIN(xb_ld(&bar[XB_XGEN(b.x)]) == gen, bar);
            __builtin_amdgcn_fence(__ATOMIC_ACQUIRE, "agent");
            asm volatile("s_waitcnt vmcnt(0)" ::: "memory");
        }
    }
    __syncthreads();
}

namespace pg8 {
#define PG8_LAS __attribute__((address_space(3)))
typedef unsigned short bf16_t;
typedef short bf16x8 __attribute__((ext_vector_type(8)));
constexpr int BM = 256, BK = 64, HALF = 128, HTB = HALF * BK * 2, STAGE_BYTES = 8 * HTB, NXCD = 8, WGM = 8;
__host__ __device__ __forceinline__ int lds_byte(int r, int c) { const int st = (r >> 4) * 2 + (c >> 5), rr = r & 15, cc = c & 31, ob = rr * 64 + cc * 2; return st * 1024 + (ob ^ (((ob >> 9) & 1) << 5)); }
__host__ __device__ __forceinline__ void stage_rc(int b, int& R, int& C) { const int st = b / 1024, sb = b % 1024, swz = sb ^ (((sb >> 9) & 1) << 5); R = (st >> 1) * 16 + swz / 64; C = (st & 1) * 32 + (swz % 64) / 2; }
__host__ __device__ __forceinline__ int perm32(int rho) { const int n = rho >> 4, i = rho & 15; return 8 * (i >> 2) + 4 * n + (i & 3); }
struct Unit { int pm, pn, a0, a1; };
struct Gemm { const bf16_t* A; const bf16_t* Bt; int lda, ldb, K; };
__device__ __forceinline__ unsigned cvt_pk_bf16(float lo, float hi) { unsigned r; asm volatile("v_cvt_pk_bf16_f32 %0, %1, %2" : "=v"(r) : "v"(lo), "v"(hi)); return r; }

struct DenseOrder {
    int nM, nN, nwg, G, c, ldb;
    __device__ void init(int M, int N, int G_, int c_, int ldb_) { nM = M / BM; nN = N / BM; nwg = nM * nN; G = G_; c = c_; ldb = ldb_; }
    __device__ __forceinline__ bool map(long L, Unit& u) const {
        if (L >= nwg) return false;
        int wgid = (int)L; { const int q = nwg / NXCD, r = nwg % NXCD, xcd = wgid % NXCD, off = wgid / NXCD; wgid = (xcd < r ? xcd * (q + 1) : r * (q + 1) + (xcd - r) * q) + off; }
        const int nig = WGM * nN, gid = wgid / nig, fm = gid * WGM, gsz = (nM - fm) < WGM ? (nM - fm) : WGM;
        u.pm = fm + ((wgid % nig) % gsz); u.pn = (wgid % nig) / gsz; u.a0 = 0; u.a1 = 0; return true;
    }
    __device__ __forceinline__ bool next(int i, Unit& u) const { return map((long)i * G + c, u); }
    __device__ __forceinline__ int arow(const Unit& u, int r) const { return u.pm * BM + r; }
    __device__ __forceinline__ size_t boff(const Unit& u) const { return (size_t)u.pn * BM * ldb; }
};

template <class Epi, class Sched>
__device__ __forceinline__ void gemm_phase(PG8_LAS unsigned char* lds, const Gemm g, const Sched& S, const Epi& E) {
    const int tid = threadIdx.x, wid = __builtin_amdgcn_readfirstlane(tid >> 6), lane = tid & 63, wr = wid >> 2, wc = wid & 3, fr = lane & 15, fq = lane >> 4;
    const int nt = g.K / BK;
    int RA[2], CA[2]; unsigned voffB[2];
#pragma unroll
    for (int i = 0; i < 2; ++i) { int R, C; stage_rc(tid * 16 + i * 8192, R, C); const int Rb = Epi::PERM ? ((R & ~31) + perm32(R & 31)) : R;
        RA[i] = R; CA[i] = C * 2; voffB[i] = (unsigned)(Rb * g.ldb + C) * 2u; }
    const size_t kstep = (size_t)(BK * 2);
    const size_t hstepB = (size_t)HALF * g.ldb * 2;
    const unsigned ldsw = (unsigned)wid * 1024u;
    const int aoff = lds_byte(wr * 64 + fr, fq * 8), boff = lds_byte(wc * 32 + fr, fq * 8);
#define PG8_SA(b, h) (((b) * 2 + (h)) * HTB)
#define PG8_SB(b, h) ((4 + (b) * 2 + (h)) * HTB)
#define PG8_STAGE(bufoff, gbase, voff) do { _Pragma("unroll") for (int _i = 0; _i < 2; ++_i) \
        __builtin_amdgcn_global_load_lds((const unsigned*)((const char*)(gbase) + (voff)[_i]), (PG8_LAS unsigned*)(lds + (bufoff) + ldsw + _i * 8192), 16, 0, 0); } while (0)
#define PG8_LDA(dst, b, h) do { _Pragma("unroll") for (int m = 0; m < 4; ++m) _Pragma("unroll") for (int k = 0; k < 2; ++k) dst[m][k] = *(const PG8_LAS bf16x8*)(lds + PG8_SA(b, h) + aoff + m * 2048 + k * 1024); } while (0)
#define PG8_LDB(dst, b, h) do { _Pragma("unroll") for (int n = 0; n < 2; ++n) _Pragma("unroll") for (int k = 0; k < 2; ++k) dst[n][k] = *(const PG8_LAS bf16x8*)(lds + PG8_SB(b, h) + boff + n * 2048 + k * 1024); } while (0)
#define PG8_MMA(ai, bj, At, Bt) do { __builtin_amdgcn_s_setprio(1); _Pragma("unroll") for (int m = 0; m < 4; ++m) _Pragma("unroll") for (int n = 0; n < 2; ++n) _Pragma("unroll") for (int k = 0; k < 2; ++k) \
        acc[ai][bj][m][n] = __builtin_amdgcn_mfma_f32_16x16x32_bf16(Bt[n][k], At[m][k], acc[ai][bj][m][n], 0, 0, 0); __builtin_amdgcn_s_setprio(0); } while (0)
#define PG8_WAIT_V(n) asm volatile("s_waitcnt vmcnt(" #n ")" ::: "memory")
#define PG8_WAIT_L(n) asm volatile("s_waitcnt lgkmcnt(" #n ")" ::: "memory")
#define PG8_BAR __builtin_amdgcn_s_barrier()
#define PG8_SCHED __builtin_amdgcn_sched_barrier(0)
#define PG8_AOFFS(dst, u) do { _Pragma("unroll") for (int _h = 0; _h < 2; ++_h) _Pragma("unroll") for (int _i = 0; _i < 2; ++_i) \
        dst[_h][_i] = (unsigned)S.arow(u, _h * HALF + RA[_i]) * (unsigned)(g.lda * 2) + (unsigned)CA[_i]; } while (0)
    Unit cur, nxt; int ui = 0;
    if (!S.next(0, cur)) return;
    f32x4 acc[2][2][4][2];
#pragma unroll
    for (int a = 0; a < 2; ++a)
#pragma unroll
        for (int b = 0; b < 2; ++b)
#pragma unroll
            for (int m = 0; m < 4; ++m)
#pragma unroll
                for (int n = 0; n < 2; ++n) acc[a][b][m][n] = (f32x4){0.f, 0.f, 0.f, 0.f};
    bf16x8 At[4][2], B0[2][2], B1[2][2];
    unsigned oc[2][2], on[2][2];
    PG8_AOFFS(oc, cur);
    const char* gA = (const char*)g.A;
    const char* cB = (const char*)g.Bt + S.boff(cur) * 2;
    PG8_STAGE(PG8_SB(0, 0), cB, voffB); PG8_STAGE(PG8_SB(0, 1), cB + hstepB, voffB); PG8_STAGE(PG8_SA(0, 0), gA, oc[0]); PG8_STAGE(PG8_SA(0, 1), gA, oc[1]);
    if (wr == 1) PG8_BAR;
    PG8_WAIT_V(2); PG8_BAR;
    PG8_STAGE(PG8_SB(1, 0), cB + kstep, voffB); PG8_STAGE(PG8_SA(1, 0), gA + kstep, oc[0]); PG8_STAGE(PG8_SB(1, 1), cB + hstepB + kstep, voffB);
    PG8_WAIT_V(6); PG8_BAR;
    for (;;) {
        const bool has_next = S.next(ui + 1, nxt);
        if (has_next) { PG8_AOFFS(on, nxt); } else {
#pragma unroll
            for (int _h = 0; _h < 2; ++_h)
#pragma unroll
                for (int _i = 0; _i < 2; ++_i) on[_h][_i] = oc[_h][_i]; }
        const char* nB = has_next ? (const char*)g.Bt + S.boff(nxt) * 2 : cB;
        for (int t = 0; t < nt; t += 2) {
            const bool last = (t == nt - 2);
            const char* a1 = gA + (size_t)(t + 1) * kstep;
            const char* a2 = last ? gA : gA + (size_t)(t + 2) * kstep; const char* b2 = last ? nB : cB + (size_t)(t + 2) * kstep;
            const char* a3 = a2 + kstep; const char* b3 = b2 + kstep;
            unsigned os[2][2];
#pragma unroll
            for (int _h = 0; _h < 2; ++_h)
#pragma unroll
                for (int _i = 0; _i < 2; ++_i) os[_h][_i] = last ? on[_h][_i] : oc[_h][_i];
            PG8_LDB(B0, 0, 0); PG8_LDB(B1, 0, 1); PG8_SCHED; PG8_LDA(At, 0, 0); PG8_STAGE(PG8_SA(1, 1), a1, oc[1]);
            PG8_WAIT_V(8); PG8_WAIT_L(0); PG8_BAR; PG8_MMA(0, 0, At, B0); PG8_MMA(0, 1, At, B1); PG8_BAR; PG8_SCHED;
            PG8_LDA(At, 0, 1); PG8_STAGE(PG8_SB(0, 0), b2, voffB); PG8_STAGE(PG8_SB(0, 1), b2 + hstepB, voffB); PG8_STAGE(PG8_SA(0, 0), a2, os[0]);
            PG8_WAIT_V(8); PG8_WAIT_L(0); PG8_BAR; PG8_MMA(1, 0, At, B0); PG8_MMA(1, 1, At, B1); PG8_BAR; PG8_SCHED;
            PG8_LDB(B0, 1, 0); PG8_LDB(B1, 1, 1); PG8_SCHED; PG8_LDA(At, 1, 0); PG8_STAGE(PG8_SA(0, 1), a2, os[1]);
            PG8_WAIT_V(8); PG8_WAIT_L(0); PG8_BAR; PG8_MMA(0, 0, At, B0); PG8_MMA(0, 1, At, B1); PG8_BAR; PG8_SCHED;
            PG8_LDA(At, 1, 1); PG8_STAGE(PG8_SB(1, 0), b3, voffB); PG8_STAGE(PG8_SB(1, 1), b3 + hstepB, voffB); PG8_STAGE(PG8_SA(1, 0), a3, os[0]);
            PG8_WAIT_V(8); PG8_WAIT_L(0); PG8_BAR; PG8_MMA(1, 0, At, B0); PG8_MMA(1, 1, At, B1); PG8_BAR; PG8_SCHED;
        }
        if (wr == 0) PG8_BAR;
        E(acc, cur, wr, wc, fr, fq);
        if (!has_next) break;
#pragma unroll
        for (int a = 0; a < 2; ++a)
#pragma unroll
            for (int b = 0; b < 2; ++b)
#pragma unroll
                for (int m = 0; m < 4; ++m)
#pragma unroll
                    for (int n = 0; n < 2; ++n) acc[a][b][m][n] = (f32x4){0.f, 0.f, 0.f, 0.f};
        cur = nxt; cB = nB; ++ui;
#pragma unroll
        for (int _h = 0; _h < 2; ++_h)
#pragma unroll
            for (int _i = 0; _i < 2; ++_i) oc[_h][_i] = on[_h][_i];
        if (wr == 1) PG8_BAR;
    }
    PG8_WAIT_V(0);
    PG8_BAR;
#undef PG8_SA
#undef PG8_SB
#undef PG8_STAGE
#undef PG8_LDA
#undef PG8_LDB
#undef PG8_MMA
#undef PG8_WAIT_V
#undef PG8_WAIT_L
#undef PG8_BAR
#undef PG8_SCHED
#undef PG8_AOFFS
}
}

struct Args { const float* in[29]; float* out; unsigned char* ws; int ph_lo, ph_hi; };
struct Frame {
    LAS unsigned char* lds;
    unsigned char* ws; gu32* ctl;
    int tid, lane, wave, G, bid;
    const __attribute__((address_space(4))) unsigned char* ka;
    float* out;
    __device__ __forceinline__ const float* inp(int k) const { return *(const float* const __attribute__((address_space(4)))*)(ka + 8 * k); }
};
__device__ __forceinline__ float wave_sum(float v) {
#pragma unroll
    for (int o = 1; o < 64; o <<= 1) v += __shfl_xor(v, o);
    return v;
}
__device__ __forceinline__ float sigmoid_f(float v) { return __builtin_amdgcn_rcpf(1.f + __builtin_amdgcn_exp2f(-LOG2E * v)); }
__device__ __forceinline__ float silu_f(float v) { return v * sigmoid_f(v); }

__constant__ float INV_FREQ[16] = {1.0f, 0.5623413324356079f, 0.3162277638912201f, 0.17782793939113617f, 0.10000000149011612f, 0.05623413249850273f, 0.03162277489900589f, 0.017782794311642647f,
    0.009999999776482582f, 0.005623413249850273f, 0.003162277629598975f, 0.0017782794311642647f, 0.0010000000474974513f, 0.000562341301701963f, 0.0003162277571391314f, 0.00017782794020604342f};
__device__ __forceinline__ double sin_poly(double r) { double r2 = r * r, t = r, s = r; for (int i = 1; i <= 12; ++i) { t *= -r2 / (double)((2 * i) * (2 * i + 1)); s += t; } return s; }
__device__ __forceinline__ double cos_poly(double r) { double r2 = r * r, t = 1.0, s = 1.0; for (int i = 1; i <= 12; ++i) { t *= -r2 / (double)((2 * i - 1) * (2 * i)); s += t; } return s; }
__device__ __forceinline__ void p0_adaln_rope(Frame& F) {
    const float* c = F.inp(1); const float* c_ctx = F.inp(3); const float* w_ada = F.inp(4); const float* b_ada = F.inp(5);
    float* MOD = (float*)(F.ws + WS_MOD);
    { float* RP = (float*)(F.ws + WS_ROPE);
      const int gi = F.bid * NTHR + F.tid;
      if (gi < 192 * 16) { const int pos = gi >> 4, f = gi & 15; const int p = pos < 128 ? pos : pos - 128;
          const float invf = INV_FREQ[f]; const float ang = (float)p * invf;
          const double a = (double)ang; const double k = rint(a * 0.15915494309189535); const double r = a - k * 6.283185307179586477;
          const float cs = (float)cos_poly(r), sn = (float)sin_poly(r);
          if (pos < 128) { RP[pos * 16 + f] = cs; RP[2048 + pos * 16 + f] = sn; } else { RP[4096 + p * 16 + f] = cs; RP[4096 + 1024 + p * 16 + f] = sn; } } }
    if (F.bid < 96) {
        LAS float* S = (LAS float*)F.lds;
        LAS float* R = S + 5 * 1024;
        for (int i = F.tid; i < 5 * 1024; i += NTHR) { const int r = i >> 10, k = i & 1023; const float v = r < 4 ? c[r * 1024 + k] : c_ctx[k]; S[i] = silu_f(v); }
        __syncthreads();
        for (int item = F.bid; item < 96; item += F.G) {
            const int c0 = item * 64; float acc[5] = {0.f, 0.f, 0.f, 0.f, 0.f};
            for (int kk = 0; kk < 128; ++kk) { const int k = F.wave * 128 + kk; const float w = w_ada[(size_t)k * 6144 + c0 + F.lane];
#pragma unroll
                for (int r = 0; r < 5; ++r) acc[r] += S[r * 1024 + k] * w; }
#pragma unroll
            for (int r = 0; r < 5; ++r) R[(F.wave * 5 + r) * 64 + F.lane] = acc[r];
            __syncthreads();
            if (F.tid < 320) { const int r = F.tid >> 6, l = F.tid & 63; float s = 0.f;
#pragma unroll
                for (int w = 0; w < 8; ++w) s += R[(w * 5 + r) * 64 + l];
                MOD[r * 6144 + c0 + l] = s + b_ada[c0 + l]; }
            __syncthreads();
        }
    }
}

__device__ __forceinline__ void norm_mod_row(const float* xrow, const float* nw, const float* scale, const float* shift, int lane, f32x4 (&v)[4]) {
    const GAS f32x4* xr = (const GAS f32x4*)xrow + lane; float ss = 0.f;
#pragma unroll
    for (int j = 0; j < 4; ++j) { v[j] = xr[64 * j]; ss += (v[j].x * v[j].x + v[j].y * v[j].y) + (v[j].z * v[j].z + v[j].w * v[j].w); }
    const float rstd = 1.0f / sqrtf(wave_sum(ss) * (1.f / D) + EPS);
#pragma unroll
    for (int j = 0; j < 4; ++j) { const int d0 = 4 * lane + 256 * j; const f32x4 w = *(const f32x4*)(nw + d0), sc = *(const f32x4*)(scale + d0), sh = *(const f32x4*)(shift + d0);
        v[j] = (v[j] * rstd * w) * (1.f + sc) + sh; }
}
__device__ __forceinline__ void store_row_bf16(bf16* orow, int lane, const f32x4 (&v)[4]) {
    GAS u32x2* o8 = (GAS u32x2*)orow + lane;
#pragma unroll
    for (int j = 0; j < 4; ++j) { u32x2 w; w.x = pk2(v[j].x, v[j].y); w.y = pk2(v[j].z, v[j].w); o8[64 * j] = w; }
}
__device__ __forceinline__ void p1a_norm1(Frame& F) {
    const float* x = F.inp(0); const float* ctx = F.inp(2); const float* nw = F.inp(6);
    const float* MOD = (const float*)(F.ws + WS_MOD); bf16* XN = (bf16*)(F.ws + WS_XN);
    const int gw = F.bid * 8 + F.wave, NGW = F.G * 8;
    for (int m = gw; m < MROWS; m += NGW) {
        const float* row; int mr;
        if (m < T) { row = x + (size_t)m * D; mr = m / SEQ; } else { row = ctx + (size_t)(m - T) * D; mr = 4; }
        f32x4 v[4]; norm_mod_row(row, nw, MOD + mr * 6144 + 1024, MOD + mr * 6144, F.lane, v);
        store_row_bf16(XN + (size_t)m * D, F.lane, v);
    }
}

__device__ __forceinline__ int kv_row(int m) { if (m < T) { const int b = m / SEQ, t = m - b * SEQ; return b * KVL + CTX + t; } const int cm = m - T, b = cm / CTX, c = cm - b * CTX; return b * KVL + c; }

__device__ __forceinline__ void p0_transpose_item(const float* W, int K, int N, bf16* WT, int kb, int n0, int dst_row0, LAS float* scr, int lane) {
    const int k0 = 64 * kb;
#pragma unroll 8
    for (int i = 0; i < 32; ++i) { const int kk = 2 * i + (lane >> 5); scr[kk * 33 + (lane & 31)] = W[(size_t)(k0 + kk) * N + n0 + (lane & 31)]; }
    asm volatile("s_waitcnt lgkmcnt(0)" ::: "memory");
    const int c = lane & 7;
#pragma unroll
    for (int j = 0; j < 4; ++j) { const int n = (lane >> 3) + 8 * j; const LAS float* sp = scr + (8 * c) * 33 + n;
        u32x4 o; o.x = pk2(sp[0 * 33], sp[1 * 33]); o.y = pk2(sp[2 * 33], sp[3 * 33]); o.z = pk2(sp[4 * 33], sp[5 * 33]); o.w = pk2(sp[6 * 33], sp[7 * 33]);
        *(GAS u32x4*)(WT + (size_t)(dst_row0 + n) * K + k0 + 8 * c) = o; }
    asm volatile("s_waitcnt lgkmcnt(0)" ::: "memory");
}
__device__ __forceinline__ int inproj_dst_row(int n0) { const int pn = n0 >> 8, w = n0 & 255, g = w >> 6, a = (w >> 5) & 1; return 256 * pn + 128 * a + 32 * g; }
__device__ __forceinline__ void p0_weights(Frame& F) {
    LAS float* scr = (LAS float*)(F.lds + 65536 + F.wave * 8704);
    const int gw = F.bid * 8 + F.wave, NGW = F.G * 8;
    constexpr int I_IN = 16 * 208, I_A = 16 * 32, I_B = 8 * 32, I_O = 16 * 32, I_G = 32 * 16 * 16, I_D = 32 * 8 * 32;
    constexpr int NITEMS = I_IN + I_A + I_B + I_O + 2 * I_G + I_D;
    for (int it = gw; it < NITEMS; it += NGW) {
        int r = it;
        if (r < I_IN) { const int kb = r / 208, n0 = (r % 208) * 32; p0_transpose_item(F.inp(8), 1024, NIN, (bf16*)(F.ws + WS_WIN), kb, n0, inproj_dst_row(n0), scr, F.lane); continue; } r -= I_IN;
        if (r < I_A) { const int kb = r / 32, n0 = (r % 32) * 32; p0_transpose_item(F.inp(19), 1024, 1024, (bf16*)(F.ws + WS_WA), kb, n0, n0, scr, F.lane); continue; } r -= I_A;
        if (r < I_B) { const int kb = r / 32, n0 = (r % 32) * 32; p0_transpose_item(F.inp(20), 512, 1024, (bf16*)(F.ws + WS_WB), kb, n0, n0, scr, F.lane); continue; } r -= I_B;
        if (r < I_O) { const int kb = r / 32, n0 = (r % 32) * 32; p0_transpose_item(F.inp(21), 1024, 1024, (bf16*)(F.ws + WS_WO), kb, n0, n0, scr, F.lane); continue; } r -= I_O;
        if (r < 2 * I_G) { const int up = r >= I_G; if (up) r -= I_G; const int e = r / 256, q = r % 256, kb = q / 16, n0 = (q % 16) * 32;
            const int drow = 256 * (n0 >> 7) + 128 * up + (n0 & 127);
            p0_transpose_item(F.inp(up ? 27 : 26) + (size_t)e * 1024 * EH, 1024, EH, (bf16*)(F.ws + WS_WGU) + (size_t)e * 1024 * 1024, kb, n0, drow, scr, F.lane); continue; } r -= 2 * I_G;
        { const int e = r / 256, q = r % 256, kb = q / 32, n0 = (q % 32) * 32;
            p0_transpose_item(F.inp(28) + (size_t)e * EH * 1024, EH, 1024, (bf16*)(F.ws + WS_WD) + (size_t)e * 1024 * EH, kb, n0, n0, scr, F.lane); }
    }
}

struct InProjOrder {
    pg8::DenseOrder d;
    __device__ __forceinline__ bool next(int i, pg8::Unit& u) const {
        long L = (long)i * d.G + d.c;
#if defined(PROBE_INPROJ2)
        if (L >= d.nwg + 48) L -= d.nwg + 48;
        if (i >= 27) return false;
#endif
        if (L < d.nwg) return d.map(L, u);
        const int j = (int)(L - d.nwg); if (j >= 48) return false;
        const int c = j % 12; u.pm = 128 + j / 12; u.pn = c < 8 ? 4 + c : 14 + (c - 8); u.a0 = 0; u.a1 = 0; return true;
    }
    __device__ __forceinline__ int arow(const pg8::Unit& u, int r) const { return u.pm * 256 + r; }
    __device__ __forceinline__ size_t boff(const pg8::Unit& u) const { return (size_t)u.pn * 256 * 1024; }
};
struct EpiInProj {
    static constexpr bool PERM = true;
    unsigned char* ws; bf16* GA; const float* gq_a; const float* gk_a; const float* gq_b; const float* gk_b;
    __device__ __forceinline__ void operator()(const f32x4 (&acc)[2][2][4][2], const pg8::Unit& u, int wr, int wc, int fr_, int fq_) const {
        int fr = fr_, fq = fq_; asm volatile("" : "+v"(fr), "+v"(fq));
        const int pn = u.pn, cg = 4 * pn + wc;
        int kind; const float* gain = nullptr; bool rope = false; float oscale = 1.f; bf16* dbase; int pitch, ccol; bool kvrow = false;
        if (cg < 16)      { kind = 0; gain = gq_a; rope = true; oscale = C2; dbase = (bf16*)(ws + WS_QA); pitch = D; ccol = cg * 64; }
        else if (cg < 32) { kind = 0; gain = gk_a; rope = true; dbase = (bf16*)(ws + WS_KA); pitch = D; ccol = (cg - 16) * 64; kvrow = true; }
        else if (cg < 48) { kind = 1; dbase = (bf16*)(ws + WS_VA); pitch = D; ccol = (cg - 32) * 64; kvrow = true; }
        else if (cg < 56) { kind = 0; gain = gq_b; oscale = C2; dbase = (bf16*)(ws + WS_QB); pitch = 512; ccol = (cg - 48) * 64; }
        else if (cg < 64) { kind = 0; gain = gk_b; dbase = (bf16*)(ws + WS_KB); pitch = 512; ccol = (cg - 56) * 64; kvrow = true; }
        else if (cg < 72) { kind = 1; dbase = (bf16*)(ws + WS_VB); pitch = 512; ccol = (cg - 64) * 64; kvrow = true; }
        else if (cg < 88) { kind = 2; dbase = GA; pitch = D; ccol = (cg - 72) * 64; }
        else              { kind = 2; dbase = GA + (size_t)T * D; pitch = D; ccol = (cg - 88) * 64; }
        const bool latent = u.pm < 128; if (!latent) rope = false;
        const float* RP = (const float*)(ws + WS_ROPE);
        const int role = fq >> 1, fl = fq & 1;
        const float sgn = role ? 1.f : -1.f;
        f32x4 gn[2][2];
        if (kind == 0) {
#pragma unroll
            for (int bj = 0; bj < 2; ++bj)
#pragma unroll
                for (int n = 0; n < 2; ++n) gn[bj][n] = *(const f32x4*)(gain + 32 * bj + 8 * fq + 4 * n) * oscale;
        }
#pragma unroll
        for (int ai = 0; ai < 2; ++ai)
#pragma unroll
            for (int m = 0; m < 4; ++m) {
                const int row = u.pm * 256 + ai * 128 + wr * 64 + m * 16 + fr;
                f32x4 v[2][2];
#pragma unroll
                for (int bj = 0; bj < 2; ++bj)
#pragma unroll
                    for (int n = 0; n < 2; ++n) v[bj][n] = acc[ai][bj][m][n];
                if (kind == 0) {
                    float ss = 0.f;
#pragma unroll
                    for (int bj = 0; bj < 2; ++bj)
#pragma unroll
                        for (int n = 0; n < 2; ++n) ss += (v[bj][n].x * v[bj][n].x + v[bj][n].y * v[bj][n].y) + (v[bj][n].z * v[bj][n].z + v[bj][n].w * v[bj][n].w);
                    ss += __shfl_xor(ss, 16); ss += __shfl_xor(ss, 32);
                    const float rstd = 1.0f / sqrtf(ss * (1.f / 64.f) + EPS);
#pragma unroll
                    for (int bj = 0; bj < 2; ++bj)
#pragma unroll
                        for (int n = 0; n < 2; ++n) v[bj][n] = v[bj][n] * rstd * gn[bj][n];
                    if (rope) {
                        const int t = row & (SEQ - 1), pr = t >> 6, pc = t & 63;
#pragma unroll
                        for (int bj = 0; bj < 2; ++bj) { const float* tb = RP + (bj ? 4096 + pc * 16 : pr * 16) + 8 * fl; const int so = bj ? 1024 : 2048;
#pragma unroll
                            for (int n = 0; n < 2; ++n) { const f32x4 cs = *(const f32x4*)(tb + 4 * n), sn = *(const f32x4*)(tb + so + 4 * n); f32x4 p;
#pragma unroll
                                for (int i = 0; i < 4; ++i) { const unsigned x = __float_as_uint(v[bj][n][i]); auto rr = __builtin_amdgcn_permlane32_swap(x, x, false, false); p[i] = __uint_as_float(role ? rr[0] : rr[1]); }
                                v[bj][n] = v[bj][n] * cs + (p * sgn) * sn; } }
                    }
                } else if (kind == 2) {
#pragma unroll
                    for (int bj = 0; bj < 2; ++bj)
#pragma unroll
                        for (int n = 0; n < 2; ++n) { v[bj][n].x = sigmoid_f(v[bj][n].x); v[bj][n].y = sigmoid_f(v[bj][n].y); v[bj][n].z = sigmoid_f(v[bj][n].z); v[bj][n].w = sigmoid_f(v[bj][n].w); }
                }
                const int drow = kvrow ? kv_row(row) : row;
                bf16* dp = dbase + (size_t)drow * pitch + ccol + 8 * fq;
#pragma unroll
                for (int bj = 0; bj < 2; ++bj) { u32x4 w; w.x = pg8::cvt_pk_bf16(v[bj][0].x, v[bj][0].y); w.y = pg8::cvt_pk_bf16(v[bj][0].z, v[bj][0].w);
                    w.z = pg8::cvt_pk_bf16(v[bj][1].x, v[bj][1].y); w.w = pg8::cvt_pk_bf16(v[bj][1].z, v[bj][1].w); *(GAS u32x4*)(dp + 32 * bj) = w; }
            }
    }
};
__device__ __forceinline__ void p1b_inproj_mfma(Frame& F) {
    pg8::Gemm g{(const bf16*)(F.ws + WS_XN), (const bf16*)(F.ws + WS_WIN), D, D, D};
    InProjOrder S; S.d.init(T, NIN, F.G, F.bid, D);
    EpiInProj E{F.ws, (bf16*)F.out, F.inp(9), F.inp(10), F.inp(16), F.inp(17)};
    pg8::gemm_phase<EpiInProj, InProjOrder>(F.lds, g, S, E);
}

__device__ __forceinline__ float lam_value(const Frame& F) {
    float a = 0.f, b = 0.f; const float* q1 = F.inp(11); const float* k1 = F.inp(12); const float* q2 = F.inp(13); const float* k2 = F.inp(14);
    for (int i = 0; i < 64; ++i) { a += q1[i] * k1[i]; b += q2[i] * k2[i]; }
    return expf(a) - expf(b) + 0.2f;
}
__device__ __forceinline__ float qk_bound(const float* gq, const float* gk) {
    float mq = 0.f, mk = 0.f; for (int i = 0; i < 64; ++i) { mq = fmaxf(mq, fabsf(gq[i])); mk = fmaxf(mk, fabsf(gk[i])); }
    return 8.0f * mq * mk * LOG2E * 1.02f + 0.1f;
}

typedef int i32x2 __attribute__((ext_vector_type(2)));
__device__ __forceinline__ void p4a_norm2_route(Frame& F) {
    const float* XMID = (const float*)(F.ws + WS_XMID); const float* nw = F.inp(7); const float* MOD = (const float*)(F.ws + WS_MOD);
    const float* w_rg = F.inp(22); const float* b_rg = F.inp(23); const float* w_re = F.inp(24); const float* b_re = F.inp(25);
    bf16* H2 = (bf16*)(F.ws + WS_H2); i32x2* LIST = (i32x2*)(F.ws + WS_LIST);
    LAS float* WG = (LAS float*)F.lds;
    LAS float* WE = WG + 4096;
    for (int i = F.tid; i < 4096; i += NTHR) WG[i] = w_rg[i];
    for (int i = F.tid; i < 4 * 1024 * 8; i += NTHR) WE[i] = w_re[i];
    __syncthreads();
    const int gw = F.bid * 8 + F.wave, NGW = F.G * 8;
    f32x4 nx[4];
    if (gw < T) { const GAS f32x4* xr = (const GAS f32x4*)(XMID + (size_t)gw * D) + F.lane;
#pragma unroll
        for (int j = 0; j < 4; ++j) nx[j] = xr[64 * j]; }
    for (int m = gw; m < T; m += NGW) {
        const int b = m / SEQ; f32x4 v[4];
#pragma unroll
        for (int j = 0; j < 4; ++j) v[j] = nx[j];
        if (m + NGW < T) { const GAS f32x4* xr = (const GAS f32x4*)(XMID + (size_t)(m + NGW) * D) + F.lane;
#pragma unroll
            for (int j = 0; j < 4; ++j) nx[j] = xr[64 * j]; }
        { float ss = 0.f;
#pragma unroll
          for (int j = 0; j < 4; ++j) ss += (v[j].x * v[j].x + v[j].y * v[j].y) + (v[j].z * v[j].z + v[j].w * v[j].w);
          const float rstd = 1.0f / sqrtf(wave_sum(ss) * (1.f / D) + EPS);
          const float* scale = MOD + b * 6144 + 4096; const float* shift = MOD + b * 6144 + 3072;
#pragma unroll
          for (int j = 0; j < 4; ++j) { const int d0 = 4 * F.lane + 256 * j; const f32x4 w = *(const f32x4*)(nw + d0), sc = *(const f32x4*)(scale + d0), sh = *(const f32x4*)(shift + d0);
              v[j] = (v[j] * rstd * w) * (1.f + sc) + sh; } }
        store_row_bf16(H2 + (size_t)m * D, F.lane, v);
        float lg[4] = {0.f, 0.f, 0.f, 0.f};
#pragma unroll
        for (int j = 0; j < 4; ++j)
#pragma unroll
            for (int e = 0; e < 4; ++e) { const int k = 4 * F.lane + 256 * j + e; const float hv = v[j][e]; const f32x4 w4 = *(const LAS f32x4*)(WG + k * 4);
                lg[0] += hv * w4.x; lg[1] += hv * w4.y; lg[2] += hv * w4.z; lg[3] += hv * w4.w; }
#pragma unroll
        for (int c = 0; c < 4; ++c) lg[c] = wave_sum(lg[c]);
        int g = 0; float gl[4];
#pragma unroll
        for (int c = 0; c < 4; ++c) gl[c] = lg[c] + b_rg[c];
        float gm = gl[0];
#pragma unroll
        for (int c = 1; c < 4; ++c) if (gl[c] > gm) { gm = gl[c]; g = c; }
        float gs = 0.f;
#pragma unroll
        for (int c = 0; c < 4; ++c) gs += expf(gl[c] - gm);
        const float g_w = 1.f / gs;
        g = __builtin_amdgcn_readfirstlane(g);
        float el[8] = {0.f, 0.f, 0.f, 0.f, 0.f, 0.f, 0.f, 0.f};
        { const LAS float* we = WE + g * 8192;
#pragma unroll
          for (int j = 0; j < 4; ++j)
#pragma unroll
              for (int e = 0; e < 4; ++e) { const int k = 4 * F.lane + 256 * j + e; const float hv = v[j][e];
                  const f32x4 wa = *(const LAS f32x4*)(we + k * 8), wb = *(const LAS f32x4*)(we + k * 8 + 4);
                  el[0] += hv * wa.x; el[1] += hv * wa.y; el[2] += hv * wa.z; el[3] += hv * wa.w; el[4] += hv * wb.x; el[5] += hv * wb.y; el[6] += hv * wb.z; el[7] += hv * wb.w; } }
#pragma unroll
        for (int e = 0; e < 8; ++e) el[e] = wave_sum(el[e]) + b_re[g * 8 + e];
        int i0 = 0; float v0 = el[0];
#pragma unroll
        for (int e = 1; e < 8; ++e) if (el[e] > v0) { v0 = el[e]; i0 = e; }
        int i1 = -1; float v1 = -3.0e38f;
#pragma unroll
        for (int e = 0; e < 8; ++e) if (e != i0 && el[e] > v1) { v1 = el[e]; i1 = e; }
        const float e1 = expf(v1 - v0), den = 1.f / (1.f + e1);
        const float w0 = g_w * den, w1 = g_w * e1 * den;
        if (F.lane < 2) {
            const int ge = F.lane * 32 + g * 8 + (F.lane ? i1 : i0);
            const unsigned p = atomicAdd((unsigned*)(F.ctl + CW_CNT + 64 * ge), 1u);
            i32x2 rec; rec.x = m; rec.y = (int)__float_as_uint(F.lane ? w1 : w0);
            LIST[(size_t)ge * T + p] = rec;
        }
    }
}

namespace dattn {
typedef short bf16x8 __attribute__((ext_vector_type(8)));
typedef short s16x4 __attribute__((ext_vector_type(4)));
typedef float f32x16 __attribute__((ext_vector_type(16)));
typedef short v4i16_t __attribute__((ext_vector_type(4)));
constexpr int SLOT = 32768, NT = KVL / 64, LDS_WS = 3 * SLOT, XS = 136;
typedef __attribute__((address_space(3))) const char* lds_cptr;
__device__ __forceinline__ int crow(int r, int hi) { return (r & 3) + 8 * (r >> 2) + 4 * hi; }
__device__ __forceinline__ void glds16(const void* gsrc, unsigned lds_dst) { unsigned keep;
    asm volatile("s_mov_b32 %0, m0\n\ts_mov_b32 m0, %2\n\ts_nop 0\n\tglobal_load_lds_dwordx4 %1, off\n\ts_mov_b32 m0, %0" : "=&s"(keep) : "v"(gsrc), "s"(lds_dst) : "memory"); }
__device__ __forceinline__ unsigned cvtpk(float lo, float hi) { typedef float f2 __attribute__((ext_vector_type(2))); typedef __bf16 b2 __attribute__((ext_vector_type(2))); f2 v = {lo, hi}; b2 b = __builtin_convertvector(v, b2); return __builtin_bit_cast(unsigned, b); }
__device__ __forceinline__ s16x4 vtr(lds_cptr p) { return __builtin_bit_cast(s16x4, __builtin_amdgcn_ds_read_tr16_b64_v4i16((__attribute__((address_space(3))) v4i16_t*)p)); }
}

namespace dattn2 {
using dattn::bf16x8; using dattn::s16x4; using dattn::f32x16; using dattn::lds_cptr; using dattn::crow; using dattn::cvtpk; using dattn::vtr;
constexpr int NT = KVL / 64, KSL = 16384, VBASE = 4 * KSL, LDS_WS = 7 * KSL, XS = 136;
__device__ __forceinline__ void glds16s(unsigned voff, const void* sbase, unsigned lds_dst) { unsigned keep;
    asm volatile("s_mov_b32 %0, m0\n\ts_mov_b32 m0, %3\n\ts_nop 0\n\tglobal_load_lds_dwordx4 %1, %2\n\ts_mov_b32 m0, %0" : "=&s"(keep) : "v"(voff), "s"(sbase), "s"(lds_dst) : "memory"); }
#define D2_WAIT_BAR(N) asm volatile("s_waitcnt vmcnt(" #N ") lgkmcnt(0)\n\ts_barrier" ::: "memory")
#define D2_SBAR() __builtin_amdgcn_sched_barrier(0)
typedef __attribute__((address_space(3))) const bf16x8* lds_b8;

template <bool SHIFT, int VAR = 0> __device__ __forceinline__ void unit(int b, int h, int qt, const bf16* QA, bf16* OA, const bf16* KA, const bf16* VA, LAS unsigned char* lds, float lam, float shift, const float* subln) {
    const int tid = threadIdx.x, lane = tid & 63, r32 = lane & 31, hi = lane >> 5; const int wid = __builtin_amdgcn_readfirstlane(tid >> 6);
    const int br = wid >> 2, qi = wid & 3;
    const size_t qrow0 = (size_t)b * SEQ + qt * 128 + qi * 32;
    const bf16* Qw = QA + qrow0 * D + h * 128 + br * 64;
    const unsigned lds0 = (unsigned)(uintptr_t)lds;
    unsigned koff[2], voff[2];
#pragma unroll
    for (int j = 0; j < 2; ++j) { const int row = 8 * wid + 4 * j + (lane >> 4), s16 = lane & 15;
        koff[j] = (unsigned)((row * D + h * 128 + ((s16 ^ (row & 15)) * 8)) * 2);
        voff[j] = (unsigned)((row * D + h * 128 + (((s16 >> 2) ^ (row & 3)) * 32) + (s16 & 3) * 8) * 2); }
    const char* Kb = (const char*)(KA + (size_t)b * KVL * D); const char* Vb = (const char*)(VA + (size_t)b * KVL * D);
    const unsigned dst0 = lds0 + (unsigned)wid * 2048u;
#define D2_KDMA1(t, slot, j) do { glds16s(koff[j], Kb + (size_t)(t) * (64 * D * 2), (unsigned)__builtin_amdgcn_readfirstlane(dst0 + (slot) + (j) * 1024u)); } while (0)
#define D2_VDMA1(t, slot, j) do { glds16s(voff[j], Vb + (size_t)(t) * (64 * D * 2), (unsigned)__builtin_amdgcn_readfirstlane(dst0 + VBASE + (slot) + (j) * 1024u)); } while (0)
#define D2_KDMA(t, slot) do { const char* _p = Kb + (size_t)(t) * (64 * D * 2); const unsigned _d = (unsigned)__builtin_amdgcn_readfirstlane(dst0 + (slot)); glds16s(koff[0], _p, _d); glds16s(koff[1], _p, _d + 1024u); } while (0)
#define D2_VDMA(t, slot) do { const char* _p = Vb + (size_t)(t) * (64 * D * 2); const unsigned _d = (unsigned)__builtin_amdgcn_readfirstlane(dst0 + VBASE + (slot)); glds16s(voff[0], _p, _d); glds16s(voff[1], _p, _d + 1024u); } while (0)
    D2_KDMA(0, 0); D2_VDMA(0, 0); D2_KDMA(1, KSL); D2_KDMA(2, 2 * KSL);
    bf16x8 qr[4];
#pragma unroll
    for (int d0 = 0; d0 < 4; ++d0) qr[d0] = *(const bf16x8*)(Qw + (size_t)r32 * D + d0 * 16 + hi * 8);
    f32x16 o[4];
#pragma unroll
    for (int i = 0; i < 4; ++i) o[i] = f32x16{};
    const f32x16 z16 = f32x16{};
    float l = 0.f;
    const unsigned kad = (unsigned)(r32 * 256 + ((((br * 8 + hi) ^ (r32 & 15))) << 4));
    unsigned vad[4];
    { const int q = (lane & 15) >> 2;
#pragma unroll
      for (int db = 0; db < 4; ++db) vad[db] = (unsigned)(VBASE + (4 * hi + q) * 256 + ((db ^ q) << 6) + ((lane >> 4) & 1) * 32 + (lane & 3) * 8); }
    const lds_cptr l3 = (lds_cptr)lds;
#define D2_KF(slot, f) (*(lds_b8)(l3 + (slot) + (kad ^ (unsigned)(((f) >> 1) << 5)) + ((f) & 1) * 8192))
#define D2_VF(dst, slot, m) do { const lds_cptr _a = l3 + (slot) + vad[(m) & 3] + ((m) >> 2) * 4096; const s16x4 _lo = vtr(_a), _hh = vtr(_a + 2048); \
        dst = (bf16x8){_lo[0], _lo[1], _lo[2], _lo[3], _hh[0], _hh[1], _hh[2], _hh[3]}; } while (0)
    D2_WAIT_BAR(0);
    D2_KDMA(3, 3 * KSL); D2_VDMA(1, KSL);
    f32x16 pA0, pA1, pB0, pB1;
#define D2_EX0(v) (SHIFT ? __builtin_amdgcn_exp2f((v) - shift) : __builtin_amdgcn_exp2f(v))
#pragma unroll
    for (int d0 = 0; d0 < 4; ++d0) {
        pA0 = __builtin_amdgcn_mfma_f32_32x32x16_bf16(D2_KF(0, 2 * d0), qr[d0], d0 == 0 ? z16 : pA0, 0, 0, 0);
        pA1 = __builtin_amdgcn_mfma_f32_32x32x16_bf16(D2_KF(0, 2 * d0 + 1), qr[d0], d0 == 0 ? z16 : pA1, 0, 0, 0); }
#pragma unroll
    for (int r = 0; r < 16; ++r) { pA0[r] = D2_EX0(pA0[r]); pA1[r] = D2_EX0(pA1[r]); }
    int k0 = KSL, k1 = 2 * KSL, k2 = 3 * KSL, k3 = 0;
    int r0 = KSL, r1 = 2 * KSL, r2 = 0;
    u32x4 pw0, pw1, pw2, pw3; bf16x8 kfa, kfb, kfc, vfa, vfb, vfc;
    kfa = D2_KF(KSL, 0); kfb = D2_KF(KSL, 1); kfc = D2_KF(KSL, 2);
#define D2_PK(P, B) cvtpk(P[B], P[(B) + 1])
#define D2_PA(k) __builtin_bit_cast(bf16x8, pw##k)
#define D2_EX(v) (SHIFT ? __builtin_amdgcn_exp2f((v) - shift) : __builtin_amdgcn_exp2f(v))
#define D2_GA(C, CIN, KC, QD, KN, NF, A0, A1, W0) do { C = __builtin_amdgcn_mfma_f32_32x32x16_bf16(KC, qr[QD], CIN, 0, 0, 0); if ((NF) < 8) KN = D2_KF(k0, NF); \
        sacc += A0; sacc += A1; W0; D2_SBAR(); } while (0)
#define D2_GB(M, VC, VN, NM, X0, X1, EXTRA) do { o[(M) & 3] = __builtin_amdgcn_mfma_f32_32x32x16_bf16(((M) >> 2) == 0 ? D2_PA(0) : ((M) >> 2) == 1 ? D2_PA(1) : ((M) >> 2) == 2 ? D2_PA(2) : D2_PA(3), VC, o[(M) & 3], 0, 0, 0); \
        if ((NM) < 16) D2_VF(VN, r2, NM); X0 = D2_EX(X0); X1 = D2_EX(X1); EXTRA; D2_SBAR(); } while (0)
#define D2_STEP(C0, C1, P0, P1, t, GK, GV, GP, WN) do { \
        D2_WAIT_BAR(WN); \
        float sacc = P0[0] + P0[1]; \
        D2_GA(C0, z16, kfa, 0, kfa, 3, P0[2],  P0[3],  pw0[0] = D2_PK(P0, 0)); \
        D2_GA(C1, z16, kfb, 0, kfb, 4, P0[4],  P0[5],  pw0[1] = D2_PK(P0, 2)); \
        D2_GA(C0, C0,  kfc, 1, kfc, 5, P0[6],  P0[7],  pw0[2] = D2_PK(P0, 4)); \
        D2_GA(C1, C1,  kfa, 1, kfa, 6, P0[8],  P0[9],  pw0[3] = D2_PK(P0, 6)); \
        D2_GA(C0, C0,  kfb, 2, kfb, 7, P0[10], P0[11], pw1[0] = D2_PK(P0, 8)); \
        D2_VF(vfa, r2, 0); \
        D2_GA(C1, C1,  kfc, 2, kfc, 8, P0[12], P0[13], pw1[1] = D2_PK(P0, 10)); \
        D2_VF(vfb, r2, 1); \
        D2_GA(C0, C0,  kfa, 3, kfa, 8, P0[14], P0[15], pw1[2] = D2_PK(P0, 12)); \
        D2_VF(vfc, r2, 2); \
        D2_GA(C1, C1,  kfb, 3, kfb, 8, P1[0],  P1[1],  pw1[3] = D2_PK(P0, 14)); \
        D2_GB(0,  vfa, vfa, 3,  C0[0],  C0[1],  (sacc += P1[2],  sacc += P1[3],  pw2[0] = D2_PK(P1, 0))); \
        D2_GB(1,  vfb, vfb, 4,  C0[2],  C0[3],  (sacc += P1[4],  sacc += P1[5],  pw2[1] = D2_PK(P1, 2))); \
        D2_GB(2,  vfc, vfc, 5,  C0[4],  C0[5],  (sacc += P1[6],  sacc += P1[7],  pw2[2] = D2_PK(P1, 4))); \
        D2_GB(3,  vfa, vfa, 6,  C0[6],  C0[7],  (sacc += P1[8],  sacc += P1[9],  pw2[3] = D2_PK(P1, 6))); \
        D2_GB(4,  vfb, vfb, 7,  C0[8],  C0[9],  (sacc += P1[10], sacc += P1[11], pw3[0] = D2_PK(P1, 8))); \
        D2_GB(5,  vfc, vfc, 8,  C0[10], C0[11], (sacc += P1[12], sacc += P1[13], pw3[1] = D2_PK(P1, 10))); \
        D2_GB(6,  vfa, vfa, 9,  C0[12], C0[13], (sacc += P1[14], sacc += P1[15], pw3[2] = D2_PK(P1, 12))); \
        D2_GB(7,  vfb, vfb, 10, C0[14], C0[15], (pw3[3] = D2_PK(P1, 14), l += sacc)); \
        D2_GB(8,  vfc, vfc, 11, C1[0],  C1[1],  do { if (GK) D2_KDMA1((t) + 3, k3, 0); } while (0)); \
        D2_GB(9,  vfa, vfa, 12, C1[2],  C1[3],  (void)0); \
        D2_GB(10, vfb, vfb, 13, C1[4],  C1[5],  do { if (GK) D2_KDMA1((t) + 3, k3, 1); } while (0)); \
        D2_GB(11, vfc, vfc, 14, C1[6],  C1[7],  (void)0); \
        D2_GB(12, vfa, vfa, 15, C1[8],  C1[9],  do { if (GV) D2_VDMA1((t) + 1, r1, 0); } while (0)); \
        D2_GB(13, vfb, vfb, 16, C1[10], C1[11], do { if (GP) { kfa = D2_KF(k1, 0); } } while (0)); \
        D2_GB(14, vfc, vfc, 16, C1[12], C1[13], do { if (GV) D2_VDMA1((t) + 1, r1, 1); if (GP) { kfb = D2_KF(k1, 1); } } while (0)); \
        D2_GB(15, vfa, vfa, 16, C1[14], C1[15], do { if (GP) { kfc = D2_KF(k1, 2); } } while (0)); \
        { const int _t = r0; r0 = r1; r1 = r2; r2 = _t; const int _k = k0; k0 = k1; k1 = k2; k2 = k3; k3 = _k; } \
    } while (0)
    if (wid >= 4) __builtin_amdgcn_s_setprio(1);
    int t = 1;
    for (; t + 1 <= NT - 4; t += 2) {
        D2_STEP(pB0, pB1, pA0, pA1, t, true, true, true, 4);
        D2_STEP(pA0, pA1, pB0, pB1, t + 1, true, true, true, 4);
    }
    D2_STEP(pB0, pB1, pA0, pA1, NT - 3, false, true, true, 4);
    D2_STEP(pA0, pA1, pB0, pB1, NT - 2, false, true, true, 2);
    D2_STEP(pB0, pB1, pA0, pA1, NT - 1, false, false, false, 2);
    __builtin_amdgcn_s_setprio(0);
    D2_WAIT_BAR(0);
    { float sacc = 0.f;
#pragma unroll
      for (int r = 0; r < 16; ++r) sacc += pB0[r] + pB1[r];
      l += sacc;
      pw0 = (u32x4){D2_PK(pB0, 0), D2_PK(pB0, 2), D2_PK(pB0, 4), D2_PK(pB0, 6)}; pw1 = (u32x4){D2_PK(pB0, 8), D2_PK(pB0, 10), D2_PK(pB0, 12), D2_PK(pB0, 14)};
      pw2 = (u32x4){D2_PK(pB1, 0), D2_PK(pB1, 2), D2_PK(pB1, 4), D2_PK(pB1, 6)}; pw3 = (u32x4){D2_PK(pB1, 8), D2_PK(pB1, 10), D2_PK(pB1, 12), D2_PK(pB1, 14)};
#pragma unroll
      for (int m = 0; m < 16; ++m) { bf16x8 vf; D2_VF(vf, r2, m);
          o[m & 3] = __builtin_amdgcn_mfma_f32_32x32x16_bf16((m >> 2) == 0 ? D2_PA(0) : (m >> 2) == 1 ? D2_PA(1) : (m >> 2) == 2 ? D2_PA(2) : D2_PA(3), vf, o[m & 3], 0, 0, 0); } }
    { auto rr = __builtin_amdgcn_permlane32_swap(__float_as_uint(l), __float_as_uint(l), false, false); l = __uint_as_float(rr[0]) + __uint_as_float(rr[1]); }
    LAS float* wsf = (LAS float*)(lds + LDS_WS) + wid * 64;
    if (hi == 0) wsf[r32] = 1.0f / l;
    asm volatile("s_waitcnt lgkmcnt(0)" ::: "memory");
    float rli[16];
    { const LAS float* wb = wsf + 4 * hi;
#pragma unroll
      for (int r = 0; r < 16; ++r) rli[r] = wb[(r & 3) + 8 * (r >> 2)]; }
    D2_WAIT_BAR(0);
    LAS float* X = (LAS float*)lds + (size_t)(qi * 32 + 4 * hi) * XS + r32;
    if (br == 1) {
#pragma unroll
        for (int db = 0; db < 4; ++db)
#pragma unroll
            for (int r = 0; r < 16; ++r) X[((r & 3) + 8 * (r >> 2)) * XS + db * 32] = o[db][r] * rli[r];
    }
    D2_WAIT_BAR(0);
    if (br == 0) {
#pragma unroll
        for (int db = 0; db < 4; ++db)
#pragma unroll
            for (int r = 0; r < 16; ++r) { const int xi = ((r & 3) + 8 * (r >> 2)) * XS + db * 32; X[xi] = o[db][r] * rli[r] - lam * X[xi]; }
        asm volatile("s_waitcnt lgkmcnt(0)" ::: "memory");
        int lane_e = lane; asm volatile("" : "+v"(lane_e) : "v"(rli[0]));
        const int row = lane_e >> 1, half = lane_e & 1;
        const LAS float* Xr = (const LAS float*)lds + (size_t)(qi * 32 + row) * XS + half * 8;
        f32x4 v[8][2]; float ss = 0.f;
#pragma unroll
        for (int i = 0; i < 8; ++i)
#pragma unroll
            for (int c = 0; c < 2; ++c) { v[i][c] = *(const LAS f32x4*)(Xr + i * 16 + c * 4); ss += (v[i][c].x * v[i][c].x + v[i][c].y * v[i][c].y) + (v[i][c].z * v[i][c].z + v[i][c].w * v[i][c].w); }
        ss += __shfl_xor(ss, 1);
        const float rstd = 0.8f / sqrtf(ss * (1.f / 128.f) + EPS);
        bf16* dst = OA + (qrow0 + row) * D + h * 128 + half * 8;
        const float* sg = subln + half * 8;
#pragma unroll
        for (int i = 0; i < 8; ++i) { const f32x4 g0 = *(const f32x4*)(sg + i * 16), g1 = *(const f32x4*)(sg + i * 16 + 4);
            u32x4 w; w.x = cvtpk(v[i][0].x * rstd * g0.x, v[i][0].y * rstd * g0.y); w.y = cvtpk(v[i][0].z * rstd * g0.z, v[i][0].w * rstd * g0.w);
            w.z = cvtpk(v[i][1].x * rstd * g1.x, v[i][1].y * rstd * g1.y); w.w = cvtpk(v[i][1].z * rstd * g1.z, v[i][1].w * rstd * g1.w);
            *(GAS u32x4*)(dst + i * 16) = w; }
    }
    D2_WAIT_BAR(0);
#undef D2_KDMA
#undef D2_VDMA
#undef D2_KF
#undef D2_VF
#undef D2_PK
#undef D2_PA
#undef D2_EX
#undef D2_GA
#undef D2_GB
#undef D2_STEP
#undef D2_EX0
}
}

template <int VAR> __device__ __forceinline__ void p2a_diffattn_mfma(Frame& F, bf16* OA) {
    bf16* QA = (bf16*)(F.ws + WS_QA); const bf16* KA = (const bf16*)(F.ws + WS_KA); const bf16* VA = (const bf16*)(F.ws + WS_VA);
    const float lam = lam_value(F); const float mb = qk_bound(F.inp(9), F.inp(10));
    constexpr int NU = NB * NH * (SEQ / 128);
    for (int i = 0; ; ++i) {
        int bh, qt;
        if (F.G == 256) { if (i >= 8) break; const int x = F.bid & 7, j = F.bid >> 3; bh = x + 8 * (i >> 1); qt = (i & 1) * 32 + j; }
        else { const int u = F.bid + i * F.G; if (u >= NU) break; bh = u / (SEQ / 128); qt = u % (SEQ / 128); }
        if (mb < 100.f) dattn2::unit<false, VAR>(bh / NH, bh % NH, qt, QA, OA, KA, VA, F.lds, lam, 0.f, F.inp(15));
        else dattn2::unit<true>(bh / NH, bh % NH, qt, QA, OA, KA, VA, F.lds, lam, mb, F.inp(15));
    }
}


namespace nattn {
using dattn::bf16x8; using dattn::s16x4; using dattn::f32x16; using dattn::lds_cptr; using dattn::crow; using dattn::glds16; using dattn::cvtpk; using dattn::vtr;
__device__ __forceinline__ void unit(int b, int r, const bf16* QB, bf16* OB, const bf16* KB, const bf16* VB, LAS unsigned char* lds, float mb) {
    const int tid = threadIdx.x, lane = tid & 63, r32 = lane & 31, hi = lane >> 5; const int h = __builtin_amdgcn_readfirstlane(tid >> 6);
    const size_t qrow0 = (size_t)b * SEQ + r * GRIDW;
    const unsigned lds0 = (unsigned)(uintptr_t)lds;
    LAS unsigned char* vbuf = lds + h * 16384;
    const LAS float* BL = (const LAS float*)(lds + 131072 + h * 2048);
    LAS float* wsf = (LAS float*)(lds + 147456) + h * 128;
    int r0 = r - 4; r0 = r0 < 0 ? 0 : (r0 > NROWS - 8 ? NROWS - 8 : r0);
    bf16x8 qr[2][4];
#pragma unroll
    for (int qb = 0; qb < 2; ++qb)
#pragma unroll
        for (int d0 = 0; d0 < 4; ++d0) qr[qb][d0] = *(const bf16x8*)(QB + (qrow0 + qb * 32 + r32) * 512 + h * 64 + d0 * 16 + hi * 8);
    f32x16 o[2][2];
#pragma unroll
    for (int i = 0; i < 2; ++i)
#pragma unroll
        for (int j = 0; j < 2; ++j) o[i][j] = f32x16{};
    const f32x16 zero16 = f32x16{};
    float l[2] = {0.f, 0.f};
    const bf16* vsrc0 = VB + (size_t)(lane >> 2) * 512 + h * 64 + (lane & 3) * 8;
    const lds_cptr vp0 = (lds_cptr)vbuf + ((lane >> 4) & 1) * 32 + (lane & 3) * 8 + (4 * hi + ((lane & 15) >> 2)) * 64;
#define NA_KROW(t) ((size_t)b * KVL + ((t) < 8 ? CTX + (r0 + (t)) * GRIDW : ((t) - 8) * 64))
#define NA_DMA(t) do { const bf16* _s = vsrc0 + NA_KROW(t) * 512; const unsigned _d = lds0 + h * 16384 + ((t) & 1) * 8192; \
        _Pragma("unroll") for (int _db = 0; _db < 2; ++_db) _Pragma("unroll") for (int _rc = 0; _rc < 4; ++_rc) \
            glds16(_s + (size_t)_rc * 16 * 512 + _db * 32, (unsigned)__builtin_amdgcn_readfirstlane(_d + _db * 4096 + _rc * 1024)); } while (0)
    NA_DMA(0);
#pragma unroll 1
    for (int t = 0; t < 12; ++t) {
        const bf16* kbase = KB + (NA_KROW(t) + r32) * 512 + h * 64 + hi * 8;
        bf16x8 kf[2][4];
#pragma unroll
        for (int kh = 0; kh < 2; ++kh)
#pragma unroll
            for (int d0 = 0; d0 < 4; ++d0) kf[kh][d0] = *(const bf16x8*)(kbase + (size_t)kh * 32 * 512 + d0 * 16);
        if (t + 1 < 12) { NA_DMA(t + 1); asm volatile("s_waitcnt vmcnt(8)" ::: "memory"); } else asm volatile("s_waitcnt vmcnt(0)" ::: "memory");
        const lds_cptr vp = vp0 + (t & 1) * 8192;
#pragma unroll
        for (int qb = 0; qb < 2; ++qb) {
            f32x16 p0, p1;
#pragma unroll
            for (int d0 = 0; d0 < 4; ++d0) {
                p0 = __builtin_amdgcn_mfma_f32_32x32x16_bf16(kf[0][d0], qr[qb][d0], d0 == 0 ? zero16 : p0, 0, 0, 0);
                p1 = __builtin_amdgcn_mfma_f32_32x32x16_bf16(kf[1][d0], qr[qb][d0], d0 == 0 ? zero16 : p1, 0, 0, 0);
            }
            if (t < 8) {
                const int w = qb * 32 + r32; int c0 = w - 8; c0 = c0 < 0 ? 0 : (c0 > GRIDW - 16 ? GRIDW - 16 : c0);
                const LAS float* brow = BL + (r0 + t - r + 7) * 31 + (15 - w) + 4 * hi;
#pragma unroll
                for (int i = 0; i < 16; ++i) { const int kcc = (i & 3) + 8 * (i >> 2); const int kc = kcc + 4 * hi, kc1 = kc + 32;
                    const bool v0 = (kc >= c0) && (kc < c0 + 16), v1 = (kc1 >= c0) && (kc1 < c0 + 16);
                    const float b0 = brow[kcc], b1 = brow[kcc + 32];
                    p0[i] = v0 ? p0[i] + b0 : -1.0e30f; p1[i] = v1 ? p1[i] + b1 : -1.0e30f; }
            }
            float sacc = 0.f;
#pragma unroll
            for (int i = 0; i < 16; ++i) { p0[i] = __builtin_amdgcn_exp2f(p0[i] - mb); p1[i] = __builtin_amdgcn_exp2f(p1[i] - mb); sacc += p0[i] + p1[i]; }
            l[qb] += sacc;
            u32x4 pw[4];
#pragma unroll
            for (int s2 = 0; s2 < 2; ++s2) {
                pw[s2]     = (u32x4){cvtpk(p0[8 * s2], p0[8 * s2 + 1]), cvtpk(p0[8 * s2 + 2], p0[8 * s2 + 3]), cvtpk(p0[8 * s2 + 4], p0[8 * s2 + 5]), cvtpk(p0[8 * s2 + 6], p0[8 * s2 + 7])};
                pw[2 + s2] = (u32x4){cvtpk(p1[8 * s2], p1[8 * s2 + 1]), cvtpk(p1[8 * s2 + 2], p1[8 * s2 + 3]), cvtpk(p1[8 * s2 + 4], p1[8 * s2 + 5]), cvtpk(p1[8 * s2 + 6], p1[8 * s2 + 7])};
            }
#pragma unroll
            for (int ks = 0; ks < 4; ++ks)
#pragma unroll
                for (int db = 0; db < 2; ++db) {
                    const s16x4 lo = vtr(vp + db * 4096 + ks * 1024), hh = vtr(vp + db * 4096 + ks * 1024 + 512);
                    const bf16x8 vf = (bf16x8){lo[0], lo[1], lo[2], lo[3], hh[0], hh[1], hh[2], hh[3]};
                    o[qb][db] = __builtin_amdgcn_mfma_f32_32x32x16_bf16(__builtin_bit_cast(bf16x8, pw[ks]), vf, o[qb][db], 0, 0, 0);
                }
            asm volatile("" ::: "memory");
        }
    }
#pragma unroll
    for (int qb = 0; qb < 2; ++qb) { auto rr = __builtin_amdgcn_permlane32_swap(__float_as_uint(l[qb]), __float_as_uint(l[qb]), false, false); l[qb] = __uint_as_float(rr[0]) + __uint_as_float(rr[1]);
        if (hi == 0) wsf[qb * 32 + r32] = 1.0f / l[qb]; }
    asm volatile("s_waitcnt lgkmcnt(0)" ::: "memory");
    LAS bf16* stg = (LAS bf16*)vbuf;
    { LAS bf16* sb = stg + (4 * hi) * 64 + r32; const LAS float* wb = wsf + 4 * hi;
#pragma unroll
      for (int qb = 0; qb < 2; ++qb)
#pragma unroll
          for (int i = 0; i < 16; ++i) { const int qc = qb * 32 + (i & 3) + 8 * (i >> 2); const float rl = wb[qc];
#pragma unroll
              for (int db = 0; db < 2; ++db) sb[qc * 64 + db * 32] = (bf16)f2bf(o[qb][db][i] * rl); } }
    asm volatile("s_waitcnt lgkmcnt(0)" ::: "memory");
#pragma unroll
    for (int i = 0; i < 8; ++i) { const int row = i * 8 + (lane >> 3), ch = lane & 7; const u32x4 v = *(const LAS u32x4*)(stg + row * 64 + ch * 8);
        *(GAS u32x4*)(OB + (qrow0 + row) * 512 + h * 64 + ch * 8) = v; }
    asm volatile("s_waitcnt vmcnt(0) lgkmcnt(0)" ::: "memory");
#undef NA_DMA
#undef NA_KROW
}
}
__device__ __forceinline__ void p2b_natten_mfma(Frame& F, bf16* OB) {
    bf16* QB = (bf16*)(F.ws + WS_QB); const bf16* KB = (const bf16*)(F.ws + WS_KB); const bf16* VB = (const bf16*)(F.ws + WS_VB);
    const float* bias = F.inp(18);
    float bm = 0.f; for (int i = F.lane; i < NH * 15 * 31; i += 64) bm = fmaxf(bm, fabsf(bias[i]));
#pragma unroll
    for (int o = 1; o < 64; o <<= 1) bm = fmaxf(bm, __shfl_xor(bm, o));
    const float mb = qk_bound(F.inp(16), F.inp(17)) + bm * LOG2E;
    LAS float* BL = (LAS float*)(F.lds + 131072);
    for (int i = F.tid; i < NH * 512; i += NTHR) { const int h = i >> 9, e = i & 511; BL[i] = e < 465 ? bias[h * 465 + e] * LOG2E : 0.f; }
    __syncthreads();
#if defined(PROBE_NA2)
    for (int u = F.bid; u < 2 * NB * NROWS; u += F.G) { const int uu = u % (NB * NROWS); nattn::unit(uu / NROWS, uu % NROWS, QB, u < NB * NROWS ? (bf16*)(F.ws + WS_XN) : OB, KB, VB, F.lds, mb); }
#else
    for (int u = F.bid; u < NB * NROWS; u += F.G) nattn::unit(u / NROWS, u % NROWS, QB, OB, KB, VB, F.lds, mb);
#endif
    __syncthreads();
}

struct EpiMergeA {
    static constexpr bool PERM = true; const bf16* GA; bf16* Y;
    __device__ __forceinline__ void operator()(const f32x4 (&acc)[2][2][4][2], const pg8::Unit& u, int wr, int wc, int fr_, int fq_) const {
        int fr = fr_, fq = fq_; asm volatile("" : "+v"(fr), "+v"(fq));
#pragma unroll
        for (int ai = 0; ai < 2; ++ai)
#pragma unroll
            for (int m = 0; m < 4; ++m) { const size_t ro = (size_t)(u.pm * 256 + ai * 128 + wr * 64 + m * 16 + fr) * D + u.pn * 256 + wc * 32 + 8 * fq;
#pragma unroll
                for (int bj = 0; bj < 2; ++bj) { const u32x4 gv = *(const GAS u32x4*)(GA + ro + bj * 128); const f32x4 a = acc[ai][bj][m][0], b = acc[ai][bj][m][1];
                    u32x4 w; w.x = pg8::cvt_pk_bf16(bf2f(gv.x & 0xffffu) * a.x, bf2f(gv.x >> 16) * a.y); w.y = pg8::cvt_pk_bf16(bf2f(gv.y & 0xffffu) * a.z, bf2f(gv.y >> 16) * a.w);
                    w.z = pg8::cvt_pk_bf16(bf2f(gv.z & 0xffffu) * b.x, bf2f(gv.z >> 16) * b.y); w.w = pg8::cvt_pk_bf16(bf2f(gv.w & 0xffffu) * b.z, bf2f(gv.w >> 16) * b.w);
                    *(GAS u32x4*)(Y + ro + bj * 128) = w; } }
    }
};
struct EpiMergeB {
    static constexpr bool PERM = true; const bf16* GB; bf16* Y;
    __device__ __forceinline__ void operator()(const f32x4 (&acc)[2][2][4][2], const pg8::Unit& u, int wr, int wc, int fr_, int fq_) const {
        int fr = fr_, fq = fq_; asm volatile("" : "+v"(fr), "+v"(fq));
#pragma unroll
        for (int ai = 0; ai < 2; ++ai)
#pragma unroll
            for (int m = 0; m < 4; ++m) { const size_t ro = (size_t)(u.pm * 256 + ai * 128 + wr * 64 + m * 16 + fr) * D + u.pn * 256 + wc * 32 + 8 * fq;
#pragma unroll
                for (int bj = 0; bj < 2; ++bj) { const u32x4 gv = *(const GAS u32x4*)(GB + ro + bj * 128); const u32x4 yv = *(const GAS u32x4*)(Y + ro + bj * 128); const f32x4 a = acc[ai][bj][m][0], b = acc[ai][bj][m][1];
                    u32x4 w; w.x = pg8::cvt_pk_bf16(bf2f(yv.x & 0xffffu) + bf2f(gv.x & 0xffffu) * a.x, bf2f(yv.x >> 16) + bf2f(gv.x >> 16) * a.y);
                    w.y = pg8::cvt_pk_bf16(bf2f(yv.y & 0xffffu) + bf2f(gv.y & 0xffffu) * a.z, bf2f(yv.y >> 16) + bf2f(gv.y >> 16) * a.w);
                    w.z = pg8::cvt_pk_bf16(bf2f(yv.z & 0xffffu) + bf2f(gv.z & 0xffffu) * b.x, bf2f(yv.z >> 16) + bf2f(gv.z >> 16) * b.y);
                    w.w = pg8::cvt_pk_bf16(bf2f(yv.w & 0xffffu) + bf2f(gv.w & 0xffffu) * b.z, bf2f(yv.w >> 16) + bf2f(gv.w >> 16) * b.w);
                    *(GAS u32x4*)(Y + ro + bj * 128) = w; } }
    }
};
struct EpiOut {
    static constexpr bool PERM = false; const float* x; const float* MOD; float* XMID;
    __device__ __forceinline__ void operator()(const f32x4 (&acc)[2][2][4][2], const pg8::Unit& u, int wr, int wc, int fr_, int fq_) const {
        int fr = fr_, fq = fq_; asm volatile("" : "+v"(fr), "+v"(fq));
        const int b = (u.pm * 256) / SEQ; const int col0 = u.pn * 256 + wc * 32 + 4 * fq;
        f32x4 g[2][2];
#pragma unroll
        for (int bj = 0; bj < 2; ++bj)
#pragma unroll
            for (int n = 0; n < 2; ++n) g[bj][n] = *(const f32x4*)(MOD + b * 6144 + 2048 + col0 + bj * 128 + n * 16);
#pragma unroll
        for (int ai = 0; ai < 2; ++ai)
#pragma unroll
            for (int m = 0; m < 4; ++m) { const size_t ro = (size_t)(u.pm * 256 + ai * 128 + wr * 64 + m * 16 + fr) * D + col0;
#pragma unroll
                for (int bj = 0; bj < 2; ++bj)
#pragma unroll
                    for (int n = 0; n < 2; ++n) { const f32x4 xv = *(const f32x4*)(x + ro + bj * 128 + n * 16); *(f32x4*)(XMID + ro + bj * 128 + n * 16) = xv + g[bj][n] * acc[ai][bj][m][n]; } }
    }
};
__device__ __forceinline__ void p3_merge_out_mfma(Frame& F, int part) {
    bf16* Y = (bf16*)(F.ws + WS_Y); const bf16* GA = (const bf16*)F.out;
    if (part == 0) {
        { pg8::Gemm g{(const bf16*)(F.ws + WS_QA), (const bf16*)(F.ws + WS_WA), D, D, D}; pg8::DenseOrder S; S.init(T, D, F.G, F.bid, D); EpiMergeA E{GA, Y}; pg8::gemm_phase<EpiMergeA, pg8::DenseOrder>(F.lds, g, S, E); }
        asm volatile("s_waitcnt vmcnt(0)" ::: "memory"); __syncthreads();
        { pg8::Gemm g{(const bf16*)(F.ws + WS_QB), (const bf16*)(F.ws + WS_WB), 512, 512, 512}; pg8::DenseOrder S; S.init(T, D, F.G, F.bid, 512); EpiMergeB E{GA + (size_t)T * D, Y}; pg8::gemm_phase<EpiMergeB, pg8::DenseOrder>(F.lds, g, S, E); }
    } else {
        pg8::Gemm g{Y, (const bf16*)(F.ws + WS_WO), D, D, D}; pg8::DenseOrder S; S.init(T, D, F.G, F.bid, D);
        EpiOut E{F.inp(0), (const float*)(F.ws + WS_MOD), (float*)(F.ws + WS_XMID)}; pg8::gemm_phase<EpiOut, pg8::DenseOrder>(F.lds, g, S, E);
    }
}

constexpr int MOE_TAB_OFF = 132096;
struct MoeTab { LAS int* cnt; LAS int* tpre; LAS int* tgrp; };
__device__ __forceinline__ MoeTab moe_tables(Frame& F) {
    MoeTab G; G.cnt = (LAS int*)(F.lds + MOE_TAB_OFF); G.tpre = G.cnt + 64; G.tgrp = G.tpre + 65;
    __syncthreads();
    if (F.tid < 64) {
        const int c = (int)__hip_atomic_load(F.ctl + CW_CNT + 64 * F.tid, __ATOMIC_RELAXED, __HIP_MEMORY_SCOPE_AGENT);
        const int nt = (c + 255) >> 8; int inc = nt;
#pragma unroll
        for (int o = 1; o < 64; o <<= 1) { const int v = __shfl_up(inc, o); if (F.lane >= o) inc += v; }
        G.cnt[F.tid] = c; G.tpre[F.tid] = inc - nt; if (F.tid == 63) G.tpre[64] = inc;
        for (int i = 0; i < nt; ++i) G.tgrp[inc - nt + i] = F.tid;
    }
    __syncthreads();
    return G;
}
struct MoeOrder {
    MoeTab G; int t_lo, t_hi, Gn, c; const i32x2* LIST; int ldb; bool gather;
    __device__ __forceinline__ bool next(int i, pg8::Unit& u) const {
        const long L = (long)i * Gn + c; const int tile = t_lo + (int)(L >> 2); if (tile >= t_hi) return false;
        const int g = G.tgrp[tile];
        u.pm = tile - G.tpre[g]; u.pn = (int)(L & 3); u.a0 = g; u.a1 = tile * 256; return true;
    }
    __device__ __forceinline__ int arow(const pg8::Unit& u, int r) const {
        if (!gather) return u.a1 + r;
        const int idx = u.pm * 256 + r; const int cnt = G.cnt[u.a0]; return LIST[(size_t)u.a0 * T + (idx < cnt ? idx : 0)].x;
    }
    __device__ __forceinline__ size_t boff(const pg8::Unit& u) const { return ((size_t)(u.a0 & 31) * 1024 + (size_t)u.pn * 256) * ldb; }
};
struct EpiGateUp {
    static constexpr bool PERM = true; bf16* HID;
    __device__ __forceinline__ void operator()(const f32x4 (&acc)[2][2][4][2], const pg8::Unit& u, int wr, int wc, int fr_, int fq_) const {
        int fr = fr_, fq = fq_; asm volatile("" : "+v"(fr), "+v"(fq));
#pragma unroll
        for (int ai = 0; ai < 2; ++ai)
#pragma unroll
            for (int m = 0; m < 4; ++m) { const size_t ro = (size_t)(u.a1 + ai * 128 + wr * 64 + m * 16 + fr) * EH + u.pn * 128 + wc * 32 + 8 * fq;
                const f32x4 ga = acc[ai][0][m][0], gb = acc[ai][0][m][1], ua = acc[ai][1][m][0], ub = acc[ai][1][m][1];
                u32x4 w; w.x = pg8::cvt_pk_bf16(silu_f(ga.x) * ua.x, silu_f(ga.y) * ua.y); w.y = pg8::cvt_pk_bf16(silu_f(ga.z) * ua.z, silu_f(ga.w) * ua.w);
                w.z = pg8::cvt_pk_bf16(silu_f(gb.x) * ub.x, silu_f(gb.y) * ub.y); w.w = pg8::cvt_pk_bf16(silu_f(gb.z) * ub.z, silu_f(gb.w) * ub.w);
                *(GAS u32x4*)(HID + ro) = w; }
    }
};
struct EpiDown {
    static constexpr bool PERM = false; MoeTab G; const i32x2* LIST; const LAS float* GA2; const float* base; float* out;
    __device__ __forceinline__ void operator()(const f32x4 (&acc)[2][2][4][2], const pg8::Unit& u, int wr, int wc, int fr_, int fq_) const {
        int fr = fr_, fq = fq_; asm volatile("" : "+v"(fr), "+v"(fq));
        const int cnt = G.cnt[u.a0]; const int col0 = u.pn * 256 + wc * 32 + 4 * fq;
        const i32x2* lst = LIST + (size_t)u.a0 * T;
        const int idx0 = u.pm * 256 + wr * 64 + fr;
        i32x2 tw[2][4];
#pragma unroll
        for (int ai = 0; ai < 2; ++ai)
#pragma unroll
            for (int m = 0; m < 4; ++m) { const int idx = idx0 + ai * 128 + m * 16; tw[ai][m] = lst[idx < cnt ? idx : 0]; }
#pragma unroll
        for (int ai = 0; ai < 2; ++ai) {
            f32x4 bv[4][2][2];
#pragma unroll
            for (int m = 0; m < 4; ++m) { const size_t ro = (size_t)tw[ai][m].x * D + col0;
#pragma unroll
                for (int bj = 0; bj < 2; ++bj)
#pragma unroll
                    for (int n = 0; n < 2; ++n) bv[m][bj][n] = *(const f32x4*)(base + ro + bj * 128 + n * 16); }
#pragma unroll
            for (int m = 0; m < 4; ++m) { const int idx = idx0 + ai * 128 + m * 16; const int tok = tw[ai][m].x; const float w = __uint_as_float((unsigned)tw[ai][m].y);
                const LAS float* g2 = GA2 + (tok / SEQ) * 1024 + col0; const size_t ro = (size_t)tok * D + col0;
                if (idx < cnt) {
#pragma unroll
                    for (int bj = 0; bj < 2; ++bj)
#pragma unroll
                        for (int n = 0; n < 2; ++n) { const f32x4 gv = *(const LAS f32x4*)(g2 + bj * 128 + n * 16); *(f32x4*)(out + ro + bj * 128 + n * 16) = bv[m][bj][n] + gv * w * acc[ai][bj][m][n]; } } }
        }
    }
};
__device__ __forceinline__ void p4_moe_mfma(Frame& F, int part) {
    const MoeTab G = moe_tables(F); const i32x2* LIST = (const i32x2*)(F.ws + WS_LIST);
    if (part == 0) {
        pg8::Gemm g{(const bf16*)(F.ws + WS_H2), (const bf16*)(F.ws + WS_WGU), D, D, D};
        MoeOrder S{G, 0, G.tpre[64], F.G, F.bid, LIST, D, true}; EpiGateUp E{(bf16*)(F.ws + WS_HID)};
        pg8::gemm_phase<EpiGateUp, MoeOrder>(F.lds, g, S, E);
    } else {
        const int kk = part - 1;
        pg8::Gemm g{(const bf16*)(F.ws + WS_HID), (const bf16*)(F.ws + WS_WD), EH, EH, EH};
        MoeOrder S{G, G.tpre[32 * kk], G.tpre[32 * kk + 32], F.G, F.bid, LIST, EH, false};
        LAS float* GA2 = (LAS float*)(F.lds + MOE_TAB_OFF + 2048);
        { const float* MOD = (const float*)(F.ws + WS_MOD); for (int i = F.tid; i < 4096; i += NTHR) GA2[i] = MOD[(i >> 10) * 6144 + 5120 + (i & 1023)]; }
        __syncthreads();
        EpiDown E{G, LIST, GA2, kk == 0 ? (const float*)(F.ws + WS_XMID) : (const float*)F.out, F.out};
        pg8::gemm_phase<EpiDown, MoeOrder>(F.lds, g, S, E);
    }
}

constexpr int NPHASE = 10;
__global__ void __launch_bounds__(NTHR, 2) mk_fwd(Args args) {
    extern __shared__ __attribute__((aligned(16))) unsigned char lds[];
    Frame F;
    F.lds = (LAS unsigned char*)lds; F.ws = args.ws; F.ctl = (gu32*)(args.ws + WS_CTL);
    F.tid = threadIdx.x; F.lane = F.tid & 63; F.wave = __builtin_amdgcn_readfirstlane(F.tid >> 6); F.G = gridDim.x; F.bid = blockIdx.x;
    F.ka = (const __attribute__((address_space(4))) unsigned char*)__builtin_amdgcn_kernarg_segment_ptr();
    F.out = args.out;
    volatile LAS unsigned* MISC = (volatile LAS unsigned*)(F.lds + LDS_BYTES - 64);
    if (F.tid < 16) MISC[F.tid] = 0u;
    __syncthreads();
    XcdBarrier bar; bar.bar = (unsigned*)(F.ctl + CW_BAR); bar.x = 0; bar.st = nullptr;
    if (MK_N_LAUNCHES == 1) bar = xcd_barrier_post((unsigned*)(F.ctl + CW_BAR), MISC);
    const int lo = args.ph_lo, hi = args.ph_hi;
#ifndef PH_MASK
#define PH_MASK 0x3ff
#endif
#define IN(k) (((PH_MASK >> (k)) & 1) && lo <= (k) && (k) < hi)
#define SEAM(k) do { if (IN(k) && IN((k) + 1)) xcd_barrier(bar); { int t_ = threadIdx.x; asm volatile("" : "+v"(t_)); F.tid = t_; F.lane = t_ & 63; } } while (0)
    if (IN(0)) { p0_adaln_rope(F); p0_weights(F); }
    SEAM(0);
    if (IN(1)) p1a_norm1(F);
    SEAM(1);
    if (IN(2)) p1b_inproj_mfma(F);
    SEAM(2);
#ifdef PROBE_ATT_VAR
    if (IN(3)) { p2a_diffattn_mfma<PROBE_ATT_VAR>(F, (bf16*)(F.ws + WS_XN)); asm volatile("s_waitcnt vmcnt(0)" ::: "memory"); __syncthreads(); }
#endif
    if (IN(3)) { p2a_diffattn_mfma<0>(F, (bf16*)(F.ws + WS_QA)); p2b_natten_mfma(F, (bf16*)(F.ws + WS_QB)); }
    SEAM(3);
    if (IN(4)) p3_merge_out_mfma(F, 0);
    SEAM(4);
    if (IN(5)) p3_merge_out_mfma(F, 1);
    SEAM(5);
    if (IN(6)) p4a_norm2_route(F);
    SEAM(6);
    if (IN(7)) p4_moe_mfma(F, 0);
    SEAM(7);
    if (IN(8)) p4_moe_mfma(F, 1);
    SEAM(8);
    if (IN(9)) p4_moe_mfma(F, 2);
#undef IN
#undef SEAM
}

extern "C" void kernel_launch(void* const* d_in, const int* in_sizes, int n_in, void* d_out, int out_size, void* d_ws, size_t ws_size, hipStream_t stream) {
    static int grid = 0;
    if (grid == 0) {
        if (n_in != 29 || out_size != T * D || ws_size < WS_END) { fprintf(stderr, "kernel_launch: unexpected shapes: n_in %d out %d ws %zu\n", n_in, out_size, ws_size); grid = -1; return; }
        int dev = 0, cus = 0, per_cu = 0;
        if (hipGetDevice(&dev) != hipSuccess || hipDeviceGetAttribute(&cus, hipDeviceAttributeMultiprocessorCount, dev) != hipSuccess) { grid = -1; return; }
        if (hipFuncSetAttribute((const void*)mk_fwd, hipFuncAttributeMaxDynamicSharedMemorySize, LDS_BYTES) != hipSuccess) { fprintf(stderr, "kernel_launch: hipFuncSetAttribute failed\n"); grid = -1; return; }
        if (hipOccupancyMaxActiveBlocksPerMultiprocessor(&per_cu, (const void*)mk_fwd, NTHR, LDS_BYTES) != hipSuccess || per_cu < 1) fprintf(stderr, "kernel_launch: occupancy query says %d\n", per_cu);
        (void)hipGetLastError();
        grid = cus;
    }
    if (grid < 0) return;
    if (hipMemsetAsync((char*)d_ws + WS_CTL, 0, CTL_ZERO_BYTES, stream) != hipSuccess) return;
    Args a{};
    for (int i = 0; i < 29; ++i) a.in[i] = (const float*)d_in[i];
    a.out = (float*)d_out; a.ws = (unsigned char*)d_ws;
    if (MK_N_LAUNCHES == 1) { a.ph_lo = 0; a.ph_hi = NPHASE; hipLaunchKernelGGL(mk_fwd, dim3(grid), dim3(NTHR), LDS_BYTES, stream, a); }
    else for (int p = 0; p < NPHASE; ++p) { a.ph_lo = p; a.ph_hi = p + 1; hipLaunchKernelGGL(mk_fwd, dim3(grid), dim3(NTHR), LDS_BYTES, stream, a); }
}
```

```cpp
#include <hip/hip_runtime.h>
#include <type_traits>
#include <cstdio>
#include <cstdint>

#ifndef MK_N_LAUNCHES
#define MK_N_LAUNCHES 1
#endif

constexpr int NB = 4, SEQ = 8192, D = 1024, T = NB * SEQ, CTX = 256, TC = NB * CTX, MROWS = T + TC;
constexpr int KVL = CTX + SEQ;
constexpr int NIN = 6656, GRIDW = 64, NROWS = SEQ / GRIDW;
constexpr int NH = 8, HD = 64;
constexpr int NEXP = 32, EH = 512, NGRP = 4, EPG = 8;
constexpr int NLIST = 64;
constexpr float EPS = 1e-6f;
constexpr float LOG2E = 1.4426950408889634f;
constexpr float C2 = 0.125f * LOG2E;

constexpr size_t MiB = 1u << 20;
constexpr size_t WS_CTL = 0, CTL_ZERO_BYTES = 1 * MiB;
constexpr size_t WS_MOD = 1 * MiB;
constexpr size_t WS_ROPE = 1 * MiB + 256 * 1024;
constexpr size_t WS_LIST = 488 * MiB;
constexpr size_t WS_WIN = 12 * MiB;
constexpr size_t WS_WA = 25 * MiB, WS_WB = 27 * MiB, WS_WO = 28 * MiB;
constexpr size_t WS_WGU = 30 * MiB;
constexpr size_t WS_WD = 94 * MiB;
constexpr size_t WS_XN = 126 * MiB;
constexpr size_t WS_QA = 192 * MiB;
constexpr size_t WS_OC = 224 * MiB;
constexpr int OCP = 1536;
constexpr size_t WS_OB = WS_OC, WS_OA = WS_OC + 512;
constexpr size_t WS_WC = 25 * MiB;
constexpr size_t WS_Y2 = 192 * MiB;
constexpr size_t WS_QB = 321 * MiB;
constexpr size_t WS_KA = 288 * MiB;
constexpr size_t WS_VA = 354 * MiB;
constexpr size_t WS_KB = 420 * MiB;
constexpr size_t WS_VB = 453 * MiB;
constexpr size_t WS_END = 504 * MiB;
constexpr size_t WS_Y = WS_XN, WS_H2 = WS_XN, WS_HID = WS_QA, WS_XMID = WS_KA;
constexpr int CW_TMO = 0, CW_BAR = 4096, CW_SUB = 8192, CW_CNT = 16384;

constexpr int LDS_BYTES = 163840;
constexpr int NTHR = 512;

#define GAS __attribute__((address_space(1)))
#define LAS __attribute__((address_space(3)))
typedef unsigned short bf16;
typedef float f32x4 __attribute__((ext_vector_type(4)));
typedef float f32x2 __attribute__((ext_vector_type(2)));
typedef unsigned u32x4 __attribute__((ext_vector_type(4)));
typedef unsigned u32x2 __attribute__((ext_vector_type(2)));
typedef GAS unsigned gu32;
__device__ __forceinline__ int lane_id() { int l; asm volatile("v_mbcnt_lo_u32_b32 %0, -1, 0\n\tv_mbcnt_hi_u32_b32 %0, -1, %0" : "=v"(l)); return l; }

__device__ __forceinline__ unsigned f2bf(float f) { unsigned u = __builtin_bit_cast(unsigned, f); return (u + 0x7fffu + ((u >> 16) & 1u)) >> 16; }
__device__ __forceinline__ float bf2f(unsigned h) { return __builtin_bit_cast(float, h << 16); }
__device__ __forceinline__ float rbf(float f) { return bf2f(f2bf(f)); }
__device__ __forceinline__ unsigned pk2(float lo, float hi) { return f2bf(lo) | (f2bf(hi) << 16); }

#define XB_TMO      128
#define XB_XCNT(j)  (256  + 64 * (j))
#define XB_XSUB(j)  (1280 + 64 * (j))
#define XB_XGEN(j)  (2304 + 64 * (j))
#define XB_TOP      3328
#define XB_TOPGEN   3392
#define XCD_BAR_WORDS 3456
#define XB_SPIN_CAP (1u << 18)
__device__ __forceinline__ unsigned xb_ld(unsigned* p)              { return __hip_atomic_load(p, __ATOMIC_RELAXED, __HIP_MEMORY_SCOPE_AGENT); }
__device__ __forceinline__ unsigned xb_add(unsigned* p, unsigned v) { return __hip_atomic_fetch_add(p, v, __ATOMIC_RELAXED, __HIP_MEMORY_SCOPE_AGENT); }
__device__ __forceinline__ unsigned xb_xcc_id() { return (unsigned)__builtin_amdgcn_s_getreg((3 << 11) | 20) & 0xFu; }
#define XB_SPIN(cond, bar) do { unsigned _sp = 0; while (cond) { __builtin_amdgcn_s_sleep(1); \
    if ((++_sp & 255u) == 0u) { if (xb_ld(&(bar)[XB_TMO])) break; if (_sp > XB_SPIN_CAP) { atomicAdd(&(bar)[XB_TMO], 1u); break; } } } } while (0)
struct XcdBarrier { unsigned* bar; unsigned x; volatile LAS unsigned* st; int wave; };
__device__ __forceinline__ XcdBarrier xcd_barrier_post(unsigned* bar, volatile LAS unsigned* st, int wave) {
    XcdBarrier b; b.bar = bar; b.x = xb_xcc_id(); b.st = st; b.wave = wave;
    if (wave == 0 && lane_id() == 0) (void)xb_add(&bar[XB_XCNT(b.x)], 1u);
    return b;
}
__device__ __forceinline__ void xcd_barrier_complete(unsigned* bar, unsigned x, unsigned& nloc, unsigned& nx) {
    const unsigned G = gridDim.x * gridDim.y * gridDim.z;
    unsigned sum, cnt, mine, sp = 0u;
    for (;;) {
        sum = 0u; cnt = 0u; mine = 0u;
#pragma unroll
        for (unsigned j = 0; j < 16; ++j) { const unsigned c = xb_ld(&bar[XB_XCNT(j)]); sum += c; cnt += (c > 0u) ? 1u : 0u; mine = (j == x) ? c : mine; }
        if (sum == G) break;
        __builtin_amdgcn_s_sleep(1);
        if ((++sp & 255u) == 0u) { if (xb_ld(&bar[XB_TMO])) break; if (sp > XB_SPIN_CAP) { atomicAdd(&bar[XB_TMO], 1u); break; } }
    }
    nloc = mine > 0u ? mine : 1u; nx = cnt > 0u ? cnt : 1u;
}
__device__ __forceinline__ void xcd_barrier(const XcdBarrier& b) {
    asm volatile("s_waitcnt vmcnt(0)" ::: "memory");
    __syncthreads();
    if (b.wave == 0 && lane_id() == 0) {
        unsigned* bar = b.bar;
        __builtin_amdgcn_s_waitcnt(0);
        unsigned nloc = b.st[0], nx = b.st[1];
        if (nloc == 0u) { xcd_barrier_complete(bar, b.x, nloc, nx); b.st[0] = nloc; b.st[1] = nx; }
        const unsigned old = xb_add(&bar[XB_XSUB(b.x)], 1u);
        const unsigned gen = old / nloc;
        if (old + 1u == (gen + 1u) * nloc) {
            __builtin_amdgcn_fence(__ATOMIC_RELEASE, "agent");
            asm volatile("s_waitcnt vmcnt(0)" ::: "memory");
            const unsigned og = xb_add(&bar[XB_TOP], 1u);
            const unsigned tgt = (og / nx + 1u) * nx;
            if (og + 1u != tgt) XB_SPIN(xb_ld(&bar[XB_TOP]) < tgt, bar);
            __builtin_amdgcn_fence(__ATOMIC_ACQUIRE, "agent");
            xb_add(&bar[XB_XGEN(b.x)], 1u);
            asm volatile("s_waitcnt vmcnt(0)" ::: "memory");
        } else {
            XB_SPIN(xb_ld(&bar[XB_XGEN(b.x)]) == gen, bar);
            __builtin_amdgcn_fence(__ATOMIC_ACQUIRE, "agent");
            asm volatile("s_waitcnt vmcnt(0)" ::: "memory");
        }
    }
    __syncthreads();
}

namespace pg8 {
#define PG8_LAS __attribute__((address_space(3)))
typedef unsigned short bf16_t;
typedef short bf16x8 __attribute__((ext_vector_type(8)));
typedef short bf16x16_t __attribute__((ext_vector_type(16)));
typedef int i32x8_t __attribute__((ext_vector_type(8)));
constexpr int BM = 256, BK = 64, HALF = 128, HTB = HALF * BK * 2, STAGE_BYTES = 8 * HTB, NXCD = 8, WGM = 8;
__host__ __device__ __forceinline__ int lds_byte(int r, int c) { const int st = (r >> 4) * 2 + (c >> 5), rr = r & 15, cc = c & 31, ob = rr * 64 + cc * 2; return st * 1024 + (ob ^ (((ob >> 9) & 1) << 5)); }
__host__ __device__ __forceinline__ void stage_rc(int b, int& R, int& C) { const int st = b / 1024, sb = b % 1024, swz = sb ^ (((sb >> 9) & 1) << 5); R = (st >> 1) * 16 + swz / 64; C = (st & 1) * 32 + (swz % 64) / 2; }
__host__ __device__ __forceinline__ int perm32(int rho) { const int n = rho >> 4, i = rho & 15; return 8 * (i >> 2) + 4 * n + (i & 3); }
struct Unit { int pm, pn, a0, a1; };
struct Gemm { const bf16_t* A; const bf16_t* Bt; int lda, ldb, K; };
__device__ __forceinline__ unsigned cvt_pk_bf16(float lo, float hi) { unsigned r; asm volatile("v_cvt_pk_bf16_f32 %0, %1, %2" : "=v"(r) : "v"(lo), "v"(hi)); return r; }

struct DenseOrder {
    static constexpr bool LAZY = true;
    int nM, nN, nwg, G, c, ldb;
    __device__ void init(int M, int N, int G_, int c_, int ldb_) { nM = M / BM; nN = N / BM; nwg = nM * nN; G = G_; c = c_; ldb = ldb_; }
    __device__ __forceinline__ bool map(long L, Unit& u) const {
        if (L >= nwg) return false;
        int wgid = (int)L; { const int q = nwg / NXCD, r = nwg % NXCD, xcd = wgid % NXCD, off = wgid / NXCD; wgid = (xcd < r ? xcd * (q + 1) : r * (q + 1) + (xcd - r) * q) + off; }
        const int nig = WGM * nN, gid = wgid / nig, fm = gid * WGM, gsz = (nM - fm) < WGM ? (nM - fm) : WGM;
        u.pm = fm + ((wgid % nig) % gsz); u.pn = (wgid % nig) / gsz; u.a0 = 0; u.a1 = 0; return true;
    }
    __device__ __forceinline__ bool next(int i, Unit& u) const { return map((long)i * G + c, u); }
    __device__ __forceinline__ int arow(const Unit& u, int r) const { return u.pm * BM + r; }
    __device__ __forceinline__ size_t boff(const Unit& u) const { return (size_t)u.pn * BM * ldb; }
};

template <class Epi, class Sched, bool F8 = false>
__device__ __forceinline__ void gemm_phase(PG8_LAS unsigned char* lds, const Gemm g, const Sched& S, const Epi& E, const int wid_) {
    constexpr int ES = F8 ? 1 : 2;
    const int wid = __builtin_amdgcn_readfirstlane(wid_);
    const int lane = lane_id(), tid = wid * 64 + lane, wr = wid >> 2, wc = wid & 3, fr = lane & 15, fq = lane >> 4;
    const int nt = g.K * ES / (BK * 2);
    int RA[2], CA[2]; unsigned voffB[2];
#pragma unroll
    for (int i = 0; i < 2; ++i) { int R, C; stage_rc(tid * 16 + i * 8192, R, C); const int Rb = Epi::PERM ? ((R & ~31) + perm32(R & 31)) : R;
        RA[i] = R; CA[i] = C * 2; voffB[i] = (unsigned)(Rb * g.ldb * ES + C * 2); }
    const size_t kstep = (size_t)(BK * 2);
    const size_t hstepB = (size_t)HALF * g.ldb * ES;
    const int pA = g.lda * ES, pB = g.ldb * ES;
    const unsigned ldsw = (unsigned)wid * 1024u;
    const unsigned lds0 = (unsigned)(uintptr_t)lds;
    const int aoff = lds_byte(wr * 64 + fr, fq * 8); int boff = lds_byte(wc * 32 + fr, fq * 8) + 4 * HTB;
    asm volatile("" : "+v"(boff));
#define PG8_SA(b, h) (((b) * 2 + (h)) * HTB)
#define PG8_SB(b, h) ((4 + (b) * 2 + (h)) * HTB)
#define PG8_SBR(b, h) (((b) * 2 + (h)) * HTB)
#define PG8_DMA(voff1, gbase, ldsa) asm volatile("s_mov_b32 m0, %2\n\ts_nop 0\n\tglobal_load_lds_dwordx4 %0, %1" : : "v"(voff1), "s"((const char*)(gbase)), "s"((unsigned)(ldsa)) : "memory", "m0")
#define PG8_STAGE(bufoff, gbase, voff) do { _Pragma("unroll") for (int _i = 0; _i < 2; ++_i) PG8_DMA((voff)[_i], gbase, lds0 + (bufoff) + ldsw + _i * 8192); } while (0)
#define PG8_STAGE1(bufoff, gbase, voff1, pitchB) do { PG8_DMA(voff1, gbase, lds0 + (bufoff) + ldsw); PG8_DMA(voff1, (const char*)(gbase) + (size_t)64 * (pitchB), lds0 + (bufoff) + ldsw + 8192); } while (0)
#define PG8_LDA(dst, b, h) do { _Pragma("unroll") for (int m = 0; m < 4; ++m) _Pragma("unroll") for (int k = 0; k < 2; ++k) dst[m][k] = *(const PG8_LAS bf16x8*)(lds + PG8_SA(b, h) + aoff + m * 2048 + k * 1024); } while (0)
#define PG8_LDB(dst, b, h) do { _Pragma("unroll") for (int n = 0; n < 2; ++n) _Pragma("unroll") for (int k = 0; k < 2; ++k) dst[n][k] = *(const PG8_LAS bf16x8*)(lds + PG8_SBR(b, h) + boff + n * 2048 + k * 1024); } while (0)
#define PG8_MMA(ai, bj, At, Bt) do { __builtin_amdgcn_s_setprio(1); _Pragma("unroll") for (int m = 0; m < 4; ++m) _Pragma("unroll") for (int n = 0; n < 2; ++n) _Pragma("unroll") for (int k = 0; k < 2; ++k) \
        acc[ai][bj][m][n] = __builtin_amdgcn_mfma_f32_16x16x32_bf16(Bt[n][k], At[m][k], acc[ai][bj][m][n], 0, 0, 0); __builtin_amdgcn_s_setprio(0); } while (0)
#define PG8_CAT(X) __builtin_bit_cast(i32x8_t, (bf16x16_t){X[0][0], X[0][1], X[0][2], X[0][3], X[0][4], X[0][5], X[0][6], X[0][7], X[1][0], X[1][1], X[1][2], X[1][3], X[1][4], X[1][5], X[1][6], X[1][7]})
#define PG8_MMA8(ai, bj, At, Bt) do { __builtin_amdgcn_s_setprio(1); _Pragma("unroll") for (int m = 0; m < 4; ++m) _Pragma("unroll") for (int n = 0; n < 2; ++n) \
        { const i32x8_t _b = PG8_CAT(Bt[n]), _a = PG8_CAT(At[m]); asm("v_mfma_f32_16x16x128_f8f6f4 %0, %1, %2, %0" : "+v"(acc[ai][bj][m][n]) : "v"(_b), "v"(_a)); } __builtin_amdgcn_s_setprio(0); } while (0)
#define PG8_MM(ai, bj, At, Bt) do { if (F8) PG8_MMA8(ai, bj, At, Bt); else PG8_MMA(ai, bj, At, Bt); } while (0)
#define PG8_MMZ(ai, bj, At, Bt) do { if (F8) { __builtin_amdgcn_s_setprio(1); _Pragma("unroll") for (int m = 0; m < 4; ++m) _Pragma("unroll") for (int n = 0; n < 2; ++n) \
        { const i32x8_t _b = PG8_CAT(Bt[n]), _a = PG8_CAT(At[m]); asm("v_mfma_f32_16x16x128_f8f6f4 %0, %1, %2, 0" : "=&v"(acc[ai][bj][m][n]) : "v"(_b), "v"(_a)); } __builtin_amdgcn_s_setprio(0); } \
        else { _Pragma("unroll") for (int m = 0; m < 4; ++m) _Pragma("unroll") for (int n = 0; n < 2; ++n) acc[ai][bj][m][n] = (f32x4){0.f, 0.f, 0.f, 0.f}; PG8_MMA(ai, bj, At, Bt); } } while (0)
#define PG8_MMF(FIRST, ai, bj, At, Bt) do { if (FIRST) PG8_MMZ(ai, bj, At, Bt); else PG8_MM(ai, bj, At, Bt); } while (0)
#define PG8_WAIT_V(n) asm volatile("s_waitcnt vmcnt(" #n ")" ::: "memory")
#define PG8_WAIT_L(n) asm volatile("s_waitcnt lgkmcnt(" #n ")" ::: "memory")
#define PG8_BAR __builtin_amdgcn_s_barrier()
#define PG8_SCHED __builtin_amdgcn_sched_barrier(0)
#define PG8_AOFFS(dst, u) do { int _R, _C; stage_rc((wid * 64 + lane_id()) * 16, _R, _C);     \
        _Pragma("unroll") for (int _h = 0; _h < 2; ++_h) _Pragma("unroll") for (int _i = 0; _i < 2; ++_i) \
        dst[_h][_i] = (unsigned)S.arow(u, _h * HALF + _R + 64 * _i) * (unsigned)(g.lda * ES) + (unsigned)(_C * 2); } while (0)
    Unit cur, nxt; int ui = 0;
    if (!S.next(0, cur)) return;
    f32x4 acc[2][2][4][2];
    bf16x8 At[4][2], B0[2][2], B1[2][2];
    unsigned oc[2][2], on[2][2], rc[2];
#pragma unroll
    for (int i = 0; i < 2; ++i) rc[i] = (unsigned)RA[i] * (unsigned)(g.lda * ES) + (unsigned)CA[i];
    const char* gA = (const char*)g.A;
    const size_t hstepA = (size_t)HALF * g.lda * ES;
    const char* uA = gA; const char* nA = gA;
    if (Sched::LAZY) uA = gA + (size_t)S.arow(cur, 0) * (size_t)(g.lda * ES); else { PG8_AOFFS(oc, cur); }
#define PG8_STAGE_A(bufoff, pAff, pGat, offGat) do { if (Sched::LAZY) PG8_STAGE1(bufoff, pAff, rc[0], pA); else PG8_STAGE(bufoff, pGat, offGat); } while (0)
    const char* cB = (const char*)g.Bt + S.boff(cur) * ES;
    PG8_STAGE1(PG8_SB(0, 0), cB, voffB[0], pB); PG8_STAGE1(PG8_SB(0, 1), cB + hstepB, voffB[0], pB); PG8_STAGE_A(PG8_SA(0, 0), uA, gA, oc[0]); PG8_STAGE_A(PG8_SA(0, 1), uA + hstepA, gA, oc[1]);
    if (wr == 1) PG8_BAR;
    PG8_WAIT_V(2); PG8_BAR;
    PG8_STAGE1(PG8_SB(1, 0), cB + kstep, voffB[0], pB); PG8_STAGE_A(PG8_SA(1, 0), uA + kstep, gA + kstep, oc[0]); PG8_STAGE1(PG8_SB(1, 1), cB + hstepB + kstep, voffB[0], pB);
    PG8_WAIT_V(6); PG8_BAR;
    for (;;) {
        const bool has_next = S.next(ui + 1, nxt);
        const char* nB = has_next ? (const char*)g.Bt + S.boff(nxt) * ES : cB;
        if (Sched::LAZY) nA = has_next ? gA + (size_t)S.arow(nxt, 0) * (size_t)(g.lda * ES) : uA;
#define PG8_BODY(FIRST, LAST) do { \
            const char* a1 = gA + (size_t)(t + 1) * kstep; \
            const char* a2 = (LAST) ? gA : gA + (size_t)(t + 2) * kstep; const char* b2 = (LAST) ? nB : cB + (size_t)(t + 2) * kstep; \
            const char* a3 = a2 + kstep; const char* b3 = b2 + kstep; \
            const char* p1 = uA + (size_t)(t + 1) * kstep; const char* p2 = (LAST) ? nA : uA + (size_t)(t + 2) * kstep; const char* p3 = p2 + kstep;     \
              \
            PG8_LDB(B0, 0, 0); PG8_LDB(B1, 0, 1); PG8_SCHED; PG8_LDA(At, 0, 0); PG8_STAGE_A(PG8_SA(1, 1), p1 + hstepA, a1, oc[1]); \
            PG8_WAIT_V(8); PG8_WAIT_L(0); PG8_BAR; PG8_MMF(FIRST, 0, 0, At, B0); PG8_MMF(FIRST, 0, 1, At, B1); PG8_BAR; PG8_SCHED; \
              \
            PG8_LDA(At, 0, 1); PG8_STAGE1(PG8_SB(0, 0), b2, voffB[0], pB); PG8_STAGE1(PG8_SB(0, 1), b2 + hstepB, voffB[0], pB); \
            if (LAST) PG8_STAGE_A(PG8_SA(0, 0), p2, a2, on[0]); else PG8_STAGE_A(PG8_SA(0, 0), p2, a2, oc[0]); \
            PG8_WAIT_V(8); PG8_WAIT_L(0); PG8_BAR; PG8_MMF(FIRST, 1, 0, At, B0); PG8_MMF(FIRST, 1, 1, At, B1); PG8_BAR; PG8_SCHED; \
              \
            PG8_LDB(B0, 1, 0); PG8_LDB(B1, 1, 1); PG8_SCHED; PG8_LDA(At, 1, 0); \
            if (LAST) PG8_STAGE_A(PG8_SA(0, 1), p2 + hstepA, a2, on[1]); else PG8_STAGE_A(PG8_SA(0, 1), p2 + hstepA, a2, oc[1]); \
            PG8_WAIT_V(8); PG8_WAIT_L(0); PG8_BAR; PG8_MM(0, 0, At, B0); PG8_MM(0, 1, At, B1); PG8_BAR; PG8_SCHED; \
              \
            PG8_LDA(At, 1, 1); PG8_STAGE1(PG8_SB(1, 0), b3, voffB[0], pB); PG8_STAGE1(PG8_SB(1, 1), b3 + hstepB, voffB[0], pB); \
            if (LAST) PG8_STAGE_A(PG8_SA(1, 0), p3, a3, on[0]); else PG8_STAGE_A(PG8_SA(1, 0), p3, a3, oc[0]); \
            PG8_WAIT_V(8); PG8_WAIT_L(0); PG8_BAR; PG8_MM(1, 0, At, B0); PG8_MM(1, 1, At, B1); PG8_BAR; PG8_SCHED; \
        } while (0)
        { const int t = 0; PG8_BODY(true, false); }
        if (!Sched::LAZY) { if (has_next) { PG8_AOFFS(on, nxt); } else {
#pragma unroll
            for (int _h = 0; _h < 2; ++_h)
#pragma unroll
                for (int _i = 0; _i < 2; ++_i) on[_h][_i] = oc[_h][_i]; } }
#pragma unroll 1
        for (int t = 2; t < nt - 2; t += 2) {
            if constexpr (Epi::MIDT > 0) if (t == Epi::MIDT) {
                if (F8) asm volatile("s_nop 15\n\ts_nop 7" ::: "memory");
                const int le = lane_id(); E.mid(acc, cur, wr, wc, le & 15, le >> 4); }
            PG8_BODY(false, false); }
        { const int t = nt - 2;
          PG8_BODY(false, true); }
#undef PG8_BODY
        if (F8) asm volatile("s_nop 15\n\ts_nop 7" ::: "memory");
        if (wr == 0) PG8_BAR;
        { const int le = lane_id(); E(acc, cur, wr, wc, le & 15, le >> 4); }
        if (!has_next) break;
        cur = nxt; cB = nB; ++ui;
        if (Sched::LAZY) { uA = nA; } else {
#pragma unroll
        for (int _h = 0; _h < 2; ++_h)
#pragma unroll
            for (int _i = 0; _i < 2; ++_i) oc[_h][_i] = on[_h][_i]; }
        if (wr == 1) PG8_BAR;
    }
    PG8_WAIT_V(0);
    PG8_BAR;
#undef PG8_SA
#undef PG8_SB
#undef PG8_SBR
#undef PG8_STAGE
#undef PG8_STAGE1
#undef PG8_DMA
#undef PG8_STAGE_A
#undef PG8_LDA
#undef PG8_LDB
#undef PG8_MMA
#undef PG8_MMA8
#undef PG8_MM
#undef PG8_CAT
#undef PG8_WAIT_V
#undef PG8_WAIT_L
#undef PG8_BAR
#undef PG8_SCHED
#undef PG8_AOFFS
}
}

struct Args { const float* in[29]; float* out; unsigned char* ws; int ph_lo, ph_hi; };
struct Frame {
    LAS unsigned char* lds;
    unsigned char* ws; gu32* ctl;
    int tid, lane, wave, G, bid;
    const __attribute__((address_space(4))) unsigned char* ka;
    float* out;
    __device__ __forceinline__ const float* inp(int k) const { return *(const float* const __attribute__((address_space(4)))*)(ka + 8 * k); }
};
#define WS_DPP(v, CTRL) ((v) + __uint_as_float((unsigned)__builtin_amdgcn_update_dpp(0, (int)__float_as_uint(v), (CTRL), 0xF, 0xF, true)))
__device__ __forceinline__ float wave_sum(float v) {
    v = WS_DPP(v, 0xB1); v = WS_DPP(v, 0x4E); v = WS_DPP(v, 0x141); v = WS_DPP(v, 0x140);
    { auto r = __builtin_amdgcn_permlane16_swap(__float_as_uint(v), __float_as_uint(v), false, false); v = __uint_as_float(r[0]) + __uint_as_float(r[1]); }
    { auto r = __builtin_amdgcn_permlane32_swap(__float_as_uint(v), __float_as_uint(v), false, false); v = __uint_as_float(r[0]) + __uint_as_float(r[1]); }
    return v;
}
__device__ __forceinline__ float sigmoid_f(float v) { return __builtin_amdgcn_rcpf(1.f + __builtin_amdgcn_exp2f(-LOG2E * v)); }
__device__ __forceinline__ float silu_f(float v) { return v * sigmoid_f(v); }
__device__ __forceinline__ float red32(float a, float b) { auto r = __builtin_amdgcn_permlane32_swap(__float_as_uint(a), __float_as_uint(b), false, false); return __uint_as_float(r[0]) + __uint_as_float(r[1]); }
__device__ __forceinline__ float red16(float a, float b) { auto r = __builtin_amdgcn_permlane16_swap(__float_as_uint(a), __float_as_uint(b), false, false); return __uint_as_float(r[0]) + __uint_as_float(r[1]); }
__device__ __forceinline__ float row_sum(float v) { v = WS_DPP(v, 0xB1); v = WS_DPP(v, 0x4E); v = WS_DPP(v, 0x141); v = WS_DPP(v, 0x140); return v; }
__device__ __forceinline__ float lane_val(float v, int l) { return __uint_as_float((unsigned)__builtin_amdgcn_readlane((int)__float_as_uint(v), l)); }
typedef float f32x2 __attribute__((ext_vector_type(2)));
#define PKFMA_LO(acc, p, w) asm("v_pk_fma_f32 %0, %1, %2, %0 op_sel_hi:[0,1,1]" : "+v"(acc) : "v"(p), "v"(w))
#define PKFMA_HI(acc, p, w) asm("v_pk_fma_f32 %0, %1, %2, %0 op_sel:[1,0,0] op_sel_hi:[1,1,1]" : "+v"(acc) : "v"(p), "v"(w))
__device__ __forceinline__ float xsum16(float x) { auto r = __builtin_amdgcn_permlane16_swap(__float_as_uint(x), __float_as_uint(x), false, false); return __uint_as_float(r[0]) + __uint_as_float(r[1]); }
__device__ __forceinline__ float xsum32(float x) { auto r = __builtin_amdgcn_permlane32_swap(__float_as_uint(x), __float_as_uint(x), false, false); return __uint_as_float(r[0]) + __uint_as_float(r[1]); }
__device__ __forceinline__ unsigned pk4_fp8(float a, float b, float c, float d) { int w = 0; w = __builtin_amdgcn_cvt_pk_fp8_f32(a, b, w, false); w = __builtin_amdgcn_cvt_pk_fp8_f32(c, d, w, true); return (unsigned)w; }
__device__ __forceinline__ unsigned pk4_u8(float a, float b, float c, float d) {
    const unsigned ua = (unsigned)(a * 255.f + 0.5f), ub = (unsigned)(b * 255.f + 0.5f), uc = (unsigned)(c * 255.f + 0.5f), ud = (unsigned)(d * 255.f + 0.5f); return ua | (ub << 8) | (uc << 16) | (ud << 24); }
__device__ __forceinline__ unsigned sig4_u8(f32x4 a, float k) {
    unsigned w = 0;
#pragma unroll
    for (int i = 0; i < 4; ++i) { const float e = __builtin_amdgcn_exp2f(a[i] * k); const float r = __builtin_amdgcn_rcpf(fmaf(e, 1.f / 255.f, 1.f / 255.f)); w = __builtin_amdgcn_cvt_pk_u8_f32(r, (unsigned)i, w); }
    return w; }
__device__ __forceinline__ f32x4 un4_u8(unsigned w) { f32x4 r; r.x = (float)(w & 0xffu); r.y = (float)((w >> 8) & 0xffu); r.z = (float)((w >> 16) & 0xffu); r.w = (float)(w >> 24); return r * (1.f / 255.f); }

__constant__ float INV_FREQ[16] = {1.0f, 0.5623413324356079f, 0.3162277638912201f, 0.17782793939113617f, 0.10000000149011612f, 0.05623413249850273f, 0.03162277489900589f, 0.017782794311642647f,
    0.009999999776482582f, 0.005623413249850273f, 0.003162277629598975f, 0.0017782794311642647f, 0.0010000000474974513f, 0.000562341301701963f, 0.0003162277571391314f, 0.00017782794020604342f};
__device__ __forceinline__ double sin_poly(double r) { double r2 = r * r, t = r, s = r; for (int i = 1; i <= 12; ++i) { t *= -r2 / (double)((2 * i) * (2 * i + 1)); s += t; } return s; }
__device__ __forceinline__ double cos_poly(double r) { double r2 = r * r, t = 1.0, s = 1.0; for (int i = 1; i <= 12; ++i) { t *= -r2 / (double)((2 * i - 1) * (2 * i)); s += t; } return s; }
__device__ __forceinline__ void p0_adaln_rope(Frame& F) {
    const float* c = F.inp(1); const float* c_ctx = F.inp(3); const float* w_ada = F.inp(4); const float* b_ada = F.inp(5);
    float* MOD = (float*)(F.ws + WS_MOD);
    { float* RP = (float*)(F.ws + WS_ROPE);
      const int gi = F.bid * NTHR + F.tid;
      if (gi < 192 * 16) { const int pos = gi >> 4, f = gi & 15; const int p = pos < 128 ? pos : pos - 128;
          const float invf = INV_FREQ[f]; const float ang = (float)p * invf;
          const double a = (double)ang; const double k = rint(a * 0.15915494309189535); const double r = a - k * 6.283185307179586477;
          const float cs = (float)cos_poly(r), sn = (float)sin_poly(r);
          if (pos < 128) { RP[pos * 16 + f] = cs; RP[2048 + pos * 16 + f] = sn; } else { RP[4096 + p * 16 + f] = cs; RP[4096 + 1024 + p * 16 + f] = sn; } } }
    const int ab = F.G >= 192 ? F.bid - (F.G - 96) : F.bid;
    if (ab >= 0 && ab < 96) {
        LAS float* S = (LAS float*)F.lds;
        LAS float* R = S + 5 * 1024;
#pragma unroll
        for (int i = F.tid; i < 5 * 1024; i += NTHR) { const int r = i >> 10, k = i & 1023; const float v = r < 4 ? c[r * 1024 + k] : c_ctx[k]; S[i] = silu_f(v); }
        __syncthreads();
        for (int item = ab; item < 96; item += (F.G >= 192 ? 96 : F.G)) {
            const int c0 = item * 64; float acc[5] = {0.f, 0.f, 0.f, 0.f, 0.f};
#pragma unroll 1
            for (int k0 = 0; k0 < 128; k0 += 64) {
                float w[64]; const float* bp = w_ada + (size_t)(__builtin_amdgcn_readfirstlane(F.wave) * 128 + k0) * 6144 + c0;
                const unsigned lo = (unsigned)F.lane * 4u;
#pragma unroll
                for (int kk = 0; kk < 64; ++kk) w[kk] = *(const float*)((const char*)(bp + (size_t)kk * 6144) + lo);
                asm volatile("" ::: "memory");
#pragma unroll
                for (int kk = 0; kk < 64; ++kk) { const int k = F.wave * 128 + k0 + kk;
#pragma unroll
                    for (int r = 0; r < 5; ++r) acc[r] += S[r * 1024 + k] * w[kk]; } }
#pragma unroll
            for (int r = 0; r < 5; ++r) R[(F.wave * 5 + r) * 64 + F.lane] = acc[r];
            __syncthreads();
            if (F.tid < 320) { const int r = F.tid >> 6, l = F.tid & 63; float s = 0.f;
#pragma unroll
                for (int w = 0; w < 8; ++w) s += R[(w * 5 + r) * 64 + l];
                MOD[r * 6144 + c0 + l] = s + b_ada[c0 + l]; }
            __syncthreads();
        }
    }
}

__device__ __forceinline__ void norm_mod_row(const float* xrow, const float* nw, const float* scale, const float* shift, int lane, f32x4 (&v)[4]) {
    const GAS f32x4* xr = (const GAS f32x4*)xrow + lane; float ss = 0.f;
#pragma unroll
    for (int j = 0; j < 4; ++j) { v[j] = xr[64 * j]; ss += (v[j].x * v[j].x + v[j].y * v[j].y) + (v[j].z * v[j].z + v[j].w * v[j].w); }
    const float rstd = __builtin_amdgcn_rsqf(wave_sum(ss) * (1.f / D) + EPS);
#pragma unroll
    for (int j = 0; j < 4; ++j) { const int d0 = 4 * lane + 256 * j; const f32x4 w = *(const f32x4*)(nw + d0), sc = *(const f32x4*)(scale + d0), sh = *(const f32x4*)(shift + d0);
        v[j] = (v[j] * rstd * w) * (1.f + sc) + sh; }
}
__device__ __forceinline__ void store_row_bf16(bf16* orow, int lane, const f32x4 (&v)[4]) {
    GAS u32x2* o8 = (GAS u32x2*)orow + lane;
#pragma unroll
    for (int j = 0; j < 4; ++j) { u32x2 w; w.x = pk2(v[j].x, v[j].y); w.y = pk2(v[j].z, v[j].w); o8[64 * j] = w; }
}
__device__ __forceinline__ void store_row_fp8(unsigned char* orow, int lane, const f32x4 (&v)[4]) {
    GAS unsigned* o4 = (GAS unsigned*)orow + lane;
#pragma unroll
    for (int j = 0; j < 4; ++j) o4[64 * j] = pk4_fp8(v[j].x, v[j].y, v[j].z, v[j].w);
}
__device__ __forceinline__ void p1a_norm1(Frame& F) {
    const float* x = F.inp(0); const float* ctx = F.inp(2); const float* nw = F.inp(6);
    const float* MOD = (const float*)(F.ws + WS_MOD); unsigned char* XN = F.ws + WS_XN;
    const bool split = F.G == 256;
    const int gw = F.bid * 8 + F.wave, NGW = (split ? 208 : F.G) * 8, MR = split ? T : MROWS;
    auto rowp = [&](int m) { return m < T ? x + (size_t)m * D : ctx + (size_t)(m - T) * D; };
    f32x4 nx[4];
    if (gw < MR) { const GAS f32x4* xr = (const GAS f32x4*)rowp(gw) + F.lane;
#pragma unroll
        for (int j = 0; j < 4; ++j) nx[j] = xr[64 * j]; }
    for (int m = gw; m < MR; m += NGW) {
        const int mr = m < T ? m / SEQ : 4; f32x4 v[4];
#pragma unroll
        for (int j = 0; j < 4; ++j) v[j] = nx[j];
        if (m + NGW < MR) { const GAS f32x4* xr = (const GAS f32x4*)rowp(m + NGW) + F.lane;
#pragma unroll
            for (int j = 0; j < 4; ++j) nx[j] = xr[64 * j]; }
        float ss = 0.f;
#pragma unroll
        for (int j = 0; j < 4; ++j) ss += (v[j].x * v[j].x + v[j].y * v[j].y) + (v[j].z * v[j].z + v[j].w * v[j].w);
        const float rstd = __builtin_amdgcn_rsqf(wave_sum(ss) * (1.f / D) + EPS);
        const float* scale = MOD + mr * 6144 + 1024; const float* shift = MOD + mr * 6144;
#pragma unroll
        for (int j = 0; j < 4; ++j) { const int d0 = 4 * F.lane + 256 * j; const f32x4 w = *(const f32x4*)(nw + d0), sc = *(const f32x4*)(scale + d0), sh = *(const f32x4*)(shift + d0);
            v[j] = (v[j] * rstd * w) * (1.f + sc) + sh; }
        store_row_fp8(XN + (size_t)m * D, F.lane, v);
    }
}

__device__ __forceinline__ int kv_row(int m) { if (m < T) { const int b = m / SEQ, t = m - b * SEQ; return b * KVL + CTX + t; } const int cm = m - T, b = cm / CTX, c = cm - b * CTX; return b * KVL + c; }

__device__ __forceinline__ void p0_transpose_item(const float* W, int K, int N, bf16* WT, int kb, int n0, int dst_row0, LAS float* scr, int lane) {
    const int k0 = 64 * kb;
    { float wv[32]; const float* wp = W + (size_t)(k0 + (lane >> 5)) * N + n0 + (lane & 31);
#pragma unroll
      for (int i = 0; i < 32; ++i) wv[i] = wp[(size_t)(2 * i) * N];
#pragma unroll
      for (int i = 0; i < 32; ++i) scr[(2 * i + (lane >> 5)) * 33 + (lane & 31)] = wv[i]; }
    asm volatile("s_waitcnt lgkmcnt(0)" ::: "memory");
    const int c = lane & 7;
#pragma unroll
    for (int j = 0; j < 4; ++j) { const int n = (lane >> 3) + 8 * j; const LAS float* sp = scr + (8 * c) * 33 + n;
        u32x4 o; o.x = pk2(sp[0 * 33], sp[1 * 33]); o.y = pk2(sp[2 * 33], sp[3 * 33]); o.z = pk2(sp[4 * 33], sp[5 * 33]); o.w = pk2(sp[6 * 33], sp[7 * 33]);
        *(GAS u32x4*)(WT + (size_t)(dst_row0 + n) * K + k0 + 8 * c) = o; }
    asm volatile("s_waitcnt lgkmcnt(0)" ::: "memory");
}
constexpr float WSCALE = 32.f, WINV = 1.f / 32.f;
constexpr float OBSCALE = 16.f;
template <bool REMAP = false> __device__ __forceinline__ void p0_transpose_item8(const float* W, int K, int N, unsigned char* WT, int kb, int n0, int dst_row0, LAS float* scr, int lane, int pitch = 0) {
    if (pitch == 0) pitch = K;
    const int k0 = 64 * kb;
    { float wv[32]; const float* wp = W + (size_t)(k0 + (lane >> 5)) * N + n0 + (lane & 31);
#pragma unroll
      for (int i = 0; i < 32; ++i) wv[i] = wp[(size_t)(2 * i) * N];
#pragma unroll
      for (int i = 0; i < 32; ++i) scr[(2 * i + (lane >> 5)) * 33 + (lane & 31)] = wv[i] * WSCALE; }
    asm volatile("s_waitcnt lgkmcnt(0)" ::: "memory");
    const int c = lane & 7;
#pragma unroll
    for (int j = 0; j < 4; ++j) { const int n = (lane >> 3) + 8 * j; const LAS float* sp = scr + (8 * c) * 33 + n;
        u32x2 o; o.x = pk4_fp8(sp[0 * 33], sp[1 * 33], sp[2 * 33], sp[3 * 33]); o.y = pk4_fp8(sp[4 * 33], sp[5 * 33], sp[6 * 33], sp[7 * 33]);
        const int nr = REMAP ? 8 * ((n >> 2) & 3) + 4 * (n >> 4) + (n & 3) : n;
        *(GAS u32x2*)(WT + (size_t)(dst_row0 + nr) * pitch + k0 + 8 * c) = o; }
    asm volatile("s_waitcnt lgkmcnt(0)" ::: "memory");
}
__device__ __forceinline__ int inproj_dst_row(int n0) { const int pn = n0 >> 8, w = n0 & 255, g = w >> 6, a = (w >> 5) & 1; return 256 * pn + 128 * a + 32 * g; }
__device__ __forceinline__ void p0_weights(Frame& F) {
    LAS float* scr = (LAS float*)(F.lds + 65536 + F.wave * 8704);
    const int gw = F.bid * 8 + F.wave, NGW = F.G * 8;
    constexpr int I_IN = 16 * 208, I_A = 16 * 32, I_B = 8 * 32, I_O = 16 * 32, I_G = 32 * 16 * 16, I_D = 32 * 8 * 32;
    constexpr int NITEMS = I_IN;
    (void)I_A; (void)I_B; (void)I_O; (void)I_G; (void)I_D;
    for (int it = gw; it < NITEMS; it += NGW) {
        int r = it;
        if (r < I_IN) { const int kb = r / 208, n0 = (r % 208) * 32;
            if (n0 < 2048) p0_transpose_item8<true>(F.inp(8), 1024, NIN, F.ws + WS_WIN, kb, n0, inproj_dst_row(n0), scr, F.lane);
            else p0_transpose_item8(F.inp(8), 1024, NIN, F.ws + WS_WIN, kb, n0, inproj_dst_row(n0), scr, F.lane);
            continue; } r -= I_IN;
        if (r < I_A) { const int kb = r / 32, n0 = (r % 32) * 32; p0_transpose_item8(F.inp(19), 1024, 1024, F.ws + WS_WC + 512, kb, n0, n0, scr, F.lane, OCP); continue; } r -= I_A;
        if (r < I_B) { const int kb = r / 32, n0 = (r % 32) * 32; p0_transpose_item8(F.inp(20), 512, 1024, F.ws + WS_WC, kb, n0, n0, scr, F.lane, OCP); continue; } r -= I_B;
        if (r < I_O) { const int kb = r / 32, n0 = (r % 32) * 32; p0_transpose_item8(F.inp(21), 1024, 1024, F.ws + WS_WO, kb, n0, n0, scr, F.lane); continue; } r -= I_O;
        if (r < 2 * I_G) { const int up = r >= I_G; if (up) r -= I_G; const int e = r / 256, q = r % 256, kb = q / 16, n0 = (q % 16) * 32;
            const int drow = 256 * (n0 >> 7) + 128 * up + (n0 & 127);
            p0_transpose_item8(F.inp(up ? 27 : 26) + (size_t)e * 1024 * EH, 1024, EH, F.ws + WS_WGU + (size_t)e * 1024 * 1024, kb, n0, drow, scr, F.lane); continue; } r -= 2 * I_G;
        { const int e = r / 256, q = r % 256, kb = q / 32, n0 = (q % 32) * 32;
            p0_transpose_item8(F.inp(28) + (size_t)e * EH * 1024, EH, 1024, F.ws + WS_WD + (size_t)e * 1024 * EH, kb, n0, n0, scr, F.lane); }
    }
}

struct InProjOrder {
    static constexpr bool LAZY = true;
    pg8::DenseOrder d;
    __device__ __forceinline__ bool next(int i, pg8::Unit& u) const {
        long L = (long)i * d.G + d.c;
        if (L < d.nwg) return d.map(L, u);
        const int j = (int)(L - d.nwg); if (j >= 48 || d.G == 256) return false;
        const int c = j % 12; u.pm = 128 + j / 12; u.pn = c < 8 ? 4 + c : 14 + (c - 8); u.a0 = 0; u.a1 = 0; return true;
    }
    __device__ __forceinline__ int arow(const pg8::Unit& u, int r) const { return u.pm * 256 + r; }
    __device__ __forceinline__ size_t boff(const pg8::Unit& u) const { return (size_t)u.pn * 256 * 1024; }
};
struct EpiInProj {
    static constexpr int MIDT = 0; static constexpr bool PERM = true;
    unsigned char* ws; bf16* GA; const LAS float* RPL;
    __device__ __forceinline__ void operator()(const f32x4 (&acc)[2][2][4][2], const pg8::Unit& u, int wr, int wc, int fr_, int fq_) const {
        int fr = fr_, fq = fq_; asm volatile("" : "+v"(fr), "+v"(fq));
        const int pn = u.pn, cg = 4 * pn + wc;
        const LAS float* gq_a = RPL + 6144; const LAS float* gk_a = gq_a + 64; const LAS float* gq_b = gq_a + 128; const LAS float* gk_b = gq_a + 192;
        int kind; const LAS float* gain = nullptr; bool rope = false; float oscale = 1.f; bf16* dbase; int pitch, ccol; bool kvrow = false;
        if (cg < 16)      { kind = 0; gain = gq_a; rope = true; oscale = C2; dbase = (bf16*)(ws + WS_QA); pitch = D; ccol = cg * 64; }
        else if (cg < 32) { kind = 0; gain = gk_a; rope = true; dbase = (bf16*)(ws + WS_KA); pitch = D; ccol = (cg - 16) * 64; kvrow = true; }
        else if (cg < 48) { kind = 1; dbase = (bf16*)(ws + WS_VA); pitch = D; ccol = (cg - 32) * 64; kvrow = true; }
        else if (cg < 56) { kind = 0; gain = gq_b; oscale = C2; dbase = (bf16*)(ws + WS_QB); pitch = 512; ccol = (cg - 48) * 64; }
        else if (cg < 64) { kind = 0; gain = gk_b; dbase = (bf16*)(ws + WS_KB); pitch = 512; ccol = (cg - 56) * 64; kvrow = true; }
        else if (cg < 72) { kind = 1; dbase = (bf16*)(ws + WS_VB); pitch = 512; ccol = (cg - 64) * 64; kvrow = true; }
        else if (cg < 88) { kind = 2; dbase = GA; pitch = D; ccol = (cg - 72) * 64; }
        else              { kind = 2; dbase = GA; pitch = D; ccol = (cg - 88) * 64 + T * D; }
        const bool latent = u.pm < 128; if (!latent) rope = false;
        const LAS float* RP = RPL;
        const bool pairs = cg < 32;
        const int dadd = !kvrow ? 0 : latent ? ((u.pm * 256) >> 13) * CTX + CTX : (u.pm - 128) * SEQ - T;
        auto run = [&](auto kc_, auto rope_, auto pairs_) {
        constexpr int KIND = decltype(kc_)::value; constexpr bool ROPE = decltype(rope_)::value, PAIRS = decltype(pairs_)::value;
        f32x4 gn[2][2];
        if constexpr (KIND == 0) {
#pragma unroll
            for (int bj = 0; bj < 2; ++bj)
#pragma unroll
                for (int n = 0; n < 2; ++n) gn[bj][n] = *(const LAS f32x4*)(gain + 32 * bj + (PAIRS ? 16 * n + 4 * fq : 8 * fq + 4 * n)) * oscale;
        }
#pragma unroll
        for (int ai = 0; ai < 2; ++ai)
#pragma unroll
            for (int m = 0; m < 4; ++m) {
                const int row = u.pm * 256 + ai * 128 + wr * 64 + m * 16 + fr;
                f32x4 v[2][2];
                if constexpr (KIND == 0) {
                    float ss = 0.f;
#pragma unroll
                    for (int bj = 0; bj < 2; ++bj)
#pragma unroll
                        for (int n = 0; n < 2; ++n) { const f32x4 a = acc[ai][bj][m][n]; ss += (a.x * a.x + a.y * a.y) + (a.z * a.z + a.w * a.w); }
                    ss = xsum16(ss); ss = xsum32(ss);
                    const float rstd = __builtin_amdgcn_rsqf(ss * (WINV * WINV / 64.f) + EPS) * WINV;
#pragma unroll
                    for (int bj = 0; bj < 2; ++bj)
#pragma unroll
                        for (int n = 0; n < 2; ++n) v[bj][n] = acc[ai][bj][m][n] * rstd * gn[bj][n];
                    if constexpr (ROPE) {
                        const int t = row & (SEQ - 1), pr = t >> 6, pc = t & 63;
#pragma unroll
                        for (int bj = 0; bj < 2; ++bj) { const LAS float* tb = RP + (bj ? 4096 + pc * 16 : pr * 16) + 4 * fq; const int so = bj ? 1024 : 2048;
                            const f32x4 cs = *(const LAS f32x4*)tb, sn = *(const LAS f32x4*)(tb + so); const f32x4 x1 = v[bj][0], x2 = v[bj][1];
                            v[bj][0] = x1 * cs - x2 * sn; v[bj][1] = x1 * sn + x2 * cs; }
                    }
                }
                if constexpr (KIND == 1) {
#pragma unroll
                    for (int bj = 0; bj < 2; ++bj)
#pragma unroll
                        for (int n = 0; n < 2; ++n) v[bj][n] = acc[ai][bj][m][n] * WINV;
                }
                const int drow = row + dadd;
                if constexpr (KIND == 2) { unsigned char* gp = (unsigned char*)dbase + (size_t)row * D + ccol + 8 * fq;
#pragma unroll
                    for (int bj = 0; bj < 2; ++bj) { u32x2 w; w.x = sig4_u8(acc[ai][bj][m][0], -LOG2E * WINV); w.y = sig4_u8(acc[ai][bj][m][1], -LOG2E * WINV); *(GAS u32x2*)(gp + 32 * bj) = w; }
                    continue; }
                if constexpr (KIND == 0 && PAIRS) {
                    unsigned char* qp = (unsigned char*)dbase + (size_t)drow * pitch + ccol + ((fq & 1) ? 16 + 4 * (fq - 1) : 4 * fq);
#pragma unroll
                    for (int bj = 0; bj < 2; ++bj) { const unsigned wa = pk4_fp8(v[bj][0].x, v[bj][0].y, v[bj][0].z, v[bj][0].w), wb = pk4_fp8(v[bj][1].x, v[bj][1].y, v[bj][1].z, v[bj][1].w);
                        auto rr = __builtin_amdgcn_permlane16_swap(wa, wb, false, false); u32x2 w; w.x = rr[0]; w.y = rr[1]; *(GAS u32x2*)(qp + 32 * bj) = w; }
                    continue; }
                if constexpr (KIND == 0) { unsigned char* qp = (unsigned char*)dbase + (size_t)drow * pitch + ccol + 8 * fq;
#pragma unroll
                    for (int bj = 0; bj < 2; ++bj) { u32x2 w; w.x = pk4_fp8(v[bj][0].x, v[bj][0].y, v[bj][0].z, v[bj][0].w); w.y = pk4_fp8(v[bj][1].x, v[bj][1].y, v[bj][1].z, v[bj][1].w); *(GAS u32x2*)(qp + 32 * bj) = w; }
                    continue; }
                if constexpr (KIND == 1) {
                    const int odd = fr & 1; unsigned char* vp = (unsigned char*)dbase + (size_t)(drow >> 1) * (2 * pitch) + (ccol + 8 * fq + 4 * odd) * 2;
#pragma unroll
                    for (int bj = 0; bj < 2; ++bj) { const unsigned w0 = pk4_fp8(v[bj][0].x, v[bj][0].y, v[bj][0].z, v[bj][0].w), w1 = pk4_fp8(v[bj][1].x, v[bj][1].y, v[bj][1].z, v[bj][1].w);
                        const unsigned keep = odd ? w1 : w0, send = odd ? w0 : w1;
                        const unsigned recv = (unsigned)__builtin_amdgcn_update_dpp(0, (int)send, 0xB1, 0xF, 0xF, true);
                        const unsigned lo = odd ? recv : keep, hh = odd ? keep : recv;
                        u32x2 w; w.x = __builtin_amdgcn_perm(hh, lo, 0x05010400u); w.y = __builtin_amdgcn_perm(hh, lo, 0x07030602u); *(GAS u32x2*)(vp + 64 * bj) = w; }
                    continue; }
            }
        };
        using TT = std::true_type; using FT = std::false_type;
        if (kind == 2) run(std::integral_constant<int, 2>{}, FT{}, FT{});
        else if (kind == 1) run(std::integral_constant<int, 1>{}, FT{}, FT{});
        else if (pairs) { if (rope) run(std::integral_constant<int, 0>{}, TT{}, TT{}); else run(std::integral_constant<int, 0>{}, FT{}, TT{}); }
        else run(std::integral_constant<int, 0>{}, FT{}, FT{});
    }
};
__device__ __forceinline__ void p1b_inproj_mfma(Frame& F) {
    pg8::Gemm g{(const bf16*)(F.ws + WS_XN), (const bf16*)(F.ws + WS_WIN), D, D, D};
    InProjOrder S; S.d.init(T, NIN, F.G, F.bid, D);
    LAS float* RPL = (LAS float*)(F.lds + 131072);
    { const float* RP = (const float*)(F.ws + WS_ROPE);
#pragma unroll
      for (int k = 0; k < 12; ++k) RPL[F.tid + k * NTHR] = RP[F.tid + k * NTHR];
      if (F.tid < 256) { const int k = F.tid >> 6; RPL[6144 + F.tid] = F.inp(k == 0 ? 9 : k == 1 ? 10 : k == 2 ? 16 : 17)[F.tid & 63]; } }
    __syncthreads();
    EpiInProj E{F.ws, (bf16*)F.out, RPL};
    pg8::gemm_phase<EpiInProj, InProjOrder, true>(F.lds, g, S, E, F.wave);
}
struct OneUnitOrder {
    static constexpr bool LAZY = true; int pm, pn;
    __device__ __forceinline__ bool next(int i, pg8::Unit& u) const { if (i != 0) return false; u.pm = pm; u.pn = pn; u.a0 = 0; u.a1 = 0; return true; }
    __device__ __forceinline__ int arow(const pg8::Unit& u, int r) const { return u.pm * 256 + r; }
    __device__ __forceinline__ size_t boff(const pg8::Unit& u) const { return (size_t)u.pn * 256 * 1024; }
};
__device__ __forceinline__ void p1c_ctx_units(Frame& F) {
    const float* ctx = F.inp(2); const float* nw = F.inp(6); const float* MOD = (const float*)(F.ws + WS_MOD); unsigned char* XN = F.ws + WS_XN;
    const int j = F.bid - 208, panel = j / 12, ct = j % 12;
    const float* scale = MOD + 4 * 6144 + 1024; const float* shift = MOD + 4 * 6144;
#pragma unroll 1
    for (int m = j * 8 + F.wave; m < TC; m += 384) {
        f32x4 v[4];
        { const GAS f32x4* xr = (const GAS f32x4*)(ctx + (size_t)m * D) + F.lane;
#pragma unroll
          for (int jj = 0; jj < 4; ++jj) v[jj] = xr[64 * jj]; }
        float ss = 0.f;
#pragma unroll
        for (int jj = 0; jj < 4; ++jj) ss += (v[jj].x * v[jj].x + v[jj].y * v[jj].y) + (v[jj].z * v[jj].z + v[jj].w * v[jj].w);
        const float rstd = __builtin_amdgcn_rsqf(wave_sum(ss) * (1.f / D) + EPS);
#pragma unroll
        for (int jj = 0; jj < 4; ++jj) { const int d0 = 4 * F.lane + 256 * jj; const f32x4 w = *(const f32x4*)(nw + d0), sc = *(const f32x4*)(scale + d0), sh = *(const f32x4*)(shift + d0);
            v[jj] = (v[jj] * rstd * w) * (1.f + sc) + sh; }
        store_row_fp8(XN + (size_t)(T + m) * D, F.lane, v);
    }
    LAS float* RPL = (LAS float*)(F.lds + 131072);
    { const float* RP = (const float*)(F.ws + WS_ROPE);
#pragma unroll
      for (int k = 0; k < 12; ++k) RPL[F.tid + k * NTHR] = RP[F.tid + k * NTHR];
      if (F.tid < 256) { const int k = F.tid >> 6; RPL[6144 + F.tid] = F.inp(k == 0 ? 9 : k == 1 ? 10 : k == 2 ? 16 : 17)[F.tid & 63]; } }
    asm volatile("s_waitcnt vmcnt(0) lgkmcnt(0)" ::: "memory");
    __syncthreads();
    if (F.wave == 0 && lane_id() == 0) {
        unsigned* sub = (unsigned*)(F.ctl + CW_SUB); unsigned* bar = (unsigned*)(F.ctl + CW_BAR);
        __builtin_amdgcn_fence(__ATOMIC_RELEASE, "agent");
        (void)xb_add(sub, 1u);
        XB_SPIN(xb_ld(sub) < 48u, bar);
        __builtin_amdgcn_fence(__ATOMIC_ACQUIRE, "agent");
    }
    __syncthreads();
    pg8::Gemm g{(const bf16*)(F.ws + WS_XN), (const bf16*)(F.ws + WS_WIN), D, D, D};
    OneUnitOrder S{128 + panel, ct < 8 ? 4 + ct : 14 + (ct - 8)};
    EpiInProj E{F.ws, (bf16*)F.out, RPL};
    pg8::gemm_phase<EpiInProj, OneUnitOrder, true>(F.lds, g, S, E, F.wave);
}

#define WM_DPP(v, CTRL) fmaxf((v), __uint_as_float((unsigned)__builtin_amdgcn_update_dpp(0, (int)__float_as_uint(v), (CTRL), 0xF, 0xF, true)))
__device__ __forceinline__ float wave_max_nonneg(float v) {
    v = WM_DPP(v, 0xB1); v = WM_DPP(v, 0x4E); v = WM_DPP(v, 0x141); v = WM_DPP(v, 0x140);
    { auto r = __builtin_amdgcn_permlane16_swap(__float_as_uint(v), __float_as_uint(v), false, false); v = fmaxf(__uint_as_float(r[0]), __uint_as_float(r[1])); }
    { auto r = __builtin_amdgcn_permlane32_swap(__float_as_uint(v), __float_as_uint(v), false, false); v = fmaxf(__uint_as_float(r[0]), __uint_as_float(r[1])); }
    return v;
}
__device__ __forceinline__ float uni(float v) { return __uint_as_float((unsigned)__builtin_amdgcn_readfirstlane((int)__float_as_uint(v))); }
__device__ __forceinline__ float lam_value(const Frame& F) {
    const int l = lane_id(); const float* q1 = F.inp(11); const float* k1 = F.inp(12); const float* q2 = F.inp(13); const float* k2 = F.inp(14);
    const float x1 = q1[l], y1 = k1[l], x2 = q2[l], y2 = k2[l];
    const float a = uni(wave_sum(x1 * y1)), b = uni(wave_sum(x2 * y2));
    return expf(a) - expf(b) + 0.2f;
}
__device__ __forceinline__ float qk_bound(const float* gq, const float* gk) {
    const int l = lane_id(); const float x = fabsf(gq[l]), y = fabsf(gk[l]);
    const float mq = uni(wave_max_nonneg(x)), mk = uni(wave_max_nonneg(y));
    return 8.0f * mq * mk * LOG2E * 1.02f + 0.1f;
}

typedef int i32x2 __attribute__((ext_vector_type(2)));
__device__ __forceinline__ void p4a_norm2_route(Frame& F) {
    const bf16* XMID = (const bf16*)(F.ws + WS_XMID); const float* nw = F.inp(7); const float* MOD = (const float*)(F.ws + WS_MOD);
    const float* w_rg = F.inp(22); const float* b_rg = F.inp(23); const float* w_re = F.inp(24); const float* b_re = F.inp(25);
    unsigned char* H2 = F.ws + WS_H2; i32x2* LIST = (i32x2*)(F.ws + WS_LIST);
    LAS float* WG = (LAS float*)F.lds;
    LAS float* WE = WG + 4096;
    auto slot = [](int krow) { return (((krow >> 8) * 4 + (krow & 3)) * 64 + ((krow & 255) >> 2)) * 4; };
#pragma unroll
    for (int k = 0; k < 8; ++k) { const int i = F.tid + k * NTHR; WG[slot(i >> 2) + (i & 3)] = w_rg[i]; }
#pragma unroll 1
    for (int k0 = 0; k0 < 64; k0 += 16) {
#pragma unroll
        for (int k = 0; k < 16; ++k) { const int i = F.tid + (k0 + k) * NTHR; WE[(i >> 13) * 8192 + ((i >> 2) & 1) * 4096 + slot((i >> 3) & 1023) + (i & 3)] = w_re[i]; } }
    __syncthreads();
    const int gw = F.bid * 8 + F.wave, NGW = F.G * 8;
    for (int m0 = gw; m0 < T; m0 += 2 * NGW) {
        f32x4 v[2][4]; bool ok[2]; int mm[2];
#pragma unroll
        for (int rr = 0; rr < 2; ++rr) { mm[rr] = m0 + rr * NGW; ok[rr] = mm[rr] < T; const int mr = ok[rr] ? mm[rr] : m0;
            const GAS u32x2* xr = (const GAS u32x2*)(XMID + (size_t)mr * D) + F.lane;
#pragma unroll
            for (int j = 0; j < 4; ++j) { const u32x2 w = xr[64 * j]; v[rr][j] = (f32x4){bf2f(w.x & 0xffffu), bf2f(w.x >> 16), bf2f(w.y & 0xffffu), bf2f(w.y >> 16)}; } }
        float lgs[2][4]; float ssq[2];
#pragma unroll
        for (int rr = 0; rr < 2; ++rr) { float ss = 0.f;
#pragma unroll
            for (int j = 0; j < 4; ++j) ss += (v[rr][j].x * v[rr][j].x + v[rr][j].y * v[rr][j].y) + (v[rr][j].z * v[rr][j].z + v[rr][j].w * v[rr][j].w);
            ssq[rr] = ss; }
        const float rs2 = __builtin_amdgcn_rsqf(row_sum(xsum16(red32(ssq[0], ssq[1]))) * (1.f / D) + EPS);
        f32x2 lg2[2][2];
#pragma unroll
        for (int rr = 0; rr < 2; ++rr) { const int b = (ok[rr] ? mm[rr] : m0) / SEQ; const float rstd = lane_val(rs2, 32 * rr);
            const float* scale = MOD + b * 6144 + 4096; const float* shift = MOD + b * 6144 + 3072;
#pragma unroll
            for (int j = 0; j < 4; ++j) { const int d0 = 4 * F.lane + 256 * j; const f32x4 w = *(const f32x4*)(nw + d0), sc = *(const f32x4*)(scale + d0), sh = *(const f32x4*)(shift + d0);
                v[rr][j] = (v[rr][j] * rstd * w) * (1.f + sc) + sh; }
            if (ok[rr]) store_row_fp8(H2 + (size_t)mm[rr] * D, F.lane, v[rr]);
            f32x2 l01 = {0.f, 0.f}, l23 = {0.f, 0.f};
#pragma unroll
            for (int j = 0; j < 4; ++j)
#pragma unroll
                for (int e = 0; e < 4; ++e) { const f32x4 w4 = *(const LAS f32x4*)(WG + ((j * 4 + e) * 64 + F.lane) * 4); const f32x2 wl = {w4.x, w4.y}, wh = {w4.z, w4.w};
                    const f32x2 p = (e < 2) ? (f32x2){v[rr][j].x, v[rr][j].y} : (f32x2){v[rr][j].z, v[rr][j].w};
                    if (e & 1) { PKFMA_HI(l01, p, wl); PKFMA_HI(l23, p, wh); } else { PKFMA_LO(l01, p, wl); PKFMA_LO(l23, p, wh); } }
            lg2[rr][0] = l01; lg2[rr][1] = l23; }
        { const float u0 = red32(lg2[0][0].x, lg2[1][0].x), u1 = red32(lg2[0][0].y, lg2[1][0].y), u2 = red32(lg2[0][1].x, lg2[1][1].x), u3 = red32(lg2[0][1].y, lg2[1][1].y);
          const float w0 = row_sum(red16(u0, u2)), w1 = row_sum(red16(u1, u3));
#pragma unroll
          for (int rr = 0; rr < 2; ++rr) { lgs[rr][0] = lane_val(w0, 32 * rr); lgs[rr][2] = lane_val(w0, 32 * rr + 16); lgs[rr][1] = lane_val(w1, 32 * rr); lgs[rr][3] = lane_val(w1, 32 * rr + 16); } }
        int gsel[2]; float gws[2]; float els[2][8]; f32x2 el2[2][4];
#pragma unroll
        for (int rr = 0; rr < 2; ++rr) { int g = 0; float gl[4];
#pragma unroll
            for (int c = 0; c < 4; ++c) gl[c] = lgs[rr][c] + b_rg[c];
            float gm = gl[0];
#pragma unroll
            for (int c = 1; c < 4; ++c) if (gl[c] > gm) { gm = gl[c]; g = c; }
            float gs = 0.f;
#pragma unroll
            for (int c = 0; c < 4; ++c) gs += __builtin_amdgcn_exp2f((gl[c] - gm) * LOG2E);
            gws[rr] = __builtin_amdgcn_rcpf(gs); g = __builtin_amdgcn_readfirstlane(g); gsel[rr] = g;
            f32x2 e01 = {0.f, 0.f}, e23 = {0.f, 0.f}, e45 = {0.f, 0.f}, e67 = {0.f, 0.f};
            const LAS float* we = WE + g * 8192;
#pragma unroll
            for (int j = 0; j < 4; ++j)
#pragma unroll
                for (int e = 0; e < 4; ++e) {
                    const f32x4 wa = *(const LAS f32x4*)(we + ((j * 4 + e) * 64 + F.lane) * 4), wb = *(const LAS f32x4*)(we + 4096 + ((j * 4 + e) * 64 + F.lane) * 4);
                    const f32x2 a0 = {wa.x, wa.y}, a1 = {wa.z, wa.w}, b0 = {wb.x, wb.y}, b1 = {wb.z, wb.w};
                    const f32x2 p = (e < 2) ? (f32x2){v[rr][j].x, v[rr][j].y} : (f32x2){v[rr][j].z, v[rr][j].w};
                    if (e & 1) { PKFMA_HI(e01, p, a0); PKFMA_HI(e23, p, a1); PKFMA_HI(e45, p, b0); PKFMA_HI(e67, p, b1); }
                    else       { PKFMA_LO(e01, p, a0); PKFMA_LO(e23, p, a1); PKFMA_LO(e45, p, b0); PKFMA_LO(e67, p, b1); } }
            el2[rr][0] = e01; el2[rr][1] = e23; el2[rr][2] = e45; el2[rr][3] = e67; }
        { float u[8];
#pragma unroll
          for (int e = 0; e < 8; ++e) u[e] = red32(el2[0][e >> 1][e & 1], el2[1][e >> 1][e & 1]);
#pragma unroll
          for (int e = 0; e < 4; ++e) { const float w = row_sum(red16(u[e], u[e + 4]));
#pragma unroll
              for (int rr = 0; rr < 2; ++rr) { els[rr][e] = lane_val(w, 32 * rr); els[rr][e + 4] = lane_val(w, 32 * rr + 16); } } }
#pragma unroll
        for (int rr = 0; rr < 2; ++rr) { const int g = gsel[rr]; float el[8];
#pragma unroll
            for (int e = 0; e < 8; ++e) el[e] = els[rr][e] + b_re[g * 8 + e];
            int i0 = 0; float v0 = el[0];
#pragma unroll
            for (int e = 1; e < 8; ++e) if (el[e] > v0) { v0 = el[e]; i0 = e; }
            int i1 = -1; float v1 = -3.0e38f;
#pragma unroll
            for (int e = 0; e < 8; ++e) if (e != i0 && el[e] > v1) { v1 = el[e]; i1 = e; }
            const float e1 = __builtin_amdgcn_exp2f((v1 - v0) * LOG2E), den = __builtin_amdgcn_rcpf(1.f + e1);
            const float w0 = gws[rr] * den, w1 = gws[rr] * e1 * den;
            if (F.lane < 2 && ok[rr]) {
                const int ge = F.lane * 32 + g * 8 + (F.lane ? i1 : i0);
                const unsigned p = atomicAdd((unsigned*)(F.ctl + CW_CNT + 64 * ge), 1u);
                i32x2 rec; rec.x = mm[rr]; rec.y = (int)__float_as_uint(F.lane ? w1 : w0);
                LIST[(size_t)ge * T + p] = rec;
            } }
    }
}


namespace dattn {
typedef short bf16x8 __attribute__((ext_vector_type(8)));
typedef short s16x4 __attribute__((ext_vector_type(4)));
typedef float f32x16 __attribute__((ext_vector_type(16)));
typedef short v4i16_t __attribute__((ext_vector_type(4)));
constexpr int SLOT = 32768, NT = KVL / 64, LDS_WS = 3 * SLOT, XS = 136;
typedef __attribute__((address_space(3))) const char* lds_cptr;
__device__ __forceinline__ int crow(int r, int hi) { return (r & 3) + 8 * (r >> 2) + 4 * hi; }
__device__ __forceinline__ void glds16(const void* gsrc, unsigned lds_dst) {
    asm volatile("s_mov_b32 m0, %1\n\ts_nop 0\n\tglobal_load_lds_dwordx4 %0, off" : : "v"(gsrc), "s"(lds_dst) : "memory", "m0"); }
__device__ __forceinline__ void glds16s(unsigned voff, const void* sbase, unsigned lds_dst) {
    asm volatile("s_mov_b32 m0, %2\n\ts_nop 0\n\tglobal_load_lds_dwordx4 %0, %1" : : "v"(voff), "s"(sbase), "s"(lds_dst) : "memory", "m0"); }
__device__ __forceinline__ unsigned cvtpk(float lo, float hi) { typedef float f2 __attribute__((ext_vector_type(2))); typedef __bf16 b2 __attribute__((ext_vector_type(2))); f2 v = {lo, hi}; b2 b = __builtin_convertvector(v, b2); return __builtin_bit_cast(unsigned, b); }
__device__ __forceinline__ s16x4 vtr(lds_cptr p) { return __builtin_bit_cast(s16x4, __builtin_amdgcn_ds_read_tr16_b64_v4i16((__attribute__((address_space(3))) v4i16_t*)p)); }
}

constexpr int MW_PER = 128, MW_NGU = 64 * MW_PER, MW_NMOE = MW_NGU + 32 * MW_PER;
constexpr int MW_NIT = MW_NMOE + 256 + 128 + 256;
__device__ __forceinline__ void mw_decode(const Frame& F, int it, const float*& wp, int& N, unsigned char*& dst) {
    const int lane = lane_id();
    if (it < MW_NGU) { const int eu = it / MW_PER, q = it % MW_PER, e = eu >> 1, up = eu & 1, kb = q >> 3, nb = q & 7;
        wp = F.inp(up ? 27 : 26) + (size_t)e * 1024 * EH + (size_t)(64 * kb) * EH + 64 * nb + lane; N = EH;
        const int n = 64 * nb + lane, drow = 256 * (n >> 7) + 128 * up + (n & 127);
        dst = F.ws + WS_WGU + (size_t)e * 1024 * 1024 + (size_t)drow * 1024 + 64 * kb; }
    else if (it < MW_NMOE) { const int r = it - MW_NGU, e = r / MW_PER, q = r % MW_PER, kb = q >> 4, nb = q & 15;
        wp = F.inp(28) + (size_t)e * EH * 1024 + (size_t)(64 * kb) * 1024 + 64 * nb + lane; N = 1024;
        dst = F.ws + WS_WD + (size_t)e * 1024 * EH + (size_t)(64 * nb + lane) * EH + 64 * kb; }
    else { int r = it - MW_NMOE; N = 1024;
        if (r < 256) { const int kb = r >> 4, nb = r & 15; wp = F.inp(19) + (size_t)(64 * kb) * 1024 + 64 * nb + lane; dst = F.ws + WS_WC + 512 + (size_t)(64 * nb + lane) * OCP + 64 * kb; }
        else if (r < 384) { r -= 256; const int kb = r >> 4, nb = r & 15; wp = F.inp(20) + (size_t)(64 * kb) * 1024 + 64 * nb + lane; dst = F.ws + WS_WC + (size_t)(64 * nb + lane) * OCP + 64 * kb; }
        else { r -= 384; const int kb = r >> 4, nb = r & 15; wp = F.inp(21) + (size_t)(64 * kb) * 1024 + 64 * nb + lane; dst = F.ws + WS_WO + (size_t)(64 * nb + lane) * 1024 + 64 * kb; } }
}
__device__ __forceinline__ void mw_load(float (&w)[64], const float* wp, int N) {
#pragma unroll
    for (int i = 0; i < 64; ++i) w[i] = wp[(size_t)i * N];
    asm volatile("" ::: "memory");
}
__device__ __forceinline__ void mw_store(const float (&w)[64], unsigned char* dst) {
#pragma unroll
    for (int c = 0; c < 8; ++c) { u32x2 o; o.x = pk4_fp8(w[8 * c] * WSCALE, w[8 * c + 1] * WSCALE, w[8 * c + 2] * WSCALE, w[8 * c + 3] * WSCALE);
        o.y = pk4_fp8(w[8 * c + 4] * WSCALE, w[8 * c + 5] * WSCALE, w[8 * c + 6] * WSCALE, w[8 * c + 7] * WSCALE);
        *(GAS u32x2*)(dst + 8 * c) = o; }
}
__device__ __forceinline__ void moe_weight_item(const Frame& F, int it) { const float* wp; int N; unsigned char* dst; mw_decode(F, it, wp, N, dst); float w[64]; mw_load(w, wp, N); mw_store(w, dst); }

namespace dattn3 {
using dattn::s16x4; using dattn::f32x16; using dattn::lds_cptr; using dattn::cvtpk; using dattn::vtr; using dattn::glds16s;
typedef int i32x8 __attribute__((ext_vector_type(8)));
typedef int i32x4 __attribute__((ext_vector_type(4)));
constexpr int NT = KVL / 64, KSL = 8192, VSL = 8192, NSL = 8, VBASE = NSL * KSL, XBASE = VBASE + 2 * VSL, LDS_WS = 150 * 1024, XS = 136;
#define D3_WAIT_BAR(N) asm volatile("s_waitcnt vmcnt(" #N ") lgkmcnt(0)\n\ts_barrier" ::: "memory")
#define D3_LDS_BAR() asm volatile("s_waitcnt lgkmcnt(0)\n\ts_barrier" ::: "memory")
#define D3_SBAR() __builtin_amdgcn_sched_barrier(0)
typedef __attribute__((address_space(3))) const i32x4* lds_i4;
#define D3_MFMA8(A, B, C) __builtin_amdgcn_mfma_scale_f32_32x32x64_f8f6f4(A, B, C, 0, 0, 0, 0, 0, 0)
__device__ __forceinline__ int pk4(float a, float b, float c, float d) { int w = 0; w = __builtin_amdgcn_cvt_pk_fp8_f32(a, b, w, false); w = __builtin_amdgcn_cvt_pk_fp8_f32(c, d, w, true); return w; }

__device__ __forceinline__ void unit(int b, int h, int qt, bool first, bool has_next, int nb, int nh, int nqt, i32x8& qr, const unsigned char* QA, unsigned char* OA, const unsigned char* KA, const unsigned char* VA, LAS unsigned char* lds, float lam, float negc, const float* subln, const int wid_, const Frame& F, const int mw_it) {
    const int wid = __builtin_amdgcn_readfirstlane(wid_);
    const int lane = lane_id(), r32 = lane & 31, hi = lane >> 5;
    const int br = wid >> 2, qi = wid & 3;
    const size_t qrow0 = (size_t)b * SEQ + qt * 128 + qi * 32;
    const unsigned char* Qw = QA + qrow0 * D + h * 128 + br * 64;
    const unsigned lds0 = (unsigned)(uintptr_t)lds;
    unsigned koff, voff;
    { const int row = 8 * wid + (lane >> 3), pos = lane & 7; koff = (unsigned)(row * D + h * 128 + ((pos ^ ((row >> 1) & 7)) << 4)); }
    { const int prow = 4 * wid + (lane >> 4), s16 = lane & 15; voff = (unsigned)(prow * (2 * D) + h * 256 + (((s16 >> 2) ^ (prow & 3)) << 6) + ((s16 & 3) << 4)); }
    const char* Kb = (const char*)(KA + (size_t)b * KVL * D); const char* Vb = (const char*)(VA + (size_t)b * KVL * D);
    const unsigned dstK = lds0 + (unsigned)wid * 1024u, dstV = lds0 + VBASE + (unsigned)wid * 1024u;
#define D3_KDMA(t, slot) do { glds16s(koff, Kb + (size_t)(t) * (64 * D), (unsigned)__builtin_amdgcn_readfirstlane(dstK + (slot))); } while (0)
#define D3_VDMA(t, slot) do { glds16s(voff, Vb + (size_t)(t) * (64 * D), (unsigned)__builtin_amdgcn_readfirstlane(dstV + (slot))); } while (0)
#define D3_QLOAD(Qp) do { const i32x4 _q0 = *(const i32x4*)((Qp) + (size_t)r32 * D + hi * 32), _q1 = *(const i32x4*)((Qp) + (size_t)r32 * D + hi * 32 + 16); \
        qr = (i32x8){_q0[0], _q0[1], _q0[2], _q0[3], _q1[0], _q1[1], _q1[2], _q1[3]}; } while (0)
    if (first) { D3_KDMA(0, 0); D3_VDMA(0, 0); D3_KDMA(1, KSL); D3_VDMA(1, VSL); D3_KDMA(2, 2 * KSL); D3_KDMA(3, 3 * KSL); D3_QLOAD(Qw); }
    f32x16 o[4];
#pragma unroll
    for (int i = 0; i < 4; ++i) o[i] = f32x16{};
    f32x16 m16;
#pragma unroll
    for (int i = 0; i < 16; ++i) m16[i] = negc;
    f32x16 osum = f32x16{};
    i32x8 ones;
#pragma unroll
    for (int i = 0; i < 8; ++i) ones[i] = 0x38383838;
    asm volatile("" : "+v"(ones));
    unsigned kad0, kad1;
    { const int R0 = 16 * ((r32 >> 2) & 1) + 4 * (r32 >> 3) + (r32 & 3); kad0 = (unsigned)(R0 * 128 + (((4 * br + 2 * hi) ^ ((R0 >> 1) & 7)) << 4)); kad1 = kad0 ^ 16u; }
    unsigned vad[4];
    { const int q = (lane & 15) >> 2;
#pragma unroll
      for (int db = 0; db < 4; ++db) vad[db] = (unsigned)(VBASE + (8 * hi + q) * 256 + ((db ^ q) << 6) + ((lane >> 4) & 1) * 32 + (lane & 3) * 8); }
    const lds_cptr l3 = (lds_cptr)lds;
#define D3_KF(dst, slot, c1) do { const i32x4 _k0 = *(lds_i4)(l3 + (slot) + kad0 + (c1) * 4096), _k1 = *(lds_i4)(l3 + (slot) + kad1 + (c1) * 4096); \
        dst = (i32x8){_k0[0], _k0[1], _k0[2], _k0[3], _k1[0], _k1[1], _k1[2], _k1[3]}; } while (0)
#define D3_VF(dst, slot, db) do { const lds_cptr _a = l3 + (slot) + vad[db]; const s16x4 _v0 = vtr(_a), _v1 = vtr(_a + 1024), _v2 = vtr(_a + 4096), _v3 = vtr(_a + 5120); \
        const i32x4 _w = __builtin_bit_cast(i32x4, (dattn::bf16x8){_v0[0], _v0[1], _v0[2], _v0[3], _v1[0], _v1[1], _v1[2], _v1[3]}), _x = __builtin_bit_cast(i32x4, (dattn::bf16x8){_v2[0], _v2[1], _v2[2], _v2[3], _v3[0], _v3[1], _v3[2], _v3[3]}); \
        dst = (i32x8){_w[0], _w[1], _w[2], _w[3], _x[0], _x[1], _x[2], _x[3]}; } while (0)
    D3_WAIT_BAR(0);
    D3_VDMA(2, 2 * VSL); D3_KDMA(4, 4 * KSL); D3_VDMA(3, 3 * VSL); D3_KDMA(5, 5 * KSL);
    f32x16 pA0, pA1, pB0, pB1;
    i32x8 kf0, kf1, vfa, vfb, vfc, vfd, pw = {};
    D3_KF(kf0, 0, 0); D3_KF(kf1, 0, 1);
    pA0 = D3_MFMA8(kf0, qr, m16); pA1 = D3_MFMA8(kf1, qr, m16);
#pragma unroll
    for (int r = 0; r < 16; ++r) { pA0[r] = __builtin_amdgcn_exp2f(pA0[r]); pA1[r] = __builtin_amdgcn_exp2f(pA1[r]); }
    D3_KF(kf0, KSL, 0); D3_KF(kf1, KSL, 1);
#define D3_EX(v) __builtin_amdgcn_exp2f(v)
#define D3_PKO(W, a, b, c, d) do { W = __builtin_amdgcn_cvt_pk_fp8_f32(a, b, W, false); W = __builtin_amdgcn_cvt_pk_fp8_f32(c, d, W, true); } while (0)
#define D3_SUMPK(P, J) do { \
        D3_PKO(pw[(J)], P[0], P[1], P[2], P[3]); D3_PKO(pw[(J) + 1], P[4], P[5], P[6], P[7]); D3_PKO(pw[(J) + 2], P[8], P[9], P[10], P[11]); D3_PKO(pw[(J) + 3], P[12], P[13], P[14], P[15]); } while (0)
#define D3_GB(db, VC, X, XB, EXTRA) do { o[db] = D3_MFMA8(pw, VC, o[db]); EXTRA; \
        X[(XB)] = D3_EX(X[(XB)]); X[(XB) + 1] = D3_EX(X[(XB) + 1]); X[(XB) + 2] = D3_EX(X[(XB) + 2]); X[(XB) + 3] = D3_EX(X[(XB) + 3]); \
        X[(XB) + 4] = D3_EX(X[(XB) + 4]); X[(XB) + 5] = D3_EX(X[(XB) + 5]); X[(XB) + 6] = D3_EX(X[(XB) + 6]); X[(XB) + 7] = D3_EX(X[(XB) + 7]); D3_SBAR(); } while (0)
#define D3_STEP(C0, C1, P0, P1, t, J, BAR, GK, GV, GP, WN) do { \
        if (BAR) D3_WAIT_BAR(WN); \
        C0 = D3_MFMA8(kf0, qr, m16); \
        D3_VF(vfa, (((J) + 7) & 7) * VSL, 0); D3_VF(vfb, (((J) + 7) & 7) * VSL, 1);                   \
        D3_SUMPK(P0, 0); \
        D3_SBAR(); \
        C1 = D3_MFMA8(kf1, qr, m16); \
        D3_VF(vfc, (((J) + 7) & 7) * VSL, 2); D3_VF(vfd, (((J) + 7) & 7) * VSL, 3); \
        D3_SUMPK(P1, 4); \
        D3_SBAR(); \
        osum = D3_MFMA8(pw, ones, osum); \
        if (GV) D3_VDMA((t) + 3, (((J) + 3) & 7) * VSL); if (GK) D3_KDMA((t) + 5, (((J) + 5) & 7) * KSL);     \
        D3_SBAR(); \
        D3_GB(0, vfa, C0, 0, (void)0); \
        D3_GB(1, vfb, C0, 8, do { if (GP) { D3_KF(kf0, (((J) + 1) & 7) * KSL, 0); } } while (0)); \
        D3_GB(2, vfc, C1, 0, do { if (GP) { D3_KF(kf1, (((J) + 1) & 7) * KSL, 1); } } while (0)); \
        D3_GB(3, vfd, C1, 8, (void)0); \
    } while (0)
    if (wid >= 4) __builtin_amdgcn_s_setprio(1);
    int t = 1;
#pragma unroll 1
    for (; t + 7 <= NT - 4; t += 8) {
        D3_STEP(pB0, pB1, pA0, pA1, t, 1, true, true, true, true, 4);
        D3_STEP(pA0, pA1, pB0, pB1, t + 1, 2, false, true, true, true, 4);
        D3_STEP(pB0, pB1, pA0, pA1, t + 2, 3, true, true, true, true, 4);
        D3_STEP(pA0, pA1, pB0, pB1, t + 3, 4, false, true, true, true, 4);
        D3_STEP(pB0, pB1, pA0, pA1, t + 4, 5, true, true, true, true, 4);
        D3_STEP(pA0, pA1, pB0, pB1, t + 5, 6, false, true, true, true, 4);
        D3_STEP(pB0, pB1, pA0, pA1, t + 6, 7, true, true, true, true, 4);
        D3_STEP(pA0, pA1, pB0, pB1, t + 7, 0, false, true, true, true, 4);
    }
    D3_STEP(pB0, pB1, pA0, pA1, NT - 3, 1, true, false, false, true, 4);
    D3_STEP(pA0, pA1, pB0, pB1, NT - 2, 2, false, false, false, true, 4);
    D3_STEP(pB0, pB1, pA0, pA1, NT - 1, 3, true, false, false, false, 0);
    static_assert(NT == 132 && ((NT - 4) & 7) == 0, "the unrolled loop covers t = 1 .. NT-4 in eights, the three tail steps have residues 1, 2, 3");
    __builtin_amdgcn_s_setprio(0);
    D3_WAIT_BAR(0);
    float mw[64]; unsigned char* mwdst = nullptr;
    if (mw_it >= 0) { const float* wp; int N; mw_decode(F, mw_it, wp, N, mwdst); mw_load(mw, wp, N); }
    { D3_SUMPK(pB0, 0); D3_SUMPK(pB1, 4); osum = D3_MFMA8(pw, ones, osum);
#pragma unroll
      for (int db = 0; db < 4; ++db) { i32x8 vf; D3_VF(vf, ((NT - 1) & 7) * VSL, db); o[db] = D3_MFMA8(pw, vf, o[db]); } }
    float rli[16];
#pragma unroll
    for (int r = 0; r < 16; ++r) rli[r] = __builtin_amdgcn_rcpf(osum[r]);
    D3_LDS_BAR();
    if (has_next) {
        const char* nKb = (const char*)(KA + (size_t)nb * KVL * D); const char* nVb = (const char*)(VA + (size_t)nb * KVL * D);
        { const int row = 8 * wid + (lane >> 3), pos = lane & 7; const unsigned nko = (unsigned)(row * D + nh * 128 + ((pos ^ ((row >> 1) & 7)) << 4));
          const unsigned d = (unsigned)__builtin_amdgcn_readfirstlane(dstK);
          glds16s(nko, nKb, d); glds16s(nko, nKb + (size_t)(64 * D), d + KSL); glds16s(nko, nKb + (size_t)2 * (64 * D), d + 2 * KSL); glds16s(nko, nKb + (size_t)3 * (64 * D), d + 3 * KSL); }
        { const int prow = 4 * wid + (lane >> 4), s16 = lane & 15; const unsigned nvo = (unsigned)(prow * (2 * D) + nh * 256 + (((s16 >> 2) ^ (prow & 3)) << 6) + ((s16 & 3) << 4));
          glds16s(nvo, nVb, (unsigned)__builtin_amdgcn_readfirstlane(dstV)); glds16s(nvo, nVb + (size_t)(64 * D), (unsigned)__builtin_amdgcn_readfirstlane(dstV + VSL)); }
        const unsigned char* nQw = QA + ((size_t)nb * SEQ + nqt * 128 + qi * 32) * D + nh * 128 + br * 64;
        D3_QLOAD(nQw);
    }
    LAS float* X = (LAS float*)(lds + XBASE) + (size_t)(qi * 32 + 4 * hi) * XS + r32;
    if (br == 1) {
#pragma unroll
        for (int db = 0; db < 4; ++db)
#pragma unroll
            for (int r = 0; r < 16; ++r) X[((r & 3) + 8 * (r >> 2)) * XS + db * 32] = o[db][r] * rli[r];
    }
    D3_LDS_BAR();
    if (br == 0) {
#pragma unroll
        for (int db = 0; db < 4; ++db)
#pragma unroll
            for (int r = 0; r < 16; ++r) { const int xi = ((r & 3) + 8 * (r >> 2)) * XS + db * 32; X[xi] = o[db][r] * rli[r] - lam * X[xi]; }
        asm volatile("s_waitcnt lgkmcnt(0)" ::: "memory");
        int lane_e = lane; asm volatile("" : "+v"(lane_e) : "v"(rli[0]));
        const int row = lane_e >> 1, half = lane_e & 1;
        const LAS float* Xr = (const LAS float*)(lds + XBASE) + (size_t)(qi * 32 + row) * XS + half * 8;
        const float* sg = subln + half * 8;
        f32x4 gg[8][2];
#pragma unroll
        for (int i = 0; i < 8; ++i) { gg[i][0] = *(const f32x4*)(sg + i * 16); gg[i][1] = *(const f32x4*)(sg + i * 16 + 4); }
        asm volatile("" ::: "memory");
        f32x4 v[8][2]; float ss = 0.f;
#pragma unroll
        for (int i = 0; i < 8; ++i)
#pragma unroll
            for (int c = 0; c < 2; ++c) { v[i][c] = *(const LAS f32x4*)(Xr + i * 16 + c * 4); ss += (v[i][c].x * v[i][c].x + v[i][c].y * v[i][c].y) + (v[i][c].z * v[i][c].z + v[i][c].w * v[i][c].w); }
        ss += __uint_as_float((unsigned)__builtin_amdgcn_update_dpp(0, (int)__float_as_uint(ss), 0xB1, 0xF, 0xF, true));
        const float rstd = 0.8f * __builtin_amdgcn_rsqf(ss * (1.f / 128.f) + EPS);
        unsigned char* dst = OA + (qrow0 + row) * OCP + h * 128 + half * 8;
#pragma unroll
        for (int i = 0; i < 8; ++i) { const f32x4 g0 = gg[i][0], g1 = gg[i][1];
            u32x2 w; w.x = (unsigned)pk4(v[i][0].x * rstd * g0.x, v[i][0].y * rstd * g0.y, v[i][0].z * rstd * g0.z, v[i][0].w * rstd * g0.w);
            w.y = (unsigned)pk4(v[i][1].x * rstd * g1.x, v[i][1].y * rstd * g1.y, v[i][1].z * rstd * g1.z, v[i][1].w * rstd * g1.w);
            *(GAS u32x2*)(dst + i * 16) = w; }
    }
    D3_LDS_BAR();
    if (mw_it >= 0) mw_store(mw, mwdst);
#undef D3_KDMA
#undef D3_VDMA
#undef D3_QLOAD
#undef D3_KF
#undef D3_VF
#undef D3_SUMPK
#undef D3_PKO
#undef D3_EX
#undef D3_GB
#undef D3_STEP
}
}

template <int VAR> __device__ __forceinline__ void p2a_diffattn_mfma(Frame& F, unsigned char* OA) {
    const unsigned char* QA = (const unsigned char*)(F.ws + WS_QA); const unsigned char* KA = (const unsigned char*)(F.ws + WS_KA); const unsigned char* VA = (const unsigned char*)(F.ws + WS_VA);
    const float lam = lam_value(F); const float mb = qk_bound(F.inp(9), F.inp(10));
    const float negc = -fmaxf(mb - 8.5f, 0.f);
    constexpr int NU = NB * NH * (SEQ / 128);
    auto unit_of = [&](int i, int& bh, int& qt) -> bool {
        if (F.G == 256) { if (i >= 8) return false; const int x = F.bid & 7, j = F.bid >> 3; bh = x + 8 * (i >> 1); qt = (i & 1) * 32 + j; return true; }
        const int u = F.bid + i * F.G; if (u >= NU) return false; bh = u / (SEQ / 128); qt = u % (SEQ / 128); return true; };
    dattn3::i32x8 qr;
    int bh, qt; bool have = unit_of(0, bh, qt); int nun = 0;
    for (int i = 0; have; ++i) {
        int nbh = 0, nqt = 0; const bool has_next = unit_of(i + 1, nbh, nqt);
        const int mwi = F.bid * 8 + __builtin_amdgcn_readfirstlane(F.wave) + i * (F.G * 8);
        dattn3::unit(bh / NH, bh % NH, qt, i == 0, has_next, nbh / NH, nbh % NH, nqt, qr, QA, OA, KA, VA, F.lds, lam, negc, F.inp(15), F.wave, F, mwi < MW_NIT ? mwi : -1);
        bh = nbh; qt = nqt; have = has_next;
        nun = i + 1;
    }
    for (int it = F.bid * 8 + __builtin_amdgcn_readfirstlane(F.wave) + nun * (F.G * 8); it < MW_NIT; it += F.G * 8) moe_weight_item(F, it);
}

namespace nattn {
using dattn::s16x4; using dattn::f32x16; using dattn::lds_cptr; using dattn::glds16; using dattn::vtr;
typedef int i32x8 __attribute__((ext_vector_type(8)));
typedef int i32x4 __attribute__((ext_vector_type(4)));
typedef __attribute__((address_space(3))) const i32x4* lds_i4;
#define NA_MFMA8(A, B, C) __builtin_amdgcn_mfma_scale_f32_32x32x64_f8f6f4(A, B, C, 0, 0, 0, 0, 0, 0)
__device__ __forceinline__ void unit(int b, int r, const unsigned char* QB, unsigned char* OB, const unsigned char* KB, const unsigned char* VB, LAS unsigned char* lds, float negc, const int wid_) {
    const int lane = lane_id(), r32 = lane & 31, hi = lane >> 5; const int h = __builtin_amdgcn_readfirstlane(wid_);
    const size_t qrow0 = (size_t)b * SEQ + r * GRIDW;
    const unsigned lds0 = (unsigned)(uintptr_t)lds;
    LAS unsigned char* vbuf = lds + h * 16384;
    const LAS float* BL = (const LAS float*)(lds + 131072 + h * 2048);
    int r0 = r - 4; r0 = r0 < 0 ? 0 : (r0 > NROWS - 8 ? NROWS - 8 : r0);
    i32x8 qr[2];
#pragma unroll
    for (int qb = 0; qb < 2; ++qb) { const unsigned char* qp = QB + (qrow0 + qb * 32 + r32) * 512 + h * 64 + hi * 32; const i32x4 q0 = *(const i32x4*)qp, q1 = *(const i32x4*)(qp + 16);
        qr[qb] = (i32x8){q0[0], q0[1], q0[2], q0[3], q1[0], q1[1], q1[2], q1[3]}; }
    f32x16 o[2][2];
#pragma unroll
    for (int i = 0; i < 2; ++i)
#pragma unroll
        for (int j = 0; j < 2; ++j) o[i][j] = f32x16{};
    f32x16 m16;
    f32x16 osum[2] = {f32x16{}, f32x16{}};
    i32x8 ones;
    { int o1; asm volatile("v_mov_b32 %0, 0x38383838" : "=v"(o1));
#pragma unroll
      for (int i = 0; i < 8; ++i) ones[i] = o1; }
    unsigned koff, voff;
    { const int row = lane >> 2, pos = lane & 3; koff = (unsigned)(row * 512 + h * 64 + ((pos ^ ((row >> 2) & 3)) << 4)); }
    { const int prow = lane >> 3, pos = lane & 7; voff = (unsigned)(prow * 1024 + h * 128 + ((((pos >> 2) ^ ((prow >> 1) & 1))) << 6) + ((pos & 3) << 4)); }
#define NA_KROW(t) ((size_t)b * KVL + ((t) < 8 ? CTX + (r0 + (t)) * GRIDW : ((t) - 8) * 64))
#define NA_DMA(t) do { const char* _ks = (const char*)KB + NA_KROW(t) * 512; const char* _vs = (const char*)VB + NA_KROW(t) * 512; const unsigned _d = lds0 + h * 16384 + ((t) & 1) * 4096; \
        _Pragma("unroll") for (int _j = 0; _j < 4; ++_j) dattn::glds16s(koff, _ks + _j * (16 * 512), _d + _j * 1024); \
        _Pragma("unroll") for (int _j = 0; _j < 4; ++_j) dattn::glds16s(voff, _vs + _j * (8 * 1024), _d + 8192 + _j * 1024); } while (0)
    NA_DMA(0);
    unsigned kad0, kad1;
    { const int R0 = 16 * ((r32 >> 2) & 1) + 4 * (r32 >> 3) + (r32 & 3); kad0 = (unsigned)(R0 * 64 + (((2 * hi) ^ ((R0 >> 2) & 3)) << 4)); kad1 = kad0 ^ 16u; }
    unsigned vad[2];
    { const int q = (lane & 15) >> 2;
#pragma unroll
      for (int db = 0; db < 2; ++db) vad[db] = (unsigned)(8192 + (8 * hi + q) * 128 + ((db ^ ((q >> 1) & 1)) << 6) + ((lane >> 4) & 1) * 32 + (lane & 3) * 8); }
    const lds_cptr l3 = (lds_cptr)vbuf;
#define NA_KF(dst, slot, c1) do { const i32x4 _k0 = *(lds_i4)(l3 + (slot) + kad0 + (c1) * 2048), _k1 = *(lds_i4)(l3 + (slot) + kad1 + (c1) * 2048); \
        dst = (i32x8){_k0[0], _k0[1], _k0[2], _k0[3], _k1[0], _k1[1], _k1[2], _k1[3]}; } while (0)
#define NA_VF(dst, slot, db) do { const lds_cptr _a = l3 + (slot) + vad[db]; const s16x4 _v0 = vtr(_a), _v1 = vtr(_a + 512), _v2 = vtr(_a + 2048), _v3 = vtr(_a + 2560); \
        const i32x4 _w = __builtin_bit_cast(i32x4, (dattn::bf16x8){_v0[0], _v0[1], _v0[2], _v0[3], _v1[0], _v1[1], _v1[2], _v1[3]}), _x = __builtin_bit_cast(i32x4, (dattn::bf16x8){_v2[0], _v2[1], _v2[2], _v2[3], _v3[0], _v3[1], _v3[2], _v3[3]}); \
        dst = (i32x8){_w[0], _w[1], _w[2], _w[3], _x[0], _x[1], _x[2], _x[3]}; } while (0)
    int wmask[2];
#pragma unroll
    for (int qb = 0; qb < 2; ++qb) { const int w = qb * 32 + r32; int c0 = w - 8; c0 = c0 < 0 ? 0 : (c0 > GRIDW - 16 ? GRIDW - 16 : c0);
        unsigned bits = 0u;
#pragma unroll
        for (int blk = 0; blk < 2; ++blk) { const int d = 16 * hi + 32 * blk - c0;
            int lo = -d; lo = lo < 0 ? 0 : (lo > 16 ? 16 : lo); int he = 16 - d; he = he < 0 ? 0 : (he > 16 ? 16 : he);
            const unsigned b16 = he > lo ? (((1u << he) - 1u) & ~((1u << lo) - 1u)) : 0u; bits |= b16 << (16 * blk); }
        wmask[qb] = (int)bits; }
    unsigned bmask[2][8];
#pragma unroll
    for (int qb = 0; qb < 2; ++qb)
#pragma unroll
        for (int j = 0; j < 8; ++j) { const unsigned nib = ((unsigned)wmask[qb] >> (j < 4 ? 4 * j : 16 + 4 * (j - 4))) & 15u;
            bmask[qb][j] = ((nib * 0x00204081u) & 0x01010101u) * 0xFFu; }
    i32x8 pw = {};
    auto tile = [&](auto win_, const int t) { constexpr bool WIN = decltype(win_)::value;
        if (t + 1 < 12) { NA_DMA(t + 1); asm volatile("s_waitcnt vmcnt(8)" ::: "memory"); } else asm volatile("s_waitcnt vmcnt(0)" ::: "memory");
        const int slot = (t & 1) * 4096;
        i32x8 kf0, kf1, vf0, vf1;
        NA_KF(kf0, slot, 0); NA_KF(kf1, slot, 1); NA_VF(vf0, slot, 0); NA_VF(vf1, slot, 1);
#pragma unroll
        for (int qb = 0; qb < 2; ++qb) {
            f32x16 p0, p1;
            if constexpr (WIN) {
                const int w = qb * 32 + r32;
                const LAS float* brow = BL + (r0 + t - r + 7) * 31 + (15 - w) + 16 * hi;
                asm volatile("" : "+v"(brow));
                f32x16 c0v, c1v;
#pragma unroll
                for (int i = 0; i < 16; ++i) { c0v[i] = brow[i]; c1v[i] = brow[i + 32]; }
                p0 = NA_MFMA8(kf0, qr[qb], c0v); p1 = NA_MFMA8(kf1, qr[qb], c1v);
            } else { p0 = NA_MFMA8(kf0, qr[qb], m16); p1 = NA_MFMA8(kf1, qr[qb], m16); }
            if constexpr (WIN) {
                const int a0 = qb == 1 ? 8 : 0, b1 = qb == 0 ? 8 : 16;
#pragma unroll
                for (int i = 0; i < 16; ++i) { if (i >= a0) p0[i] = __builtin_amdgcn_exp2f(p0[i]); if (i < b1) p1[i] = __builtin_amdgcn_exp2f(p1[i]); }
#pragma unroll
                for (int j = 0; j < 4; ++j) {
                    if (4 * j >= a0) { pw[j] = __builtin_amdgcn_cvt_pk_fp8_f32(p0[4 * j], p0[4 * j + 1], pw[j], false); pw[j] = __builtin_amdgcn_cvt_pk_fp8_f32(p0[4 * j + 2], p0[4 * j + 3], pw[j], true); pw[j] &= (int)bmask[qb][j]; } else pw[j] = 0;
                    if (4 * j < b1) { pw[4 + j] = __builtin_amdgcn_cvt_pk_fp8_f32(p1[4 * j], p1[4 * j + 1], pw[4 + j], false); pw[4 + j] = __builtin_amdgcn_cvt_pk_fp8_f32(p1[4 * j + 2], p1[4 * j + 3], pw[4 + j], true); pw[4 + j] &= (int)bmask[qb][4 + j]; } else pw[4 + j] = 0; }
            } else {
#pragma unroll
                for (int i = 0; i < 16; ++i) { p0[i] = __builtin_amdgcn_exp2f(p0[i]); p1[i] = __builtin_amdgcn_exp2f(p1[i]); }
#pragma unroll
                for (int j = 0; j < 4; ++j) { pw[j] = __builtin_amdgcn_cvt_pk_fp8_f32(p0[4 * j], p0[4 * j + 1], pw[j], false); pw[j] = __builtin_amdgcn_cvt_pk_fp8_f32(p0[4 * j + 2], p0[4 * j + 3], pw[j], true);
                    pw[4 + j] = __builtin_amdgcn_cvt_pk_fp8_f32(p1[4 * j], p1[4 * j + 1], pw[4 + j], false); pw[4 + j] = __builtin_amdgcn_cvt_pk_fp8_f32(p1[4 * j + 2], p1[4 * j + 3], pw[4 + j], true); }
            }
            osum[qb] = NA_MFMA8(pw, ones, osum[qb]);
            o[qb][0] = NA_MFMA8(pw, vf0, o[qb][0]);
            o[qb][1] = NA_MFMA8(pw, vf1, o[qb][1]);
        }
        asm volatile("s_waitcnt lgkmcnt(0)" ::: "memory");
    };
#pragma unroll 1
    for (int t = 0; t < 8; ++t) tile(std::true_type{}, t);
    { float nc; asm volatile("v_mov_b32 %0, %1" : "=v"(nc) : "v"(negc));
#pragma unroll
      for (int i = 0; i < 16; ++i) m16[i] = nc; }
#pragma unroll 1
    for (int t = 8; t < 12; ++t) tile(std::false_type{}, t);
    LAS bf16* stg = (LAS bf16*)vbuf;
    { LAS bf16* sb = stg + (4 * hi) * 64 + r32;
#pragma unroll
      for (int qb = 0; qb < 2; ++qb)
#pragma unroll
          for (int i = 0; i < 16; ++i) { const int qc = qb * 32 + (i & 3) + 8 * (i >> 2); const float rl = __builtin_amdgcn_rcpf(osum[qb][i]);
#pragma unroll
              for (int db = 0; db < 2; ++db) sb[qc * 64 + db * 32] = (bf16)f2bf(o[qb][db][i] * rl); } }
    asm volatile("s_waitcnt lgkmcnt(0)" ::: "memory");
#pragma unroll
    for (int i = 0; i < 8; ++i) { const int row = i * 8 + (lane >> 3), ch = lane & 7; const u32x4 v = *(const LAS u32x4*)(stg + row * 64 + ch * 8);
        u32x2 w; w.x = pk4_fp8(bf2f(v.x & 0xffffu) * OBSCALE, bf2f(v.x >> 16) * OBSCALE, bf2f(v.y & 0xffffu) * OBSCALE, bf2f(v.y >> 16) * OBSCALE);
        w.y = pk4_fp8(bf2f(v.z & 0xffffu) * OBSCALE, bf2f(v.z >> 16) * OBSCALE, bf2f(v.w & 0xffffu) * OBSCALE, bf2f(v.w >> 16) * OBSCALE);
        *(GAS u32x2*)(OB + (qrow0 + row) * OCP + h * 64 + ch * 8) = w; }
    asm volatile("s_waitcnt lgkmcnt(0)" ::: "memory");
#undef NA_DMA
#undef NA_KROW
#undef NA_KF
#undef NA_VF
}
}
__device__ __forceinline__ void p2b_natten_mfma(Frame& F, unsigned char* OB) {
    const unsigned char* QB = F.ws + WS_QB; const unsigned char* KB = F.ws + WS_KB; const unsigned char* VB = F.ws + WS_VB;
    const float* bias = F.inp(18);
    float bm = 0.f;
    { float v[59];
#pragma unroll
      for (int k = 0; k < 59; ++k) { const int i = F.lane + k * 64; v[k] = i < NH * 15 * 31 ? fabsf(bias[i]) : 0.f; }
      asm volatile("" ::: "memory");
#pragma unroll
      for (int k = 0; k < 59; ++k) bm = fmaxf(bm, v[k]); }
#pragma unroll
    for (int o = 1; o < 64; o <<= 1) bm = fmaxf(bm, __shfl_xor(bm, o));
    const float mb = qk_bound(F.inp(16), F.inp(17)) + bm * LOG2E;
    const float negc = -fmaxf(mb - 8.5f, 0.f);
    LAS float* BL = (LAS float*)(F.lds + 131072);
#pragma unroll
    for (int k = 0; k < 8; ++k) { const int i = F.tid + k * NTHR; const int h = i >> 9, e = i & 511; BL[i] = e < 465 ? bias[h * 465 + e] * LOG2E + negc : 0.f; }
    __syncthreads();
    if (F.G == 256) { for (int i = 0; i < 2; ++i) { const int u = (F.bid & 7) * 64 + i * 32 + (F.bid >> 3); nattn::unit(u / NROWS, u % NROWS, QB, OB, KB, VB, F.lds, negc, F.wave); } }
    else for (int u = F.bid; u < NB * NROWS; u += F.G) nattn::unit(u / NROWS, u % NROWS, QB, OB, KB, VB, F.lds, negc, F.wave);
    __syncthreads();
}

__device__ __forceinline__ f32x4 ub4(unsigned w) { f32x4 r; r.x = (float)(w & 0xffu); r.y = (float)((w >> 8) & 0xffu); r.z = (float)((w >> 16) & 0xffu); r.w = (float)(w >> 24); return r; }
struct EpiMerge {
    static constexpr int MIDT = 4; static constexpr bool PERM = true; const unsigned char* GA; const unsigned char* GB; unsigned char* Y2;
    __device__ __forceinline__ void mid(f32x4 (&acc)[2][2][4][2], const pg8::Unit& u, int wr, int wc, int fr_, int fq_) const {
        int fr = fr_, fq = fq_; asm volatile("" : "+v"(fr), "+v"(fq));
        const size_t r0 = (size_t)(u.pm * 256 + wr * 64 + fr) * D + u.pn * 256 + wc * 32 + 8 * fq;
        u32x2 gaa[2][4][2], gbb[2][4][2];
#pragma unroll
        for (int ai = 0; ai < 2; ++ai)
#pragma unroll
            for (int m = 0; m < 4; ++m)
#pragma unroll
                for (int bj = 0; bj < 2; ++bj) { const size_t o = r0 + (size_t)(ai * 128 + m * 16) * D + bj * 128; gaa[ai][m][bj] = *(const GAS u32x2*)(GA + o); gbb[ai][m][bj] = *(const GAS u32x2*)(GB + o); }
        asm volatile("" ::: "memory");
#pragma unroll
        for (int ai = 0; ai < 2; ++ai) {
            const u32x2 (&ga)[4][2] = gaa[ai]; const u32x2 (&gb)[4][2] = gbb[ai];
#pragma unroll
            for (int m = 0; m < 4; ++m)
#pragma unroll
                for (int bj = 0; bj < 2; ++bj) {
                    const f32x4 a0 = ub4(ga[m][bj].x), a1 = ub4(ga[m][bj].y), b0 = ub4(gb[m][bj].x), b1 = ub4(gb[m][bj].y);
                    f32x4 r0v, r1v;
#pragma unroll
                    for (int i = 0; i < 4; ++i) { r0v[i] = b0[i] * __builtin_amdgcn_rcpf(OBSCALE * fmaxf(a0[i], 0.5f)); r1v[i] = b1[i] * __builtin_amdgcn_rcpf(OBSCALE * fmaxf(a1[i], 0.5f)); }
                    acc[ai][bj][m][0] = acc[ai][bj][m][0] * r0v; acc[ai][bj][m][1] = acc[ai][bj][m][1] * r1v; }
        }
    }
    __device__ __forceinline__ void operator()(const f32x4 (&acc)[2][2][4][2], const pg8::Unit& u, int wr, int wc, int fr_, int fq_) const {
        int fr = fr_, fq = fq_; asm volatile("" : "+v"(fr), "+v"(fq));
        const size_t r0 = (size_t)(u.pm * 256 + wr * 64 + fr) * D + u.pn * 256 + wc * 32 + 8 * fq;
        u32x2 gaa[2][4][2];
#pragma unroll
        for (int ai = 0; ai < 2; ++ai)
#pragma unroll
            for (int m = 0; m < 4; ++m)
#pragma unroll
                for (int bj = 0; bj < 2; ++bj) gaa[ai][m][bj] = *(const GAS u32x2*)(GA + r0 + (size_t)(ai * 128 + m * 16) * D + bj * 128);
        asm volatile("" ::: "memory");
#pragma unroll
        for (int ai = 0; ai < 2; ++ai) {
            const u32x2 (&ga)[4][2] = gaa[ai];
#pragma unroll
            for (int m = 0; m < 4; ++m)
#pragma unroll
                for (int bj = 0; bj < 2; ++bj) { const f32x4 a0 = ub4(ga[m][bj].x), a1 = ub4(ga[m][bj].y); f32x4 s0, s1;
#pragma unroll
                    for (int i = 0; i < 4; ++i) { s0[i] = fmaxf(a0[i], 0.5f) * (WINV / 255.f); s1[i] = fmaxf(a1[i], 0.5f) * (WINV / 255.f); }
                    const f32x4 y0 = acc[ai][bj][m][0] * s0, y1 = acc[ai][bj][m][1] * s1;
                    u32x2 w; w.x = pk4_fp8(y0.x, y0.y, y0.z, y0.w); w.y = pk4_fp8(y1.x, y1.y, y1.z, y1.w);
                    *(GAS u32x2*)(Y2 + r0 + (size_t)(ai * 128 + m * 16) * D + bj * 128) = w; }
        }
    }
};
struct EpiMergeA {
    static constexpr int MIDT = 0; static constexpr bool PERM = true; const unsigned char* GA; bf16* Y;
    __device__ __forceinline__ void operator()(const f32x4 (&acc)[2][2][4][2], const pg8::Unit& u, int wr, int wc, int fr_, int fq_) const {
        int fr = fr_, fq = fq_; asm volatile("" : "+v"(fr), "+v"(fq));
        const size_t r0 = (size_t)(u.pm * 256 + wr * 64 + fr) * D + u.pn * 256 + wc * 32 + 8 * fq;
        u32x2 gv[2][4][2];
#pragma unroll
        for (int ai = 0; ai < 2; ++ai)
#pragma unroll
            for (int m = 0; m < 4; ++m)
#pragma unroll
                for (int bj = 0; bj < 2; ++bj) gv[ai][m][bj] = *(const GAS u32x2*)(GA + r0 + (size_t)(ai * 128 + m * 16) * D + bj * 128);
#pragma unroll
        for (int ai = 0; ai < 2; ++ai)
#pragma unroll
            for (int m = 0; m < 4; ++m)
#pragma unroll
                for (int bj = 0; bj < 2; ++bj) { const f32x4 a = acc[ai][bj][m][0] * WINV * un4_u8(gv[ai][m][bj].x), b = acc[ai][bj][m][1] * WINV * un4_u8(gv[ai][m][bj].y);
                    u32x4 w; w.x = pg8::cvt_pk_bf16(a.x, a.y); w.y = pg8::cvt_pk_bf16(a.z, a.w); w.z = pg8::cvt_pk_bf16(b.x, b.y); w.w = pg8::cvt_pk_bf16(b.z, b.w);
                    *(GAS u32x4*)(Y + r0 + (size_t)(ai * 128 + m * 16) * D + bj * 128) = w; }
    }
};
struct EpiMergeB {
    static constexpr int MIDT = 0; static constexpr bool PERM = true; const unsigned char* GB; const bf16* Y; unsigned char* Y2;
    __device__ __forceinline__ void operator()(const f32x4 (&acc)[2][2][4][2], const pg8::Unit& u, int wr, int wc, int fr_, int fq_) const {
        int fr = fr_, fq = fq_; asm volatile("" : "+v"(fr), "+v"(fq));
        const size_t r0 = (size_t)(u.pm * 256 + wr * 64 + fr) * D + u.pn * 256 + wc * 32 + 8 * fq;
#pragma unroll
        for (int ai = 0; ai < 2; ++ai) {
            u32x2 gv[4][2]; u32x4 yv[4][2];
#pragma unroll
            for (int m = 0; m < 4; ++m)
#pragma unroll
                for (int bj = 0; bj < 2; ++bj) { const size_t o = r0 + (size_t)(ai * 128 + m * 16) * D + bj * 128; gv[m][bj] = *(const GAS u32x2*)(GB + o); yv[m][bj] = *(const GAS u32x4*)(Y + o); }
#pragma unroll
            for (int m = 0; m < 4; ++m)
#pragma unroll
                for (int bj = 0; bj < 2; ++bj) { const u32x4 y = yv[m][bj]; const f32x4 a = acc[ai][bj][m][0] * (WINV / OBSCALE) * un4_u8(gv[m][bj].x), b = acc[ai][bj][m][1] * (WINV / OBSCALE) * un4_u8(gv[m][bj].y);
                    u32x2 w; w.x = pk4_fp8(bf2f(y.x & 0xffffu) + a.x, bf2f(y.x >> 16) + a.y, bf2f(y.y & 0xffffu) + a.z, bf2f(y.y >> 16) + a.w);
                    w.y = pk4_fp8(bf2f(y.z & 0xffffu) + b.x, bf2f(y.z >> 16) + b.y, bf2f(y.w & 0xffffu) + b.z, bf2f(y.w >> 16) + b.w);
                    *(GAS u32x2*)(Y2 + r0 + (size_t)(ai * 128 + m * 16) * D + bj * 128) = w; }
        }
    }
};
struct EpiOut {
    static constexpr int MIDT = 0; static constexpr bool PERM = false; const float* x; const float* MOD; bf16* XMID;
    __device__ __forceinline__ void operator()(const f32x4 (&acc)[2][2][4][2], const pg8::Unit& u, int wr, int wc, int fr_, int fq_) const {
        int fr = fr_, fq = fq_; asm volatile("" : "+v"(fr), "+v"(fq));
        const int b = (u.pm * 256) / SEQ; const int col0 = u.pn * 256 + wc * 32 + 4 * fq;
        f32x4 g[2][2];
#pragma unroll
        for (int bj = 0; bj < 2; ++bj)
#pragma unroll
            for (int n = 0; n < 2; ++n) g[bj][n] = *(const f32x4*)(MOD + b * 6144 + 2048 + col0 + bj * 128 + n * 16) * WINV;
        const size_t r0 = (size_t)(u.pm * 256 + wr * 64 + fr) * D + col0;
        f32x4 xv[2][2][2][2];
        auto load = [&](int buf, int bt) {
#pragma unroll
            for (int mm = 0; mm < 2; ++mm)
#pragma unroll
                for (int bj = 0; bj < 2; ++bj)
#pragma unroll
                    for (int n = 0; n < 2; ++n) xv[buf][mm][bj][n] = *(const f32x4*)(x + r0 + (size_t)((bt >> 1) * 128 + (2 * (bt & 1) + mm) * 16) * D + bj * 128 + n * 16); };
        load(0, 0);
#pragma unroll
        for (int bt = 0; bt < 4; ++bt) {
            if (bt + 1 < 4) load((bt + 1) & 1, bt + 1);
            asm volatile("" ::: "memory");
            const int ai = bt >> 1;
#pragma unroll
            for (int mm = 0; mm < 2; ++mm) { const int m = 2 * (bt & 1) + mm;
#pragma unroll
                for (int bj = 0; bj < 2; ++bj)
#pragma unroll
                    for (int n = 0; n < 2; ++n) { const f32x4 r = xv[bt & 1][mm][bj][n] + g[bj][n] * acc[ai][bj][m][n]; u32x2 w; w.x = pg8::cvt_pk_bf16(r.x, r.y); w.y = pg8::cvt_pk_bf16(r.z, r.w);
                        *(GAS u32x2*)(XMID + r0 + (size_t)(ai * 128 + m * 16) * D + bj * 128 + n * 16) = w; } }
        }
    }
};
__device__ __forceinline__ void p3_merge_out_mfma(Frame& F, int part) {
    bf16* Y = (bf16*)(F.ws + WS_Y); const unsigned char* GA = (const unsigned char*)F.out;
    if (part == 0) {
        pg8::Gemm g{(const bf16*)(F.ws + WS_OC), (const bf16*)(F.ws + WS_WC), OCP, OCP, OCP}; pg8::DenseOrder S; S.init(T, D, F.G, F.bid, OCP);
        EpiMerge E{GA, GA + (size_t)T * D, F.ws + WS_Y2}; pg8::gemm_phase<EpiMerge, pg8::DenseOrder, true>(F.lds, g, S, E, F.wave);
    } else {
        pg8::Gemm g{(const bf16*)(F.ws + WS_Y2), (const bf16*)(F.ws + WS_WO), D, D, D}; pg8::DenseOrder S; S.init(T, D, F.G, F.bid, D);
        EpiOut E{F.inp(0), (const float*)(F.ws + WS_MOD), (bf16*)(F.ws + WS_XMID)}; pg8::gemm_phase<EpiOut, pg8::DenseOrder, true>(F.lds, g, S, E, F.wave);
    }
}

constexpr int MOE_TAB_OFF = 132096;
struct MoeTab { LAS int* cnt; LAS int* tpre; LAS int* tgrp; };
__device__ __forceinline__ MoeTab moe_tables(Frame& F, bool have) {
    MoeTab G; G.cnt = (LAS int*)(F.lds + MOE_TAB_OFF); G.tpre = G.cnt + 64; G.tgrp = G.tpre + 65;
    if (have) return G;
    __syncthreads();
    if (F.tid < 64) {
        const int c = (int)__hip_atomic_load(F.ctl + CW_CNT + 64 * F.tid, __ATOMIC_RELAXED, __HIP_MEMORY_SCOPE_AGENT);
        const int nt = (c + 255) >> 8; int inc = nt;
#pragma unroll
        for (int o = 1; o < 64; o <<= 1) { const int v = __shfl_up(inc, o); if (F.lane >= o) inc += v; }
        G.cnt[F.tid] = c; G.tpre[F.tid] = inc - nt; if (F.tid == 63) G.tpre[64] = inc;
        for (int i = 0; i < nt; ++i) G.tgrp[inc - nt + i] = F.tid;
    }
    __syncthreads();
    return G;
}
struct MoeOrder {
    static constexpr bool LAZY = false;
    MoeTab G; int t_lo, t_hi, Gn, c; const i32x2* LIST; int ldb; bool gather;
    __device__ __forceinline__ bool next(int i, pg8::Unit& u) const {
        const long L = (long)i * Gn + c; const int tile = t_lo + (int)(L >> 2); if (tile >= t_hi) return false;
        const int g = G.tgrp[tile];
        u.pm = tile - G.tpre[g]; u.pn = (int)(L & 3); u.a0 = g; u.a1 = tile * 256; return true;
    }
    __device__ __forceinline__ int arow(const pg8::Unit& u, int r) const {
        if (!gather) return u.a1 + r;
        const int idx = u.pm * 256 + r; const int cnt = G.cnt[u.a0]; return LIST[(size_t)u.a0 * T + (idx < cnt ? idx : 0)].x;
    }
    __device__ __forceinline__ size_t boff(const pg8::Unit& u) const { return ((size_t)(u.a0 & 31) * 1024 + (size_t)u.pn * 256) * ldb; }
};
struct MoeOrderDown : MoeOrder { static constexpr bool LAZY = true; };
struct EpiGateUp {
    static constexpr int MIDT = 0; static constexpr bool PERM = true; unsigned char* HID;
    __device__ __forceinline__ void operator()(const f32x4 (&acc)[2][2][4][2], const pg8::Unit& u, int wr, int wc, int fr_, int fq_) const {
        int fr = fr_, fq = fq_; asm volatile("" : "+v"(fr), "+v"(fq));
#pragma unroll
        for (int ai = 0; ai < 2; ++ai)
#pragma unroll
            for (int m = 0; m < 4; ++m) { const size_t ro = (size_t)(u.a1 + ai * 128 + wr * 64 + m * 16 + fr) * EH + u.pn * 128 + wc * 32 + 8 * fq;
                const f32x4 ga = acc[ai][0][m][0] * WINV, gb = acc[ai][0][m][1] * WINV, ua = acc[ai][1][m][0] * WINV, ub = acc[ai][1][m][1] * WINV;
                u32x2 w; w.x = pk4_fp8(silu_f(ga.x) * ua.x, silu_f(ga.y) * ua.y, silu_f(ga.z) * ua.z, silu_f(ga.w) * ua.w);
                w.y = pk4_fp8(silu_f(gb.x) * ub.x, silu_f(gb.y) * ub.y, silu_f(gb.z) * ub.z, silu_f(gb.w) * ub.w);
                *(GAS u32x2*)(HID + ro) = w; }
    }
};
struct EpiDown0 {
    static constexpr int MIDT = 0; static constexpr bool PERM = true; MoeTab G; const i32x2* LIST; const LAS float* GA2; bf16* TMP;
    __device__ __forceinline__ void operator()(const f32x4 (&acc)[2][2][4][2], const pg8::Unit& u, int wr, int wc, int fr_, int fq_) const {
        int fr = fr_, fq = fq_; asm volatile("" : "+v"(fr), "+v"(fq));
        const int cnt = G.cnt[u.a0]; const int col0 = u.pn * 256 + wc * 32 + 8 * fq;
        const i32x2* lst = LIST + (size_t)u.a0 * T;
        const int idx0 = u.pm * 256 + wr * 64 + fr;
        i32x2 tw[2][4];
#pragma unroll
        for (int ai = 0; ai < 2; ++ai)
#pragma unroll
            for (int m = 0; m < 4; ++m) { const int idx = idx0 + ai * 128 + m * 16; tw[ai][m] = lst[idx < cnt ? idx : 0]; }
#pragma unroll
        for (int ai = 0; ai < 2; ++ai)
#pragma unroll
            for (int m = 0; m < 4; ++m) { const int idx = idx0 + ai * 128 + m * 16; const int tok = tw[ai][m].x; const float w = __uint_as_float((unsigned)tw[ai][m].y) * WINV;
                const LAS float* g2 = GA2 + (tok / SEQ) * 1024 + col0; bf16* dp = TMP + (size_t)tok * D + col0;
                if (idx < cnt) {
#pragma unroll
                    for (int bj = 0; bj < 2; ++bj) { const f32x4 ga = *(const LAS f32x4*)(g2 + bj * 128) * w, gb = *(const LAS f32x4*)(g2 + bj * 128 + 4) * w;
                        const f32x4 a = ga * acc[ai][bj][m][0], b = gb * acc[ai][bj][m][1];
                        u32x4 o; o.x = pg8::cvt_pk_bf16(a.x, a.y); o.y = pg8::cvt_pk_bf16(a.z, a.w); o.z = pg8::cvt_pk_bf16(b.x, b.y); o.w = pg8::cvt_pk_bf16(b.z, b.w);
                        *(GAS u32x4*)(dp + bj * 128) = o; } } }
    }
};
struct EpiDown {
    static constexpr int MIDT = 0; static constexpr bool PERM = false; MoeTab G; const i32x2* LIST; const LAS float* GA2; const bf16* base; const bf16* TMP; float* out;
    __device__ __forceinline__ void operator()(const f32x4 (&acc)[2][2][4][2], const pg8::Unit& u, int wr, int wc, int fr_, int fq_) const {
        int fr = fr_, fq = fq_; asm volatile("" : "+v"(fr), "+v"(fq));
        const int cnt = G.cnt[u.a0]; const int col0 = u.pn * 256 + wc * 32 + 4 * fq;
        const i32x2* lst = LIST + (size_t)u.a0 * T;
        const int idx0 = u.pm * 256 + wr * 64 + fr;
        i32x2 tw[2][4];
#pragma unroll
        for (int ai = 0; ai < 2; ++ai)
#pragma unroll
            for (int m = 0; m < 4; ++m) { const int idx = idx0 + ai * 128 + m * 16; tw[ai][m] = lst[idx < cnt ? idx : 0]; }
#pragma unroll
        for (int ai = 0; ai < 2; ++ai)
#pragma unroll
            for (int mp = 0; mp < 2; ++mp) {
                u32x2 bv[2][2][2]; u32x2 dv[2][2][2];
#pragma unroll
                for (int mm = 0; mm < 2; ++mm) { const size_t ro = (size_t)tw[ai][2 * mp + mm].x * D + col0;
#pragma unroll
                    for (int bj = 0; bj < 2; ++bj)
#pragma unroll
                        for (int n = 0; n < 2; ++n) { bv[mm][bj][n] = *(const GAS u32x2*)(base + ro + bj * 128 + n * 16); dv[mm][bj][n] = *(const GAS u32x2*)(TMP + ro + bj * 128 + n * 16); } }
#pragma unroll
                for (int mm = 0; mm < 2; ++mm) { const int m = 2 * mp + mm; const int idx = idx0 + ai * 128 + m * 16; const int tok = tw[ai][m].x; const float w = __uint_as_float((unsigned)tw[ai][m].y) * WINV;
                    const LAS float* g2 = GA2 + (tok / SEQ) * 1024 + col0; const size_t ro = (size_t)tok * D + col0;
                    if (idx < cnt) {
#pragma unroll
                        for (int bj = 0; bj < 2; ++bj)
#pragma unroll
                            for (int n = 0; n < 2; ++n) { const f32x4 gv = *(const LAS f32x4*)(g2 + bj * 128 + n * 16); const u32x2 d = dv[mm][bj][n];
                                const f32x4 dl = (f32x4){bf2f(d.x & 0xffffu), bf2f(d.x >> 16), bf2f(d.y & 0xffffu), bf2f(d.y >> 16)}; const u32x2 xb = bv[mm][bj][n];
                                const f32x4 xm = (f32x4){bf2f(xb.x & 0xffffu), bf2f(xb.x >> 16), bf2f(xb.y & 0xffffu), bf2f(xb.y >> 16)};
                                *(f32x4*)(out + ro + bj * 128 + n * 16) = (xm + dl) + gv * w * acc[ai][bj][m][n]; } } }
            }
    }
};
__device__ __forceinline__ void p4_moe_mfma(Frame& F, int part, bool have_tabs, bool have_ga2) {
    const MoeTab G = moe_tables(F, have_tabs); const i32x2* LIST = (const i32x2*)(F.ws + WS_LIST);
    if (part == 0) {
        pg8::Gemm g{(const bf16*)(F.ws + WS_H2), (const bf16*)(F.ws + WS_WGU), D, D, D};
        MoeOrder S{G, 0, G.tpre[64], F.G, F.bid, LIST, D, true}; EpiGateUp E{F.ws + WS_HID};
        pg8::gemm_phase<EpiGateUp, MoeOrder, true>(F.lds, g, S, E, F.wave);
    } else {
        const int kk = part - 1;
        pg8::Gemm g{(const bf16*)(F.ws + WS_HID), (const bf16*)(F.ws + WS_WD), EH, EH, EH};
        MoeOrderDown S{{G, G.tpre[32 * kk], G.tpre[32 * kk + 32], F.G, F.bid, LIST, EH, false}};
        LAS float* GA2 = (LAS float*)(F.lds + MOE_TAB_OFF + 2048);
        if (!have_ga2) { const float* MOD = (const float*)(F.ws + WS_MOD);
#pragma unroll
          for (int k = 0; k < 8; ++k) { const int i = F.tid + k * NTHR; GA2[i] = MOD[(i >> 10) * 6144 + 5120 + (i & 1023)]; }
          __syncthreads(); }
        bf16* TMP = (bf16*)(F.ws + WS_H2);
        if (kk == 0) { EpiDown0 E{G, LIST, GA2, TMP}; pg8::gemm_phase<EpiDown0, MoeOrderDown, true>(F.lds, g, S, E, F.wave); }
        else { EpiDown E{G, LIST, GA2, (const bf16*)(F.ws + WS_XMID), TMP, F.out}; pg8::gemm_phase<EpiDown, MoeOrderDown, true>(F.lds, g, S, E, F.wave); }
    }
}

constexpr int NPHASE = 10;
__global__ void __launch_bounds__(NTHR, 2) mk_fwd(Args args) {
    extern __shared__ __attribute__((aligned(16))) unsigned char lds[];
    Frame F;
    F.lds = (LAS unsigned char*)lds; F.ws = args.ws; F.ctl = (gu32*)(args.ws + WS_CTL);
    F.wave = __builtin_amdgcn_readfirstlane((int)threadIdx.x >> 6); F.lane = lane_id(); F.tid = F.wave * 64 + F.lane; F.G = gridDim.x; F.bid = blockIdx.x;
    F.ka = (const __attribute__((address_space(4))) unsigned char*)__builtin_amdgcn_kernarg_segment_ptr();
    F.out = args.out;
    volatile LAS unsigned* MISC = (volatile LAS unsigned*)(F.lds + LDS_BYTES - 64);
    if (F.tid < 16) MISC[F.tid] = 0u;
    __syncthreads();
    XcdBarrier bar; bar.bar = (unsigned*)(F.ctl + CW_BAR); bar.x = 0; bar.st = nullptr; bar.wave = F.wave;
    if (MK_N_LAUNCHES == 1) bar = xcd_barrier_post((unsigned*)(F.ctl + CW_BAR), MISC, F.wave);
    const int lo = args.ph_lo, hi = args.ph_hi;
#ifndef PH_MASK
#define PH_MASK 0x3ff
#endif
#define IN(k) (((PH_MASK >> (k)) & 1) && lo <= (k) && (k) < hi)
#define SEAM(k) do { if (IN(k) && IN((k) + 1)) xcd_barrier(bar); { int l_ = lane_id(); asm volatile("" : "+v"(l_)); F.lane = l_; F.tid = F.wave * 64 + l_; } } while (0)
    if (IN(0)) { p0_adaln_rope(F); p0_weights(F); }
    SEAM(0);
    if (IN(1)) { if (F.G == 256 && F.bid >= 208) p1c_ctx_units(F); else p1a_norm1(F); }
    SEAM(1);
    if (IN(2)) p1b_inproj_mfma(F);
    SEAM(2);
    if (IN(3)) { p2a_diffattn_mfma<0>(F, F.ws + WS_OA); { int l_ = lane_id(); asm volatile("" : "+v"(l_)); F.lane = l_; F.tid = F.wave * 64 + l_; } p2b_natten_mfma(F, F.ws + WS_OB); }
    SEAM(3);
    if (IN(4)) p3_merge_out_mfma(F, 0);
    SEAM(4);
    if (IN(5)) p3_merge_out_mfma(F, 1);
    SEAM(5);
    if (IN(6)) p4a_norm2_route(F);
    SEAM(6);
    if (IN(7)) p4_moe_mfma(F, 0, false, false);
    SEAM(7);
    if (IN(8)) p4_moe_mfma(F, 1, IN(7), false);
    SEAM(8);
    if (IN(9)) p4_moe_mfma(F, 2, IN(7) || IN(8), IN(8));
#undef IN
#undef SEAM
}

extern "C" void kernel_launch(void* const* d_in, const int* in_sizes, int n_in, void* d_out, int out_size, void* d_ws, size_t ws_size, hipStream_t stream) {
    static int grid = 0;
    if (grid == 0) {
        if (n_in != 29 || out_size != T * D || ws_size < WS_END) { fprintf(stderr, "kernel_launch: unexpected shapes: n_in %d out %d ws %zu\n", n_in, out_size, ws_size); grid = -1; return; }
        int dev = 0, cus = 0, per_cu = 0;
        if (hipGetDevice(&dev) != hipSuccess || hipDeviceGetAttribute(&cus, hipDeviceAttributeMultiprocessorCount, dev) != hipSuccess) { grid = -1; return; }
        if (hipFuncSetAttribute((const void*)mk_fwd, hipFuncAttributeMaxDynamicSharedMemorySize, LDS_BYTES) != hipSuccess) { fprintf(stderr, "kernel_launch: hipFuncSetAttribute failed\n"); grid = -1; return; }
        if (hipOccupancyMaxActiveBlocksPerMultiprocessor(&per_cu, (const void*)mk_fwd, NTHR, LDS_BYTES) != hipSuccess || per_cu < 1) fprintf(stderr, "kernel_launch: occupancy query says %d\n", per_cu);
        (void)hipGetLastError();
        grid = cus;
    }
    if (grid < 0) return;
    if (hipMemsetAsync((char*)d_ws + WS_CTL, 0, CTL_ZERO_BYTES, stream) != hipSuccess) return;
    Args a{};
    for (int i = 0; i < 29; ++i) a.in[i] = (const float*)d_in[i];
    a.out = (float*)d_out; a.ws = (unsigned char*)d_ws;
    if (MK_N_LAUNCHES == 1) { a.ph_lo = 0; a.ph_hi = NPHASE; hipLaunchKernelGGL(mk_fwd, dim3(grid), dim3(NTHR), LDS_BYTES, stream, a); }
    else for (int p = 0; p < NPHASE; ++p) { a.ph_lo = p; a.ph_hi = p + 1; hipLaunchKernelGGL(mk_fwd, dim3(grid), dim3(NTHR), LDS_BYTES, stream, a); }
}
```
